# Optimizing an MI355X kernel written in HIP

```python
import math
import jax, jax.numpy as jnp
from jax import lax
import numpy as np

D_MODEL = 4096
BATCH = 4
SEQ = 2048
DEPTH = 4

CHUNK = 64
N_MIXERS = 2
MEM_TOKENS = 256
X_HEADS = 4
X_WIDTH = D_MODEL // 4
X_HEAD_DIM = X_WIDTH // X_HEADS
MIX_WIDTH = D_MODEL - X_WIDTH
SC_WIDTH = 3
GDN_CONV_WIDTH = 4
GDN_HEAD_DIM = 128
GDN_HEADS = MIX_WIDTH // GDN_HEAD_DIM
D_FF = 3 * D_MODEL // 2
EPS = 1e-6
SC_IN = 3 * MIX_WIDTH + X_WIDTH
GDN_IN = 4 * MIX_WIDTH + 2 * GDN_HEADS + X_WIDTH

kernel_name = "chunk_causal_hybrid_conv_gdn_trunk"


def rms_norm(x, g):
    xf = x.astype(jnp.float32)
    y = xf * lax.rsqrt(jnp.mean(xf * xf, axis=-1, keepdims=True) + EPS)
    return (y * g.astype(jnp.float32)).astype(x.dtype)


def l2_norm(x):
    xf = x.astype(jnp.float32)
    return xf * lax.rsqrt(jnp.sum(xf * xf, axis=-1, keepdims=True) + EPS)


def swiglu(x, w_gate, w_up, w_down):
    return (jax.nn.silu(x @ w_gate) * (x @ w_up)) @ w_down


def macaron_ffn(h, pre_g, post_g, w_gate, w_up, w_down):
    return h + 0.5 * rms_norm(swiglu(rms_norm(h, pre_g), w_gate, w_up, w_down), post_g)


def causal_depthwise_conv(x, w):
    width = w.shape[0]
    seq = x.shape[1]
    xp = jnp.pad(x, ((0, 0), (width - 1, 0), (0, 0)))
    return sum(xp[:, j:j + seq] * w[j] for j in range(width))


def memory_cross_attention(xq, mem_n, w_kv):
    b, s, _ = xq.shape
    m = mem_n.shape[1]
    k, v = jnp.split(mem_n @ w_kv, 2, axis=-1)
    q = xq.reshape(b, s, X_HEADS, X_HEAD_DIM)
    k = k.reshape(b, m, X_HEADS, X_HEAD_DIM)
    v = v.reshape(b, m, X_HEADS, X_HEAD_DIM)
    scores = jnp.einsum('bshd,bmhd->bhsm', q, k).astype(jnp.float32) * (X_HEAD_DIM ** -0.5)
    p = jax.nn.softmax(scores, axis=-1).astype(v.dtype)
    return jnp.einsum('bhsm,bmhd->bshd', p, v).reshape(b, s, X_WIDTH)


def short_conv_mixer(hn, mem_n, w_in, conv_w, w_kv, w_out):
    proj = hn @ w_in
    gate_b, gate_c, hid, xq = jnp.split(proj, [MIX_WIDTH, 2 * MIX_WIDTH, 3 * MIX_WIDTH], axis=-1)
    y = gate_b * causal_depthwise_conv(gate_c * hid, conv_w)
    xo = memory_cross_attention(xq, mem_n, w_kv)
    return jnp.concatenate([y, xo], axis=-1) @ w_out


def chunk_gated_delta_rule(q, k, v, g, beta):
    bsz, s, h, dk = q.shape
    dv = v.shape[-1]
    n = s // CHUNK
    f32 = jnp.float32

    def to_chunks(t):
        t = jnp.moveaxis(t.astype(f32), 2, 1)
        return t.reshape(t.shape[:2] + (n, CHUNK) + t.shape[3:])

    q, k, v, g, beta = (to_chunks(t) for t in (q, k, v, g, beta))
    q = q * (dk ** -0.5)
    k_beta = k * beta[..., None]
    v_beta = v * beta[..., None]
    g = jnp.cumsum(g, axis=-1)
    causal = jnp.tril(jnp.ones((CHUNK, CHUNK), dtype=bool))
    strict = jnp.tril(jnp.ones((CHUNK, CHUNK), dtype=bool), k=-1)
    diff = g[..., :, None] - g[..., None, :]
    decay = jnp.where(causal, jnp.exp(jnp.where(causal, diff, 0.0)), 0.0)
    lower = jnp.where(strict, jnp.einsum('bhncd,bhnsd->bhncs', k_beta, k) * decay, 0.0)
    eye = jnp.eye(CHUNK, dtype=f32)
    t_mat = lax.linalg.triangular_solve(eye + lower, jnp.broadcast_to(eye, lower.shape),
                                        left_side=True, lower=True, unit_diagonal=True)
    u = t_mat @ v_beta
    w = t_mat @ (k_beta * jnp.exp(g)[..., None])
    intra = jnp.where(causal, jnp.einsum('bhncd,bhnsd->bhncs', q, k) * decay, 0.0)
    q_dec = q * jnp.exp(g)[..., None]
    k_tail = k * jnp.exp(g[..., -1:] - g)[..., None]
    chunk_decay = jnp.exp(g[..., -1])

    def step(state, inp):
        w_c, u_c, q_c, intra_c, k_c, d_c = inp
        v_new = u_c - w_c @ state
        out = q_c @ state + intra_c @ v_new
        state = state * d_c[..., None, None] + jnp.einsum('bhck,bhcv->bhkv', k_c, v_new)
        return state, out

    xs = tuple(jnp.moveaxis(t, 2, 0) for t in (w, u, q_dec, intra, k_tail, chunk_decay))
    state0 = jnp.zeros((bsz, h, dk, dv), f32)
    _, out = lax.scan(step, state0, xs)
    out = jnp.moveaxis(out, 0, 2).reshape(bsz, h, s, dv)
    return jnp.moveaxis(out, 1, 2)


def gated_deltanet_mixer(hn, mem_n, w_in, conv_w, a_log, dt_bias, norm_g, w_kv, w_out):
    b, s, _ = hn.shape
    f32 = jnp.float32
    proj = hn @ w_in
    qkv, z, beta_in, a_in, xq = jnp.split(
        proj, [3 * MIX_WIDTH, 4 * MIX_WIDTH, 4 * MIX_WIDTH + GDN_HEADS, 4 * MIX_WIDTH + 2 * GDN_HEADS], axis=-1)
    qkv = jax.nn.silu(causal_depthwise_conv(qkv, conv_w))
    q, k, v = jnp.split(qkv, 3, axis=-1)
    q = l2_norm(q.reshape(b, s, GDN_HEADS, GDN_HEAD_DIM))
    k = l2_norm(k.reshape(b, s, GDN_HEADS, GDN_HEAD_DIM))
    v = v.reshape(b, s, GDN_HEADS, GDN_HEAD_DIM).astype(f32)
    beta = jax.nn.sigmoid(beta_in.astype(f32))
    g = -jnp.exp(a_log.astype(f32)) * jax.nn.softplus(a_in.astype(f32) + dt_bias.astype(f32))
    o = chunk_gated_delta_rule(q, k, v, g, beta)
    o = o * lax.rsqrt(jnp.mean(o * o, axis=-1, keepdims=True) + EPS) * norm_g.astype(f32)
    o = o * jax.nn.silu(z.reshape(b, s, GDN_HEADS, GDN_HEAD_DIM).astype(f32))
    y = o.reshape(b, s, MIX_WIDTH).astype(hn.dtype)
    xo = memory_cross_attention(xq, mem_n, w_kv)
    return jnp.concatenate([y, xo], axis=-1) @ w_out


def setup_inputs(seed: int = 0) -> dict:
    key = jax.random.key(seed)
    ks = iter(jax.random.split(key, 24))
    f32 = jnp.float32
    n_a = (DEPTH + N_MIXERS - 1) // N_MIXERS
    n_b = DEPTH // N_MIXERS

    def dense(shape, fan_in):
        return jax.random.normal(next(ks), shape, f32) * (fan_in ** -0.5)

    def gain(shape):
        return 1.0 + 0.02 * jax.random.normal(next(ks), shape, f32)

    x = jax.random.normal(next(ks), (BATCH, SEQ, D_MODEL), f32)
    mem = jax.random.normal(next(ks), (BATCH, MEM_TOKENS, D_MODEL), f32)
    ffn_pre_g = gain((DEPTH, 2, D_MODEL))
    ffn_post_g = gain((DEPTH, 2, D_MODEL))
    mix_pre_g = gain((DEPTH, D_MODEL))
    mix_post_g = gain((DEPTH, D_MODEL))
    mem_g = gain((DEPTH, D_MODEL))
    ffn_w_gate = dense((DEPTH, 2, D_MODEL, D_FF), D_MODEL)
    ffn_w_up = dense((DEPTH, 2, D_MODEL, D_FF), D_MODEL)
    ffn_w_down = dense((DEPTH, 2, D_FF, D_MODEL), D_FF)
    mem_w_kv = dense((DEPTH, D_MODEL, 2 * X_WIDTH), D_MODEL)
    mix_w_out = dense((DEPTH, D_MODEL, D_MODEL), D_MODEL)
    sc_w_in = dense((n_a, D_MODEL, SC_IN), D_MODEL)
    sc_conv_w = dense((n_a, SC_WIDTH, MIX_WIDTH), SC_WIDTH)
    gdn_w_in = dense((n_b, D_MODEL, GDN_IN), D_MODEL)
    gdn_conv_w = dense((n_b, GDN_CONV_WIDTH, 3 * MIX_WIDTH), GDN_CONV_WIDTH)
    gdn_a_log = jnp.log(jax.random.uniform(next(ks), (n_b, GDN_HEADS), f32, 1.0, 16.0))
    dt = jnp.exp(jax.random.uniform(next(ks), (n_b, GDN_HEADS), f32, math.log(1e-3), math.log(1e-1)))
    gdn_dt_bias = dt + jnp.log(-jnp.expm1(-dt))
    gdn_norm_g = gain((n_b, GDN_HEAD_DIM))
    return {"x": x, "mem": mem, "ffn_pre_g": ffn_pre_g, "ffn_post_g": ffn_post_g,
            "mix_pre_g": mix_pre_g, "mix_post_g": mix_post_g, "mem_g": mem_g,
            "ffn_w_gate": ffn_w_gate, "ffn_w_up": ffn_w_up, "ffn_w_down": ffn_w_down,
            "mem_w_kv": mem_w_kv, "mix_w_out": mix_w_out, "sc_w_in": sc_w_in, "sc_conv_w": sc_conv_w,
            "gdn_w_in": gdn_w_in, "gdn_conv_w": gdn_conv_w, "gdn_a_log": gdn_a_log,
            "gdn_dt_bias": gdn_dt_bias, "gdn_norm_g": gdn_norm_g}


def reference(x, mem, ffn_pre_g, ffn_post_g, mix_pre_g, mix_post_g, mem_g, ffn_w_gate, ffn_w_up,
              ffn_w_down, mem_w_kv, mix_w_out, sc_w_in, sc_conv_w, gdn_w_in, gdn_conv_w, gdn_a_log,
              gdn_dt_bias, gdn_norm_g):
    h = x
    for i in range(DEPTH):
        j = i // N_MIXERS
        h = macaron_ffn(h, ffn_pre_g[i, 0], ffn_post_g[i, 0], ffn_w_gate[i, 0], ffn_w_up[i, 0], ffn_w_down[i, 0])
        hn = rms_norm(h, mix_pre_g[i])
        mem_n = rms_norm(mem, mem_g[i])
        if i % N_MIXERS == 0:
            mixed = short_conv_mixer(hn, mem_n, sc_w_in[j], sc_conv_w[j], mem_w_kv[i], mix_w_out[i])
        else:
            mixed = gated_deltanet_mixer(hn, mem_n, gdn_w_in[j], gdn_conv_w[j], gdn_a_log[j],
                                         gdn_dt_bias[j], gdn_norm_g[j], mem_w_kv[i], mix_w_out[i])
        h = h + rms_norm(mixed, mix_post_g[i])
        h = macaron_ffn(h, ffn_pre_g[i, 1], ffn_post_g[i, 1], ffn_w_gate[i, 1], ffn_w_up[i, 1], ffn_w_down[i, 1])
    return h
```

```cpp
#include <hip/hip_runtime.h>
#include <cstdio>
#include <cstdint>
namespace pg8 {
#define PG8_LAS __attribute__((address_space(3)))
typedef unsigned short bf16_t;
typedef short bf16x8 __attribute__((ext_vector_type(8)));
typedef float f32x4 __attribute__((ext_vector_type(4)));
typedef unsigned u32x4 __attribute__((ext_vector_type(4)));
constexpr int BM = 256, BK = 64, HALF = 128, HTB = HALF * BK * 2  , STAGE_BYTES = 8 * HTB, NXCD = 8, WGM = 8;

__host__ __device__ __forceinline__ int lds_byte(int r, int c) { const int st = (r >> 4) * 2 + (c >> 5), rr = r & 15, cc = c & 31, ob = rr * 64 + cc * 2; return st * 1024 + (ob ^ (((ob >> 9) & 1) << 5)); }
__host__ __device__ __forceinline__ void stage_rc(int b, int& R, int& C) { const int st = b / 1024, sb = b % 1024, swz = sb ^ (((sb >> 9) & 1) << 5); R = (st >> 1) * 16 + swz / 64; C = (st & 1) * 32 + (swz % 64) / 2; }
__host__ __device__ __forceinline__ int perm32(int rho) { const int n = rho >> 4, i = rho & 15; return 8 * (i >> 2) + 4 * n + (i & 3); }

struct Unit { int pm, pn; };
struct Gemm { const bf16_t* A; const bf16_t* Bt; int M, N, K; };

struct StaticOrder {
    int nM, nN, nwg, G, c;
    __host__ __device__ void init(int M, int N, int G_, int c_) { nM = M / BM; nN = N / BM; nwg = nM * nN; G = G_; c = c_; }
    __host__ __device__ bool next(int i, Unit& u) const {
        const long L = (long)i * G + c; if (L >= nwg) return false;
        int wgid = (int)L; { const int q = nwg / NXCD, r = nwg % NXCD, xcd = wgid % NXCD, off = wgid / NXCD; wgid = (xcd < r ? xcd * (q + 1) : r * (q + 1) + (xcd - r) * q) + off; }
        const int nig = WGM * nN, gid = wgid / nig, fm = gid * WGM, gsz = (nM - fm) < WGM ? (nM - fm) : WGM;
        u.pm = fm + ((wgid % nig) % gsz); u.pn = (wgid % nig) / gsz; return true;
    }
    __device__ __forceinline__ void a_ready(const Unit&) const {}
    __device__ __forceinline__ void done(const Unit&) const {}
};

__device__ __forceinline__ unsigned cvt_pk_bf16(float lo, float hi) { unsigned r; asm volatile("v_cvt_pk_bf16_f32 %0, %1, %2" : "=v"(r) : "v"(lo), "v"(hi)); return r; }

struct EpiProj {
    static constexpr bool PERM = true, AFTER_DRAIN = false;
    bf16_t* O; int ldc; float* aux; int aux_pn;
    __device__ __forceinline__ void operator()(const f32x4 (&acc)[2][2][4][2], const Unit& u, int wr, int wc, int fr, int fq) const {
        const int row0 = u.pm * BM + wr * 64 + fr;
        if (u.pn == aux_pn) {
            if (wc < 2) {
#pragma unroll
                for (int ai = 0; ai < 2; ++ai)
#pragma unroll
                    for (int m = 0; m < 4; ++m) { float* rowp = aux + (size_t)(row0 + ai * HALF + m * 16) * 64 + wc * 32 + 8 * fq;
                        *(f32x4*)(rowp) = acc[ai][0][m][0]; *(f32x4*)(rowp + 4) = acc[ai][0][m][1]; }
            }
            return;
        }
        const int col0 = u.pn * BM + wc * 32 + 8 * fq;
#pragma unroll
        for (int ai = 0; ai < 2; ++ai)
#pragma unroll
            for (int m = 0; m < 4; ++m) { bf16_t* rowp = O + (size_t)(row0 + ai * HALF + m * 16) * ldc + col0;
#pragma unroll
                for (int bj = 0; bj < 2; ++bj) { const f32x4 v0 = acc[ai][bj][m][0], v1 = acc[ai][bj][m][1];
                    u32x4 w; w.x = cvt_pk_bf16(v0[0], v0[1]); w.y = cvt_pk_bf16(v0[2], v0[3]); w.z = cvt_pk_bf16(v1[0], v1[1]); w.w = cvt_pk_bf16(v1[2], v1[3]);
                    *(u32x4*)(rowp + bj * HALF) = w; } }
    }
};
struct EpiSwiGLU {
    static constexpr bool PERM = true, AFTER_DRAIN = false;
    bf16_t* O; int ldc;
    __device__ __forceinline__ void operator()(const f32x4 (&acc)[2][2][4][2], const Unit& u, int wr, int wc, int fr, int fq) const {
        const int row0 = u.pm * BM + wr * 64 + fr, col0 = u.pn * HALF + wc * 32 + 8 * fq;
#pragma unroll
        for (int ai = 0; ai < 2; ++ai)
#pragma unroll
            for (int m = 0; m < 4; ++m) { bf16_t* rowp = O + (size_t)(row0 + ai * HALF + m * 16) * ldc + col0;
                f32x4 r[2];
#pragma unroll
                for (int n = 0; n < 2; ++n)
#pragma unroll
                    for (int j = 0; j < 4; ++j) { const float g = acc[ai][0][m][n][j], up = acc[ai][1][m][n][j];
                        r[n][j] = g * up * __builtin_amdgcn_rcpf(1.0f + __builtin_amdgcn_exp2f(g * -1.44269504089f)); }
                u32x4 w; w.x = cvt_pk_bf16(r[0][0], r[0][1]); w.y = cvt_pk_bf16(r[0][2], r[0][3]); w.z = cvt_pk_bf16(r[1][0], r[1][1]); w.w = cvt_pk_bf16(r[1][2], r[1][3]);
                *(u32x4*)(rowp) = w; }
    }
};
struct EpiKV {
    static constexpr bool PERM = true, AFTER_DRAIN = false;
    bf16_t* Kb; bf16_t* VTb;
    __device__ __forceinline__ void operator()(const f32x4 (&acc)[2][2][4][2], const Unit& u, int wr, int wc, int fr, int fq) const {
        const int l = u.pm / 12, ri = u.pm % 12, rj = u.pn % 12;
        bf16_t* base = (ri < 4) ? Kb + (size_t)l * 1048576 + (size_t)(ri * 256) * 1024 + (rj - 4) * 256
                                : VTb + (size_t)l * 1048576 + (size_t)((ri - 8) * 256) * 1024 + rj * 256;
        const int row0 = wr * 64 + fr, col0 = wc * 32 + 8 * fq;
#pragma unroll
        for (int ai = 0; ai < 2; ++ai)
#pragma unroll
            for (int m = 0; m < 4; ++m) { bf16_t* rowp = base + (size_t)(row0 + ai * HALF + m * 16) * 1024 + col0;
#pragma unroll
                for (int bj = 0; bj < 2; ++bj) { const f32x4 v0 = acc[ai][bj][m][0], v1 = acc[ai][bj][m][1];
                    u32x4 w; w.x = cvt_pk_bf16(v0[0], v0[1]); w.y = cvt_pk_bf16(v0[2], v0[3]); w.z = cvt_pk_bf16(v1[0], v1[1]); w.w = cvt_pk_bf16(v1[2], v1[3]);
                    *(u32x4*)(rowp + bj * HALF) = w; } }
    }
};
struct KvOrder {
    int G, c;
    __device__ __forceinline__ bool next(int i, Unit& u) const {
        const int L = i * G + c; if (L >= 128) return false;
        const int l = L >> 5, r = L & 31;
        if (r < 16) { u.pm = 12 * l + (r >> 2); u.pn = 12 * l + 4 + (r & 3); }
        else { u.pm = 12 * l + 8 + ((r - 16) >> 2); u.pn = 12 * l + (r & 3); }
        return true;
    }
    __device__ __forceinline__ void a_ready(const Unit&) const {}
    __device__ __forceinline__ void done(const Unit&) const {}
};

template <class Epi, class Sched, bool ALIGN_EPI = false, bool SP2 = false>
__device__ __forceinline__ void gemm_phase(PG8_LAS unsigned char* lds, const Gemm g, const Sched& S, const Epi& E) {
    int tid_o = threadIdx.x; asm volatile("" : "+v"(tid_o));
    const int tid = tid_o, wid = __builtin_amdgcn_readfirstlane(tid >> 6), lane = tid & 63, wr = wid >> 2, wc = wid & 3, fr = lane & 15, fq = lane >> 4;
    const int K = g.K, nt = K / BK;
    unsigned voffA[2], voffB[2];
#pragma unroll
    for (int i = 0; i < 2; ++i) { int R, C; stage_rc(tid * 16 + i * 8192, R, C); const int Rb = Epi::PERM ? ((R & ~31) + perm32(R & 31)) : R;
        voffA[i] = (unsigned)(R * K + C) * 2u; voffB[i] = (unsigned)(Rb * K + C) * 2u; }
    const size_t kstep = (size_t)(BK * 2);
    const size_t hstep = (size_t)HALF * K * 2;
    const size_t tstep = 2 * hstep;
    const unsigned ldsw = (unsigned)wid * 1024u;
    const int aoff = lds_byte(wr * 64 + fr, fq * 8), boff = lds_byte(wc * 32 + fr, fq * 8);
#define PG8_SA(b, h) (((b) * 2 + (h)) * HTB)
#define PG8_SB(b, h) ((4 + (b) * 2 + (h)) * HTB)
#define PG8_STAGE(bufoff, gbase, voff) do { _Pragma("unroll") for (int _i = 0; _i < 2; ++_i) \
        __builtin_amdgcn_global_load_lds((const unsigned*)((const char*)(gbase) + (voff)[_i]), (PG8_LAS unsigned*)(lds + (bufoff) + ldsw + _i * 8192), 16, 0, 0); } while (0)
#define PG8_LDA(dst, b, h) do { _Pragma("unroll") for (int m = 0; m < 4; ++m) _Pragma("unroll") for (int k = 0; k < 2; ++k) dst[m][k] = *(const PG8_LAS bf16x8*)(lds + PG8_SA(b, h) + aoff + m * 2048 + k * 1024); } while (0)
#define PG8_LDB(dst, b, h) do { _Pragma("unroll") for (int n = 0; n < 2; ++n) _Pragma("unroll") for (int k = 0; k < 2; ++k) dst[n][k] = *(const PG8_LAS bf16x8*)(lds + PG8_SB(b, h) + boff + n * 2048 + k * 1024); } while (0)
#define PG8_MMA(ai, bj, At, Bt) do { __builtin_amdgcn_s_setprio(1); _Pragma("unroll") for (int m = 0; m < 4; ++m) _Pragma("unroll") for (int n = 0; n < 2; ++n) _Pragma("unroll") for (int k = 0; k < 2; ++k) \
        acc[ai][bj][m][n] = __builtin_amdgcn_mfma_f32_16x16x32_bf16(Bt[n][k], At[m][k], acc[ai][bj][m][n], 0, 0, 0); __builtin_amdgcn_s_setprio(0); } while (0)
#define PG8_WAIT_V(n) asm volatile("s_waitcnt vmcnt(" #n ")" ::: "memory")
#define PG8_WAIT_L(n) asm volatile("s_waitcnt lgkmcnt(" #n ")" ::: "memory")
#define PG8_BAR __builtin_amdgcn_s_barrier()
#define PG8_SCHED __builtin_amdgcn_sched_barrier(0)
    Unit cur, nxt; int ui = 0;
    if (!S.next(0, cur)) return;
    f32x4 acc[2][2][4][2];
#pragma unroll
    for (int a = 0; a < 2; ++a)
#pragma unroll
        for (int b = 0; b < 2; ++b)
#pragma unroll
            for (int m = 0; m < 4; ++m)
#pragma unroll
                for (int n = 0; n < 2; ++n) acc[a][b][m][n] = (f32x4){0.f, 0.f, 0.f, 0.f};
    bf16x8 At[4][2], B0[2][2], B1[2][2];
    const char* cA = (const char*)g.A + (size_t)cur.pm * tstep; const char* cB = (const char*)g.Bt + (size_t)cur.pn * tstep;
    S.a_ready(cur);
    if constexpr (SP2) {
        PG8_STAGE(PG8_SB(0, 0), cB, voffB); PG8_STAGE(PG8_SB(0, 1), cB + hstep, voffB); PG8_STAGE(PG8_SA(0, 0), cA, voffA); PG8_STAGE(PG8_SA(0, 1), cA + hstep, voffA);
        if (wr == 1) PG8_BAR;
        PG8_WAIT_V(2); PG8_BAR;
        PG8_STAGE(PG8_SB(1, 0), cB + kstep, voffB); PG8_STAGE(PG8_SA(1, 0), cA + kstep, voffA); PG8_STAGE(PG8_SB(1, 1), cB + hstep + kstep, voffB);
        PG8_WAIT_V(6); PG8_BAR;
    } else {
        PG8_STAGE(PG8_SB(0, 0), cB, voffB); PG8_STAGE(PG8_SA(0, 0), cA, voffA); PG8_STAGE(PG8_SB(0, 1), cB + hstep, voffB); PG8_STAGE(PG8_SA(0, 1), cA + hstep, voffA);
        if (wr == 1) PG8_BAR;
        PG8_WAIT_V(4); PG8_BAR;
        PG8_STAGE(PG8_SB(1, 0), cB + kstep, voffB); PG8_STAGE(PG8_SA(1, 0), cA + kstep, voffA); PG8_STAGE(PG8_SB(1, 1), cB + hstep + kstep, voffB);
        PG8_WAIT_V(6); PG8_BAR;
    }
    for (;;) {
        const bool has_next = S.next(ui + 1, nxt);
        const char* nA = has_next ? (const char*)g.A + (size_t)nxt.pm * tstep : cA; const char* nB = has_next ? (const char*)g.Bt + (size_t)nxt.pn * tstep : cB;
        for (int t = 0; t < nt; t += 2) {
            const bool last = (t == nt - 2);
            const char* a1 = cA + (size_t)(t + 1) * kstep;
            const char* a2 = last ? nA : cA + (size_t)(t + 2) * kstep; const char* b2 = last ? nB : cB + (size_t)(t + 2) * kstep;
            const char* a3 = a2 + kstep; const char* b3 = b2 + kstep;
            if (last && has_next) S.a_ready(nxt);
            if constexpr (SP2) {
            PG8_LDB(B0, 0, 0); PG8_LDB(B1, 0, 1); PG8_SCHED; PG8_LDA(At, 0, 0); PG8_STAGE(PG8_SA(1, 1), a1 + hstep, voffA);
            PG8_WAIT_V(8); PG8_WAIT_L(0); PG8_BAR; PG8_MMA(0, 0, At, B0); PG8_MMA(0, 1, At, B1); PG8_BAR; PG8_SCHED;
            PG8_LDA(At, 0, 1); PG8_STAGE(PG8_SB(0, 0), b2, voffB); PG8_STAGE(PG8_SB(0, 1), b2 + hstep, voffB); PG8_STAGE(PG8_SA(0, 0), a2, voffA);
            PG8_WAIT_V(8); PG8_WAIT_L(0); PG8_BAR; PG8_MMA(1, 0, At, B0); PG8_MMA(1, 1, At, B1); PG8_BAR; PG8_SCHED;
            PG8_LDB(B0, 1, 0); PG8_LDB(B1, 1, 1); PG8_SCHED; PG8_LDA(At, 1, 0); PG8_STAGE(PG8_SA(0, 1), a2 + hstep, voffA);
            PG8_WAIT_V(8); PG8_WAIT_L(0); PG8_BAR; PG8_MMA(0, 0, At, B0); PG8_MMA(0, 1, At, B1); PG8_BAR; PG8_SCHED;
            PG8_LDA(At, 1, 1); PG8_STAGE(PG8_SB(1, 0), b3, voffB); PG8_STAGE(PG8_SB(1, 1), b3 + hstep, voffB); PG8_STAGE(PG8_SA(1, 0), a3, voffA);
            PG8_WAIT_V(8); PG8_WAIT_L(0); PG8_BAR; PG8_MMA(1, 0, At, B0); PG8_MMA(1, 1, At, B1); PG8_BAR; PG8_SCHED;
            } else {
            PG8_LDB(B0, 0, 0); PG8_SCHED; PG8_LDA(At, 0, 0); PG8_STAGE(PG8_SA(1, 1), a1 + hstep, voffA);
            PG8_WAIT_L(8); PG8_BAR; PG8_WAIT_L(0); PG8_MMA(0, 0, At, B0); PG8_BAR; PG8_SCHED;
            PG8_LDB(B1, 0, 1); PG8_STAGE(PG8_SB(0, 0), b2, voffB);
            PG8_BAR; PG8_WAIT_L(0); PG8_MMA(0, 1, At, B1); PG8_BAR;
            PG8_LDA(At, 0, 1); PG8_STAGE(PG8_SA(0, 0), a2, voffA);
            PG8_BAR; PG8_WAIT_L(0); PG8_MMA(1, 0, At, B0); PG8_BAR; PG8_SCHED;
            PG8_STAGE(PG8_SB(0, 1), b2 + hstep, voffB);
            PG8_WAIT_V(6); PG8_BAR; PG8_MMA(1, 1, At, B1); PG8_BAR;
            PG8_LDB(B0, 1, 0); PG8_SCHED; PG8_LDA(At, 1, 0); PG8_STAGE(PG8_SA(0, 1), a2 + hstep, voffA);
            PG8_WAIT_L(8); PG8_BAR; PG8_WAIT_L(0); PG8_MMA(0, 0, At, B0); PG8_BAR; PG8_SCHED;
            PG8_LDB(B1, 1, 1); PG8_STAGE(PG8_SB(1, 0), b3, voffB);
            PG8_BAR; PG8_WAIT_L(0); PG8_MMA(0, 1, At, B1); PG8_BAR;
            PG8_LDA(At, 1, 1); PG8_STAGE(PG8_SA(1, 0), a3, voffA);
            PG8_BAR; PG8_WAIT_L(0); PG8_MMA(1, 0, At, B0); PG8_BAR; PG8_SCHED;
            PG8_STAGE(PG8_SB(1, 1), b3 + hstep, voffB);
            PG8_WAIT_V(6); PG8_BAR; PG8_MMA(1, 1, At, B1); PG8_BAR;
            }
        }
        if constexpr (ALIGN_EPI) { if (wr == 0) PG8_BAR; }
        if constexpr (!Epi::AFTER_DRAIN) { E(acc, cur, wr, wc, fr, fq); S.done(cur); }
        if (!has_next) break;
#pragma unroll
        for (int a = 0; a < 2; ++a)
#pragma unroll
            for (int b = 0; b < 2; ++b)
#pragma unroll
                for (int m = 0; m < 4; ++m)
#pragma unroll
                    for (int n = 0; n < 2; ++n) acc[a][b][m][n] = (f32x4){0.f, 0.f, 0.f, 0.f};
        cur = nxt; cA = nA; cB = nB; ++ui;
        if constexpr (ALIGN_EPI) { if (wr == 1) PG8_BAR; }
    }
    PG8_WAIT_V(0);
    if constexpr (!ALIGN_EPI) { if (wr == 0) PG8_BAR; }
    PG8_BAR;
    if constexpr (Epi::AFTER_DRAIN) { E.fused(acc, cur, wr, wc, fr, fq, lds, wid, lane); S.done(cur); }
#undef PG8_SA
#undef PG8_SB
#undef PG8_STAGE
#undef PG8_LDA
#undef PG8_LDB
#undef PG8_MMA
#undef PG8_WAIT_V
#undef PG8_WAIT_L
#undef PG8_BAR
#undef PG8_SCHED
}
}

#ifndef PG8_SP2
#define PG8_SP2 true
#endif
#ifndef PG8_ALIGN
#define PG8_ALIGN true
#endif

constexpr int NWAVES = 8;
constexpr int DM = 4096, NBATCH = 4, SEQ = 2048, MROWS = NBATCH * SEQ, DEPTH = 4;
constexpr int MEMT = 256, XH = 4, XW = 1024, XHD = 256, MIXW = 3072, DFF = 6144;
constexpr int GH = 24, GHD = 128;
constexpr int SC_IN = 3 * MIXW + XW;
constexpr int GDN_SRC = 4 * MIXW + 2 * GH + XW;
constexpr int GDN_LD = 4 * MIXW + XW;
constexpr int GDN_N = GDN_LD + 256;
constexpr float EPS = 1e-6f;

constexpr size_t MiB = 1u << 20;
constexpr size_t WS_CTL = 0, CTL_ZERO_BYTES = 1 * MiB;
constexpr size_t WS_H = 1 * MiB;
constexpr size_t WS_A = WS_H + 128 * MiB;
constexpr size_t WS_OUT = WS_A + 64 * MiB;
constexpr size_t WS_CAT = WS_OUT + 64 * MiB;
constexpr size_t WS_ACT = WS_CAT + 64 * MiB;
constexpr size_t WS_PROJ = WS_ACT + 96 * MiB;
constexpr size_t WS_AUX = WS_PROJ + 208 * MiB;
constexpr size_t WS_AB = WS_AUX + 2 * MiB;
constexpr size_t WS_QKV = WS_AB + 2 * MiB;
constexpr size_t WS_O = WS_QKV + 144 * MiB;
constexpr size_t WS_KVOPS = WS_O + 96 * MiB;
constexpr size_t WS_KB = WS_KVOPS + 96 * MiB;
constexpr size_t WS_VTB = WS_KB + 8 * MiB;
constexpr size_t WS_WGU = WS_VTB + 8 * MiB;
constexpr size_t WS_WDN = WS_WGU + 768 * MiB;
constexpr size_t WS_WOUT = WS_WDN + 384 * MiB;
constexpr size_t WS_WSC = WS_WOUT + 128 * MiB;
constexpr size_t WS_WGDN = WS_WSC + 160 * MiB;
constexpr size_t WS_END = WS_WGDN + 212 * MiB;
constexpr int CW_BAR = 4096;

constexpr int RING_OFF = 0, RING_BYTES = 131072;
constexpr int LDSCTL_OFF = RING_BYTES, MISC_OFF = LDSCTL_OFF + 320;
constexpr int LDS_BYTES = 147456;

#define GAS __attribute__((address_space(1)))
#define LAS __attribute__((address_space(3)))
typedef unsigned short bf16;
typedef unsigned v4u __attribute__((ext_vector_type(4)));
typedef unsigned v2u __attribute__((ext_vector_type(2)));
typedef float f32x4 __attribute__((ext_vector_type(4)));
typedef float f32x2 __attribute__((ext_vector_type(2)));
typedef short bf16x8 __attribute__((ext_vector_type(8)));
#define LDS_WAIT() asm volatile("s_waitcnt lgkmcnt(0)" ::: "memory")
#define VM_WAIT() asm volatile("s_waitcnt vmcnt(0)" ::: "memory")
__device__ __forceinline__ unsigned pk2(float lo, float hi) { return pg8::cvt_pk_bf16(lo, hi); }
__device__ __forceinline__ float bflo(unsigned u) { return __uint_as_float(u << 16); }
__device__ __forceinline__ float bfhi(unsigned u) { return __uint_as_float(u & 0xffff0000u); }
__device__ __forceinline__ float silu_f(float x) { return x * __builtin_amdgcn_rcpf(1.0f + __builtin_amdgcn_exp2f(x * -1.44269504089f)); }

#define XB_TMO      128
#define XB_XCNT(j)  (256  + 64 * (j))
#define XB_XSUB(j)  (1280 + 64 * (j))
#define XB_XGEN(j)  (2304 + 64 * (j))
#define XB_TOP      3328
#define XB_TOPGEN   3392
#define XCD_BAR_WORDS 3456
#define XB_SPIN_CAP (1u << 18)

__device__ __forceinline__ unsigned xb_ld(unsigned* p)              { return __hip_atomic_load(p, __ATOMIC_RELAXED, __HIP_MEMORY_SCOPE_AGENT); }
__device__ __forceinline__ unsigned xb_add(unsigned* p, unsigned v) { return __hip_atomic_fetch_add(p, v, __ATOMIC_RELAXED, __HIP_MEMORY_SCOPE_AGENT); }
__device__ __forceinline__ unsigned xb_xcc_id() { return (unsigned)__builtin_amdgcn_s_getreg((3 << 11) | 20) & 0xFu; }
#define XB_SPIN(cond, bar) do { unsigned _sp = 0; while (cond) { __builtin_amdgcn_s_sleep(1); \
    if ((++_sp & 255u) == 0u) { if (xb_ld(&(bar)[XB_TMO])) break; if (_sp > XB_SPIN_CAP) { atomicAdd(&(bar)[XB_TMO], 1u); break; } } } } while (0)

struct XcdBarrier {
    unsigned* bar; unsigned x;
    volatile LAS unsigned* st;
};
__device__ __forceinline__ XcdBarrier xcd_barrier_post(unsigned* bar, volatile LAS unsigned* st) {
    XcdBarrier b; b.bar = bar; b.x = xb_xcc_id(); b.st = st;
    if (threadIdx.x == 0) (void)xb_add(&bar[XB_XCNT(b.x)], 1u);
    return b;
}
__device__ __forceinline__ void xcd_barrier_complete(unsigned* bar, unsigned x, unsigned& nloc, unsigned& nx) {
    const unsigned G = gridDim.x * gridDim.y * gridDim.z;
    unsigned sum, cnt, mine, sp = 0u;
    for (;;) {
        sum = 0u; cnt = 0u; mine = 0u;
#pragma unroll
        for (unsigned j = 0; j < 16; ++j) { const unsigned c = xb_ld(&bar[XB_XCNT(j)]); sum += c; cnt += (c > 0u) ? 1u : 0u; mine = (j == x) ? c : mine; }
        if (sum == G) break;
        __builtin_amdgcn_s_sleep(1);
        if ((++sp & 255u) == 0u) { if (xb_ld(&bar[XB_TMO])) break; if (sp > XB_SPIN_CAP) { atomicAdd(&bar[XB_TMO], 1u); break; } }
    }
    nloc = mine > 0u ? mine : 1u; nx = cnt > 0u ? cnt : 1u;
}
__device__ __forceinline__ void xcd_barrier(const XcdBarrier& b) {
    asm volatile("s_waitcnt vmcnt(0)" ::: "memory");
    __syncthreads();
    if (threadIdx.x == 0) {
        unsigned* bar = b.bar;
        __builtin_amdgcn_s_waitcnt(0);
        unsigned nloc = b.st[0], nx = b.st[1];
        if (nloc == 0u) { xcd_barrier_complete(bar, b.x, nloc, nx); b.st[0] = nloc; b.st[1] = nx; }
        const unsigned old = xb_add(&bar[XB_XSUB(b.x)], 1u);
        const unsigned gen = old / nloc;
        if (old + 1u == (gen + 1u) * nloc) {
            __builtin_amdgcn_fence(__ATOMIC_RELEASE, "agent");
            asm volatile("s_waitcnt vmcnt(0)" ::: "memory");
            const unsigned og = xb_add(&bar[XB_TOP], 1u);
            const unsigned tg = og / nx;
            if (og + 1u == (tg + 1u) * nx) xb_add(&bar[XB_TOPGEN], 1u);
            else XB_SPIN(xb_ld(&bar[XB_TOPGEN]) == tg, bar);
            __builtin_amdgcn_fence(__ATOMIC_ACQUIRE, "agent");
            xb_add(&bar[XB_XGEN(b.x)], 1u);
            asm volatile("s_waitcnt vmcnt(0)" ::: "memory");
        } else {
            XB_SPIN(xb_ld(&bar[XB_XGEN(b.x)]) == gen, bar);
            __builtin_amdgcn_fence(__ATOMIC_ACQUIRE, "agent");
            asm volatile("s_waitcnt vmcnt(0)" ::: "memory");
        }
    }
    __syncthreads();
}

__device__ __forceinline__ float wave_sum(float v) {
#pragma unroll
    for (int o = 1; o < 64; o <<= 1) v += __shfl_xor(v, o);
    return v;
}
__device__ __forceinline__ float grp16_sum(float v) {
#pragma unroll
    for (int o = 1; o < 16; o <<= 1) v += __shfl_xor(v, o);
    return v;
}
template <int CTRL> __device__ __forceinline__ float dpp_mov(float v) {
    return __builtin_bit_cast(float, __builtin_amdgcn_update_dpp(0, __builtin_bit_cast(int, v), CTRL, 0xF, 0xF, true));
}
__device__ __forceinline__ float grp8_sum(float v) {
    v += dpp_mov<0xB1>(v); v += dpp_mov<0x4E>(v); v += dpp_mov<0x141>(v); return v;
}

__device__ __forceinline__ void xpose_item(const float* W, int N, int col0, int nvalid, bf16* WT, int Kd, int drow0, LAS float* scr, int k0, int n0, int lane) {
    const int nn = n0 + (lane & 31); const bool ok = nn < nvalid;
#pragma unroll 8
    for (int i = 0; i < 32; ++i) { const int kk = 2 * i + (lane >> 5); scr[kk * 33 + (lane & 31)] = ok ? W[(size_t)(k0 + kk) * N + col0 + nn] : 0.f; }
    LDS_WAIT(); asm volatile("" ::: "memory");
    const int c = lane & 7;
#pragma unroll
    for (int j = 0; j < 4; ++j) { const int n = (lane >> 3) + 8 * j; const LAS float* s = scr + (8 * c) * 33 + n;
        v4u o; o.x = pk2(s[0 * 33], s[1 * 33]); o.y = pk2(s[2 * 33], s[3 * 33]); o.z = pk2(s[4 * 33], s[5 * 33]); o.w = pk2(s[6 * 33], s[7 * 33]);
        *(GAS v4u*)(WT + (size_t)(drow0 + n) * Kd + k0 + 8 * c) = o; }
    LDS_WAIT(); asm volatile("" ::: "memory");
}

struct Args { const float* in[19]; float* out; unsigned char* ws; };
enum { I_X = 0, I_MEM, I_FPRE, I_FPOST, I_MPRE, I_MPOST, I_MEMG, I_WG, I_WU, I_WD, I_WKV, I_WOUT, I_SCIN, I_SCCONV, I_GDNIN, I_GDNCONV, I_ALOG, I_DTB, I_NORMG };

__device__ __forceinline__ void norm_phase(int gw, int NGW, int lane, const bf16* outb, float w, const float* g_post, const float* hsrc, float* hdst, const float* g_pre, bf16* Adst) {
    for (int row = gw; row < MROWS; row += NGW) {
        const float* hr = hsrc + (size_t)row * DM;
        f32x4 hv[16];
#pragma unroll
        for (int j = 0; j < 8; ++j) { const int e = (j * 64 + lane) * 8; hv[2 * j] = *(const GAS f32x4*)(hr + e); hv[2 * j + 1] = *(const GAS f32x4*)(hr + e + 4); }
        if (outb) {
            v4u ov[8]; float ss = 0.f;
#pragma unroll
            for (int j = 0; j < 8; ++j) { ov[j] = *(const GAS v4u*)(outb + (size_t)row * DM + (j * 64 + lane) * 8);
#pragma unroll
                for (int q = 0; q < 4; ++q) { const float a = bflo(ov[j][q]), b = bfhi(ov[j][q]); ss += a * a + b * b; } }
            ss = wave_sum(ss);
            const float sc = w / sqrtf(ss * (1.0f / DM) + EPS);
#pragma unroll
            for (int j = 0; j < 8; ++j) { const int e = (j * 64 + lane) * 8;
                const f32x4 g0 = *(const GAS f32x4*)(g_post + e), g1 = *(const GAS f32x4*)(g_post + e + 4);
                f32x4 o0, o1; o0[0] = bflo(ov[j][0]); o0[1] = bfhi(ov[j][0]); o0[2] = bflo(ov[j][1]); o0[3] = bfhi(ov[j][1]);
                o1[0] = bflo(ov[j][2]); o1[1] = bfhi(ov[j][2]); o1[2] = bflo(ov[j][3]); o1[3] = bfhi(ov[j][3]);
                hv[2 * j] += o0 * g0 * sc; hv[2 * j + 1] += o1 * g1 * sc; }
        }
        if (hdst) { float* hw = hdst + (size_t)row * DM;
#pragma unroll
            for (int j = 0; j < 8; ++j) { const int e = (j * 64 + lane) * 8; *(GAS f32x4*)(hw + e) = hv[2 * j]; *(GAS f32x4*)(hw + e + 4) = hv[2 * j + 1]; } }
        if (Adst) {
            float ss = 0.f;
#pragma unroll
            for (int j = 0; j < 16; ++j) ss += (hv[j][0] * hv[j][0] + hv[j][1] * hv[j][1]) + (hv[j][2] * hv[j][2] + hv[j][3] * hv[j][3]);
            ss = wave_sum(ss);
            const float sc = 1.0f / sqrtf(ss * (1.0f / DM) + EPS);
#pragma unroll
            for (int j = 0; j < 8; ++j) { const int e = (j * 64 + lane) * 8;
                const f32x4 g0 = *(const GAS f32x4*)(g_pre + e), g1 = *(const GAS f32x4*)(g_pre + e + 4);
                const f32x4 a0 = hv[2 * j] * g0 * sc, a1 = hv[2 * j + 1] * g1 * sc;
                v4u o; o.x = pk2(a0[0], a0[1]); o.y = pk2(a0[2], a0[3]); o.z = pk2(a1[0], a1[1]); o.w = pk2(a1[2], a1[3]);
                *(GAS v4u*)(Adst + (size_t)row * DM + e) = o; }
        }
    }
}

__device__ __forceinline__ void xattn_unit(int unit, const bf16* proj, int ldp, int xq_col0, const bf16* Kb, const bf16* VTb, bf16* cat, int wave, int lane) {
    const int rb = unit & 15, h = (unit >> 4) & 3, b = unit >> 6;
    const int r0 = b * SEQ + rb * 128 + wave * 16, c15 = lane & 15, q4 = lane >> 4;
    bf16x8 qf[8];
    const bf16* qp = proj + (size_t)(r0 + c15) * ldp + xq_col0 + h * XHD + 8 * q4;
#pragma unroll
    for (int s = 0; s < 8; ++s) qf[s] = *(const GAS bf16x8*)(qp + 32 * s);
    f32x4 st[16];
    const bf16* kp = Kb + (size_t)(b * MEMT + c15) * 1024 + h * XHD + 8 * q4;
#pragma unroll
    for (int kb = 0; kb < 16; ++kb) { f32x4 acc = {0.f, 0.f, 0.f, 0.f};
#pragma unroll
        for (int s = 0; s < 8; ++s) { const bf16x8 kf = *(const GAS bf16x8*)(kp + (size_t)(16 * kb) * 1024 + 32 * s);
            acc = __builtin_amdgcn_mfma_f32_16x16x32_bf16(kf, qf[s], acc, 0, 0, 0); }
        st[kb] = acc; }
    float mx = -3.0e38f;
#pragma unroll
    for (int kb = 0; kb < 16; ++kb)
#pragma unroll
        for (int j = 0; j < 4; ++j) mx = fmaxf(mx, st[kb][j]);
    mx = fmaxf(mx, __shfl_xor(mx, 16)); mx = fmaxf(mx, __shfl_xor(mx, 32));
    const float sc = 0.0625f * 1.44269504089f; float sum = 0.f;
#pragma unroll
    for (int kb = 0; kb < 16; ++kb)
#pragma unroll
        for (int j = 0; j < 4; ++j) { const float p = __builtin_amdgcn_exp2f((st[kb][j] - mx) * sc); st[kb][j] = p; sum += p; }
    sum += __shfl_xor(sum, 16); sum += __shfl_xor(sum, 32);
    const float inv = 1.0f / sum;
    bf16x8 pf[8];
#pragma unroll
    for (int s = 0; s < 8; ++s) { v4u w; w.x = pk2(st[2 * s][0], st[2 * s][1]); w.y = pk2(st[2 * s][2], st[2 * s][3]); w.z = pk2(st[2 * s + 1][0], st[2 * s + 1][1]); w.w = pk2(st[2 * s + 1][2], st[2 * s + 1][3]);
        pf[s] = __builtin_bit_cast(bf16x8, w); }
    const bf16* vp = VTb + (size_t)(h * XHD + c15) * 1024 + b * MEMT + 4 * q4;
    bf16* op = cat + (size_t)(r0 + c15) * DM + MIXW + h * XHD + 4 * q4;
#pragma unroll 4
    for (int db = 0; db < 16; ++db) { f32x4 acc = {0.f, 0.f, 0.f, 0.f};
#pragma unroll
        for (int s = 0; s < 8; ++s) { const v2u lo = *(const GAS v2u*)(vp + (size_t)(16 * db) * 1024 + 32 * s), hi = *(const GAS v2u*)(vp + (size_t)(16 * db) * 1024 + 32 * s + 16);
            v4u w; w.x = lo.x; w.y = lo.y; w.z = hi.x; w.w = hi.y;
            acc = __builtin_amdgcn_mfma_f32_16x16x32_bf16(__builtin_bit_cast(bf16x8, w), pf[s], acc, 0, 0, 0); }
        v2u o; o.x = pk2(acc[0] * inv, acc[1] * inv); o.y = pk2(acc[2] * inv, acc[3] * inv);
        *(GAS v2u*)(op + 16 * db) = o; }
}

__device__ __forceinline__ void sc_gate_phase(int gw, int NGW, int lane, const bf16* proj, const float* convw, bf16* cat) {
    for (int task = gw; task < (MROWS / 16) * 6; task += NGW) {
        const int row0 = (task / 6) * 16, c = (task % 6) * 512 + lane * 8;
        float cw[3][8];
#pragma unroll
        for (int j = 0; j < 3; ++j) { const f32x4 a = *(const GAS f32x4*)(convw + j * MIXW + c), b = *(const GAS f32x4*)(convw + j * MIXW + c + 4);
            cw[j][0] = a[0]; cw[j][1] = a[1]; cw[j][2] = a[2]; cw[j][3] = a[3]; cw[j][4] = b[0]; cw[j][5] = b[1]; cw[j][6] = b[2]; cw[j][7] = b[3]; }
        float u2[8], u1[8];
#pragma unroll
        for (int e = 0; e < 8; ++e) { u2[e] = 0.f; u1[e] = 0.f; }
        if ((row0 % SEQ) != 0) {
#pragma unroll
            for (int hrow = 0; hrow < 2; ++hrow) { const bf16* pr = proj + (size_t)(row0 - 2 + hrow) * SC_IN + c;
                const v4u cv = *(const GAS v4u*)(pr + MIXW), hv = *(const GAS v4u*)(pr + 2 * MIXW);
#pragma unroll
                for (int q = 0; q < 4; ++q) { const float a = bflo(cv[q]) * bflo(hv[q]), b = bfhi(cv[q]) * bfhi(hv[q]);
                    if (hrow == 0) { u2[2 * q] = a; u2[2 * q + 1] = b; } else { u1[2 * q] = a; u1[2 * q + 1] = b; } } }
        }
#pragma unroll 4
        for (int r = 0; r < 16; ++r) { const bf16* pr = proj + (size_t)(row0 + r) * SC_IN + c;
            const v4u bv = *(const GAS v4u*)(pr), cv = *(const GAS v4u*)(pr + MIXW), hv = *(const GAS v4u*)(pr + 2 * MIXW);
            float u0[8], y[8];
#pragma unroll
            for (int q = 0; q < 4; ++q) { u0[2 * q] = bflo(cv[q]) * bflo(hv[q]); u0[2 * q + 1] = bfhi(cv[q]) * bfhi(hv[q]); }
#pragma unroll
            for (int q = 0; q < 4; ++q) {
                y[2 * q] = bflo(bv[q]) * (cw[0][2 * q] * u2[2 * q] + cw[1][2 * q] * u1[2 * q] + cw[2][2 * q] * u0[2 * q]);
                y[2 * q + 1] = bfhi(bv[q]) * (cw[0][2 * q + 1] * u2[2 * q + 1] + cw[1][2 * q + 1] * u1[2 * q + 1] + cw[2][2 * q + 1] * u0[2 * q + 1]); }
            v4u o; o.x = pk2(y[0], y[1]); o.y = pk2(y[2], y[3]); o.z = pk2(y[4], y[5]); o.w = pk2(y[6], y[7]);
            *(GAS v4u*)(cat + (size_t)(row0 + r) * DM + c) = o;
#pragma unroll
            for (int e = 0; e < 8; ++e) { u2[e] = u1[e]; u1[e] = u0[e]; } }
    }
}

__device__ __forceinline__ void gdn_prep_phase(int gw, int NGW, int lane, const bf16* proj, const float* convw, bf16* qkvn, const float* aux, const float* alog, const float* dtb, float* ab) {
    for (int task = gw; task < (MROWS / 16) * 18; task += NGW) {
        const int row0 = (task / 18) * 16, slot = (task % 18) * 4 + (lane >> 4), type = slot / GH, ch = slot * GHD + (lane & 15) * 8;
        float cw[4][8];
#pragma unroll
        for (int j = 0; j < 4; ++j) { const f32x4 a = *(const GAS f32x4*)(convw + j * (3 * MIXW) + ch), b = *(const GAS f32x4*)(convw + j * (3 * MIXW) + ch + 4);
            cw[j][0] = a[0]; cw[j][1] = a[1]; cw[j][2] = a[2]; cw[j][3] = a[3]; cw[j][4] = b[0]; cw[j][5] = b[1]; cw[j][6] = b[2]; cw[j][7] = b[3]; }
        float w0[8], w1[8], w2[8];
#pragma unroll
        for (int e = 0; e < 8; ++e) { w0[e] = 0.f; w1[e] = 0.f; w2[e] = 0.f; }
        if ((row0 % SEQ) != 0) {
#pragma unroll
            for (int hrow = 0; hrow < 3; ++hrow) { const v4u xv = *(const GAS v4u*)(proj + (size_t)(row0 - 3 + hrow) * GDN_LD + ch);
#pragma unroll
                for (int q = 0; q < 4; ++q) { const float a = bflo(xv[q]), b = bfhi(xv[q]);
                    if (hrow == 0) { w0[2 * q] = a; w0[2 * q + 1] = b; } else if (hrow == 1) { w1[2 * q] = a; w1[2 * q + 1] = b; } else { w2[2 * q] = a; w2[2 * q + 1] = b; } } }
        }
        const float post = (type == 0) ? 0.08838834764831845f : 1.0f;
#pragma unroll 4
        for (int r = 0; r < 16; ++r) { const v4u xv = *(const GAS v4u*)(proj + (size_t)(row0 + r) * GDN_LD + ch);
            float x[8], y[8]; float ss = 0.f;
#pragma unroll
            for (int q = 0; q < 4; ++q) { x[2 * q] = bflo(xv[q]); x[2 * q + 1] = bfhi(xv[q]); }
#pragma unroll
            for (int e = 0; e < 8; ++e) { const float v = cw[0][e] * w0[e] + cw[1][e] * w1[e] + cw[2][e] * w2[e] + cw[3][e] * x[e]; y[e] = silu_f(v); ss += y[e] * y[e]; }
            if (type < 2) { ss = grp16_sum(ss); const float sc = post / sqrtf(ss + EPS);
#pragma unroll
                for (int e = 0; e < 8; ++e) y[e] *= sc; }
            v4u o; o.x = pk2(y[0], y[1]); o.y = pk2(y[2], y[3]); o.z = pk2(y[4], y[5]); o.w = pk2(y[6], y[7]);
            *(GAS v4u*)(qkvn + (size_t)(row0 + r) * (3 * MIXW) + ch) = o;
#pragma unroll
            for (int e = 0; e < 8; ++e) { w0[e] = w1[e]; w1[e] = w2[e]; w2[e] = x[e]; } }
    }
    for (int idx = gw * 64 + lane; idx < MROWS * GH; idx += NGW * 64) { const int row = idx / GH, h = idx % GH;
        const float bi = aux[(size_t)row * 64 + h], ai = aux[(size_t)row * 64 + GH + h] + dtb[h];
        const float sp = ai > 20.f ? ai : log1pf(expf(ai));
        ab[(size_t)row * 48 + h] = 1.0f / (1.0f + expf(-bi));
        ab[(size_t)row * 48 + GH + h] = expf(-expf(alog[h]) * sp); }
}

constexpr int SCAN_T = 32, SCAN_QK_LD = 264, SCAN_BUF_FLOATS = SCAN_T * SCAN_QK_LD + SCAN_T * 64 + SCAN_T * 2;
__device__ __forceinline__ void gdn_scan_unit(int unit, LAS unsigned char* ldsb, const bf16* qkvn, const float* ab, float* O, int tid, int wave, int lane) {
    const int bh = unit >> 1, half = unit & 1, b = bh / GH, h = bh % GH;
    const int s = lane & 7, colL = wave * 8 + (lane >> 3), jc = half * 64 + colL;
    LAS float* buf0 = (LAS float*)ldsb;
    float S[16];
#pragma unroll
    for (int i = 0; i < 16; ++i) S[i] = 0.f;
    const int t_a = tid >> 5, cc_a = tid & 31;
    const size_t rowbase = (size_t)b * SEQ;
    v4u rq0, rq1, rv; float rbd = 0.f;
    rq0 = (v4u){0u, 0u, 0u, 0u}; rq1 = rq0; rv = rq0;
#define SCAN_ISSUE(cidx) do { \
        const size_t r0_ = rowbase + (size_t)(cidx) * SCAN_T; \
        const int coff_ = (cc_a < 16) ? (h * GHD + cc_a * 8) : (MIXW + h * GHD + (cc_a - 16) * 8); \
        rq0 = *(const GAS v4u*)(qkvn + (r0_ + t_a) * (size_t)(3 * MIXW) + coff_); \
        rq1 = *(const GAS v4u*)(qkvn + (r0_ + t_a + 16) * (size_t)(3 * MIXW) + coff_); \
        if (tid < 256) rv = *(const GAS v4u*)(qkvn + (r0_ + (tid >> 3)) * (size_t)(3 * MIXW) + 2 * MIXW + h * GHD + half * 64 + (tid & 7) * 8); \
        else if (tid < 320) { const int t_ = (tid - 256) >> 1, which_ = tid & 1; rbd = ab[(r0_ + t_) * 48 + which_ * GH + h]; } \
    } while (0)
    SCAN_ISSUE(0);
    for (int c = 0; c < SEQ / SCAN_T; ++c) {
        LAS float* buf = buf0 + (c & 1) * SCAN_BUF_FLOATS;
        {
            LAS float* d0 = buf + t_a * SCAN_QK_LD + ((cc_a < 16) ? cc_a * 8 : 128 + (cc_a - 16) * 8);
            LAS float* d1 = d0 + 16 * SCAN_QK_LD;
            *(LAS f32x4*)(d0) = (f32x4){bflo(rq0[0]), bfhi(rq0[0]), bflo(rq0[1]), bfhi(rq0[1])}; *(LAS f32x4*)(d0 + 4) = (f32x4){bflo(rq0[2]), bfhi(rq0[2]), bflo(rq0[3]), bfhi(rq0[3])};
            *(LAS f32x4*)(d1) = (f32x4){bflo(rq1[0]), bfhi(rq1[0]), bflo(rq1[1]), bfhi(rq1[1])}; *(LAS f32x4*)(d1 + 4) = (f32x4){bflo(rq1[2]), bfhi(rq1[2]), bflo(rq1[3]), bfhi(rq1[3])};
            if (tid < 256) { LAS float* dv = buf + SCAN_T * SCAN_QK_LD + (tid >> 3) * 64 + (tid & 7) * 8;
                *(LAS f32x4*)(dv) = (f32x4){bflo(rv[0]), bfhi(rv[0]), bflo(rv[1]), bfhi(rv[1])}; *(LAS f32x4*)(dv + 4) = (f32x4){bflo(rv[2]), bfhi(rv[2]), bflo(rv[3]), bfhi(rv[3])}; }
            else if (tid < 320) buf[SCAN_T * SCAN_QK_LD + SCAN_T * 64 + (tid - 256)] = rbd;
        }
        __syncthreads();
        if (c + 1 < SEQ / SCAN_T) SCAN_ISSUE(c + 1);
        const LAS float* vb = buf + SCAN_T * SCAN_QK_LD; const LAS float* bd = vb + SCAN_T * 64;
        float* orow = O + (rowbase + (size_t)c * SCAN_T) * MIXW + h * GHD + jc;
#pragma unroll 2
        for (int t = 0; t < SCAN_T; ++t) {
            const LAS float* qk = buf + t * SCAN_QK_LD + 16 * s;
            f32x4 kk[4], qq[4];
#pragma unroll
            for (int i = 0; i < 4; ++i) { kk[i] = *(const LAS f32x4*)(qk + 128 + 4 * i); qq[i] = *(const LAS f32x4*)(qk + 4 * i); }
            const float v = vb[t * 64 + colL], beta = bd[2 * t], a = bd[2 * t + 1];
            float ks0 = 0.f, ks1 = 0.f;
#pragma unroll
            for (int i = 0; i < 4; ++i) { ks0 += kk[i][0] * S[4 * i] + kk[i][2] * S[4 * i + 2]; ks1 += kk[i][1] * S[4 * i + 1] + kk[i][3] * S[4 * i + 3]; }
            const float kS = grp8_sum(ks0 + ks1);
            const float cc = beta * (v - a * kS);
            float o0 = 0.f, o1 = 0.f;
#pragma unroll
            for (int i = 0; i < 4; ++i) {
                S[4 * i] = a * S[4 * i] + kk[i][0] * cc; S[4 * i + 1] = a * S[4 * i + 1] + kk[i][1] * cc; S[4 * i + 2] = a * S[4 * i + 2] + kk[i][2] * cc; S[4 * i + 3] = a * S[4 * i + 3] + kk[i][3] * cc;
                o0 += qq[i][0] * S[4 * i] + qq[i][2] * S[4 * i + 2]; o1 += qq[i][1] * S[4 * i + 1] + qq[i][3] * S[4 * i + 3]; }
            const float o = grp8_sum(o0 + o1);
            if (s == 0) orow[(size_t)t * MIXW] = o;
        }
    }
    __syncthreads();
#undef SCAN_ISSUE
}

__device__ __forceinline__ void gdn_out_phase(int gw, int NGW, int lane, const float* O, const bf16* proj, const float* normg, bf16* cat) {
    const int dl = (lane & 15) * 8;
    const f32x4 g0 = *(const GAS f32x4*)(normg + dl), g1 = *(const GAS f32x4*)(normg + dl + 4);
    for (int row = gw; row < MROWS; row += NGW) {
#pragma unroll 2
        for (int it = 0; it < 6; ++it) { const int ch = (it * 4 + (lane >> 4)) * GHD + dl;
            const f32x4 o0 = *(const GAS f32x4*)(O + (size_t)row * MIXW + ch), o1 = *(const GAS f32x4*)(O + (size_t)row * MIXW + ch + 4);
            const v4u zv = *(const GAS v4u*)(proj + (size_t)row * GDN_LD + 3 * MIXW + ch);
            float ss = (o0[0] * o0[0] + o0[1] * o0[1]) + (o0[2] * o0[2] + o0[3] * o0[3]) + (o1[0] * o1[0] + o1[1] * o1[1]) + (o1[2] * o1[2] + o1[3] * o1[3]);
            ss = grp16_sum(ss);
            const float r = 1.0f / sqrtf(ss * (1.0f / GHD) + EPS);
            float y[8];
            y[0] = o0[0] * r * g0[0] * silu_f(bflo(zv[0])); y[1] = o0[1] * r * g0[1] * silu_f(bfhi(zv[0])); y[2] = o0[2] * r * g0[2] * silu_f(bflo(zv[1])); y[3] = o0[3] * r * g0[3] * silu_f(bfhi(zv[1]));
            y[4] = o1[0] * r * g1[0] * silu_f(bflo(zv[2])); y[5] = o1[1] * r * g1[1] * silu_f(bfhi(zv[2])); y[6] = o1[2] * r * g1[2] * silu_f(bflo(zv[3])); y[7] = o1[3] * r * g1[3] * silu_f(bfhi(zv[3]));
            v4u w; w.x = pk2(y[0], y[1]); w.y = pk2(y[2], y[3]); w.z = pk2(y[4], y[5]); w.w = pk2(y[6], y[7]);
            *(GAS v4u*)(cat + (size_t)row * DM + ch) = w; }
    }
}

__device__ __forceinline__ int opq_v(int x) { asm volatile("" : "+v"(x)); return x; }
__device__ __forceinline__ int opq_s(int x) { asm volatile("" : "+s"(x)); return x; }
typedef unsigned char* const __attribute__((address_space(4)))* karg_tab_t;
__device__ __forceinline__ unsigned char* karg_ptr(int i) { asm volatile("" : "+s"(i)); return ((karg_tab_t)__builtin_amdgcn_kernarg_segment_ptr())[i]; }
#define INP(i) ((const float*)karg_ptr(i))
#define WSP(off) (karg_ptr(20) + (off))

__global__ void __launch_bounds__(NWAVES * 64, 2) fwd_kernel(Args args) {
    extern __shared__ __attribute__((aligned(16))) unsigned char lds[];
    LAS unsigned char* L = (LAS unsigned char*)lds;
    volatile LAS unsigned* MISC = (volatile LAS unsigned*)(L + MISC_OFF);
    const int tid0 = threadIdx.x;
    const int G = gridDim.x, c = blockIdx.x;
#define tid (opq_v(tid0))
#define lane (opq_v(tid0) & 63)
#define wave (__builtin_amdgcn_readfirstlane(opq_v(tid0) >> 6))
#define gw (opq_s(c) * NWAVES + __builtin_amdgcn_readfirstlane(opq_v(tid0) >> 6))
#define NGW (opq_s(G) * NWAVES)
    for (int u = tid0; u < (LDS_BYTES - LDSCTL_OFF) / 4; u += NWAVES * 64) ((LAS unsigned*)(L + LDSCTL_OFF))[u] = 0u;
    __syncthreads();
    (void)xcd_barrier_post((unsigned*)(WSP(WS_CTL)) + CW_BAR, MISC + 8);
#define GRID_BAR() do { XcdBarrier bar_; bar_.bar = (unsigned*)(WSP(WS_CTL)) + CW_BAR; bar_.x = xb_xcc_id(); bar_.st = MISC + 8; xcd_barrier(bar_); } while (0)
#ifdef NO_P0
#define PH_P0(x)
#else
#define PH_P0(x) x
#endif
#ifdef NO_KV
#define PH_KV(x)
#else
#define PH_KV(x) x
#endif
#ifdef NO_GU
#define PH_GU(x)
#else
#define PH_GU(x) x
#endif
#ifdef NO_DN
#define PH_DN(x)
#else
#define PH_DN(x) x
#endif
#ifdef NO_NORM
#define PH_NORM(x)
#else
#define PH_NORM(x) x
#endif
#ifdef NO_SCIN
#define PH_SCIN(x)
#else
#define PH_SCIN(x) x
#endif
#ifdef NO_SCG
#define PH_SCG(x)
#else
#define PH_SCG(x) x
#endif
#ifdef NO_XA
#define PH_XA(x)
#else
#define PH_XA(x) x
#endif
#ifdef NO_GDNIN
#define PH_GDNIN(x)
#else
#define PH_GDNIN(x) x
#endif
#ifdef NO_PREP
#define PH_PREP(x)
#else
#define PH_PREP(x) x
#endif
#ifdef NO_GOUT
#define PH_GOUT(x)
#else
#define PH_GOUT(x) x
#endif
#ifdef NO_WOUT
#define PH_WOUT(x)
#else
#define PH_WOUT(x) x
#endif
#ifdef NO_SCAN
#define DO_SCAN(x)
#else
#define DO_SCAN(x) x
#endif

#define Hbuf ((float*)WSP(WS_H))
#define Abuf ((bf16*)WSP(WS_A))
#define OUTb ((bf16*)WSP(WS_OUT))
#define CAT ((bf16*)WSP(WS_CAT))
#define ACT ((bf16*)WSP(WS_ACT))
#define PROJ ((bf16*)WSP(WS_PROJ))
#define AUX ((float*)WSP(WS_AUX))
#define AB ((float*)WSP(WS_AB))
#define QKVN ((bf16*)WSP(WS_QKV))
#define OBUF ((float*)WSP(WS_O))
#define KVOPS ((bf16*)WSP(WS_KVOPS))
#define KB ((bf16*)WSP(WS_KB))
#define VTB ((bf16*)WSP(WS_VTB))
#define WGU ((bf16*)WSP(WS_WGU))
#define WDN ((bf16*)WSP(WS_WDN))
#define WOUT ((bf16*)WSP(WS_WOUT))
#define WSC ((bf16*)WSP(WS_WSC))
#define WGDN ((bf16*)WSP(WS_WGDN))

#ifndef NO_P0
    {
        LAS float* scr = (LAS float*)(L + RING_OFF + wave * 16384);
        long base = 0;
        for (int job = 0; job < 40; ++job) {
            const float* W; bf16* WT; int K, N, col0 = 0, ncols, nvalid, mode = 0, roff = 0;
            if (job < 8)       { W = INP(I_WG) + (size_t)job * DM * DFF; K = DM; N = DFF; ncols = DFF; WT = WGU + (size_t)job * 2 * DFF * DM; mode = 1; roff = 0; }
            else if (job < 16) { W = INP(I_WU) + (size_t)(job - 8) * DM * DFF; K = DM; N = DFF; ncols = DFF; WT = WGU + (size_t)(job - 8) * 2 * DFF * DM; mode = 1; roff = 128; }
            else if (job < 24) { W = INP(I_WD) + (size_t)(job - 16) * DFF * DM; K = DFF; N = DM; ncols = DM; WT = WDN + (size_t)(job - 16) * DM * DFF; }
            else if (job < 28) { W = INP(I_WOUT) + (size_t)(job - 24) * DM * DM; K = DM; N = DM; ncols = DM; WT = WOUT + (size_t)(job - 24) * DM * DM; }
            else if (job < 32) { W = INP(I_WKV) + (size_t)(job - 28) * DM * 2 * XW; K = DM; N = 2 * XW; ncols = 2 * XW; WT = KVOPS + ((size_t)(job - 28) * 3072 + 1024) * DM; }
            else if (job < 34) { W = INP(I_SCIN) + (size_t)(job - 32) * DM * SC_IN; K = DM; N = SC_IN; ncols = SC_IN; WT = WSC + (size_t)(job - 32) * SC_IN * DM; }
            else if (job < 36) { W = INP(I_GDNIN) + (size_t)(job - 34) * DM * GDN_SRC; K = DM; N = GDN_SRC; ncols = 4 * MIXW; WT = WGDN + (size_t)(job - 34) * GDN_N * DM; }
            else if (job < 38) { W = INP(I_GDNIN) + (size_t)(job - 36) * DM * GDN_SRC; K = DM; N = GDN_SRC; col0 = 4 * MIXW + 2 * GH; ncols = XW; WT = WGDN + (size_t)(job - 36) * GDN_N * DM; roff = 4 * MIXW; }
            else               { W = INP(I_GDNIN) + (size_t)(job - 38) * DM * GDN_SRC; K = DM; N = GDN_SRC; col0 = 4 * MIXW; ncols = 64; WT = WGDN + (size_t)(job - 38) * GDN_N * DM; roff = GDN_LD; }
            nvalid = (job >= 38) ? 2 * GH : ncols;
            const int nblk = ncols / 32, items = (K / 64) * nblk;
            int first = (int)(((long)gw - base) % NGW); if (first < 0) first += NGW;
            for (int it = first; it < items; it += NGW) {
                const int kb = it / nblk, nb = it % nblk;
                const int drow0 = mode ? (256 * (nb >> 2) + 32 * (nb & 3) + roff) : (32 * nb + roff);
                xpose_item(W, N, col0, nvalid, WT, K, drow0, scr, 64 * kb, 32 * nb, lane);
            }
            base += items;
        }
        for (int r = gw; r < 2 * 192; r += NGW) { bf16* p = WGDN + ((size_t)(r / 192) * GDN_N + GDN_LD + 64 + (r % 192)) * DM;
#pragma unroll
            for (int j = 0; j < 8; ++j) *(GAS v4u*)(p + (j * 64 + lane) * 8) = (v4u){0u, 0u, 0u, 0u}; }
        for (int r = gw; r < NBATCH * MEMT; r += NGW) { const float* mr = INP(I_MEM) + (size_t)r * DM;
            f32x4 v[16]; float ss = 0.f;
#pragma unroll
            for (int j = 0; j < 16; ++j) { v[j] = *(const GAS f32x4*)(mr + (j * 64 + lane) * 4); ss += (v[j][0] * v[j][0] + v[j][1] * v[j][1]) + (v[j][2] * v[j][2] + v[j][3] * v[j][3]); }
            ss = wave_sum(ss); const float sc = 1.0f / sqrtf(ss * (1.0f / DM) + EPS);
            for (int l = 0; l < DEPTH; ++l) { const float* g = INP(I_MEMG) + (size_t)l * DM; bf16* dst = KVOPS + ((size_t)l * 3072 + r) * DM;
#pragma unroll
                for (int j = 0; j < 16; ++j) { const f32x4 gg = *(const GAS f32x4*)(g + (j * 64 + lane) * 4); const f32x4 a = v[j] * gg * sc;
                    v2u o; o.x = pk2(a[0], a[1]); o.y = pk2(a[2], a[3]); *(GAS v2u*)(dst + (j * 64 + lane) * 4) = o; } } }
        norm_phase(gw, NGW, lane, nullptr, 0.f, nullptr, INP(I_X), Hbuf, INP(I_FPRE), Abuf);
    }
#endif
    GRID_BAR();

    {
        pg8::Gemm g{KVOPS, KVOPS, 4 * 3072, 4 * 3072, DM}; pg8::KvOrder S{G, c}; pg8::EpiKV E{KB, VTB};
        PH_KV((pg8::gemm_phase<pg8::EpiKV, pg8::KvOrder, PG8_ALIGN, PG8_SP2>(L + RING_OFF, g, S, E)));
    }

#define FFN_GEMMS(f_) do { \
        { pg8::Gemm g{Abuf, WGU + (size_t)(l * 2 + (f_)) * 2 * DFF * DM, MROWS, 2 * DFF, DM}; pg8::StaticOrder S; S.init(MROWS, 2 * DFF, G, c); pg8::EpiSwiGLU E{ACT, DFF}; \
          PH_GU((pg8::gemm_phase<pg8::EpiSwiGLU, pg8::StaticOrder, PG8_ALIGN, PG8_SP2>(L + RING_OFF, g, S, E))); } \
        GRID_BAR(); \
        { pg8::Gemm g{ACT, WDN + (size_t)(l * 2 + (f_)) * DM * DFF, MROWS, DM, DFF}; pg8::StaticOrder S; S.init(MROWS, DM, G, c); pg8::EpiProj E{OUTb, DM, nullptr, -1}; \
          PH_DN((pg8::gemm_phase<pg8::EpiProj, pg8::StaticOrder, PG8_ALIGN, PG8_SP2>(L + RING_OFF, g, S, E))); } \
        GRID_BAR(); \
    } while (0)

    for (int l = 0; l < DEPTH; ++l) {
        const int j2 = l >> 1; const bool gdn = (l & 1) != 0;
        FFN_GEMMS(0);
        PH_NORM(norm_phase(gw, NGW, lane, OUTb, 0.5f, INP(I_FPOST) + (size_t)(l * 2) * DM, Hbuf, Hbuf, INP(I_MPRE) + (size_t)l * DM, Abuf);)
        GRID_BAR();
        if (!gdn) {
            { pg8::Gemm g{Abuf, WSC + (size_t)j2 * SC_IN * DM, MROWS, SC_IN, DM}; pg8::StaticOrder S; S.init(MROWS, SC_IN, G, c); pg8::EpiProj E{PROJ, SC_IN, nullptr, -1};
              PH_SCIN((pg8::gemm_phase<pg8::EpiProj, pg8::StaticOrder, PG8_ALIGN, PG8_SP2>(L + RING_OFF, g, S, E))); }
            GRID_BAR();
            PH_SCG(sc_gate_phase(gw, NGW, lane, PROJ, INP(I_SCCONV) + (size_t)j2 * 3 * MIXW, CAT);)
            for (int u = c; u < 256; u += G) { PH_XA(xattn_unit(u, PROJ, SC_IN, 3 * MIXW, KB + (size_t)l * 1048576, VTB + (size_t)l * 1048576, CAT, wave, lane);) }
            GRID_BAR();
        } else {
            { pg8::Gemm g{Abuf, WGDN + (size_t)j2 * GDN_N * DM, MROWS, GDN_N, DM}; pg8::StaticOrder S; S.init(MROWS, GDN_N, G, c); pg8::EpiProj E{PROJ, GDN_LD, AUX, GDN_LD / 256};
              PH_GDNIN((pg8::gemm_phase<pg8::EpiProj, pg8::StaticOrder, PG8_ALIGN, PG8_SP2>(L + RING_OFF, g, S, E))); }
            GRID_BAR();
            PH_PREP(gdn_prep_phase(gw, NGW, lane, PROJ, INP(I_GDNCONV) + (size_t)j2 * 4 * 3 * MIXW, QKVN, AUX, INP(I_ALOG) + j2 * GH, INP(I_DTB) + j2 * GH, AB);)
            GRID_BAR();
            {
                const int nscan = NBATCH * GH * 2;
                if (G > nscan) {
                    if (c < nscan) { DO_SCAN(gdn_scan_unit(c, L + RING_OFF, QKVN, AB, OBUF, tid, wave, lane)); }
                    else for (int u = c - nscan; u < 256; u += G - nscan) { PH_XA(xattn_unit(u, PROJ, GDN_LD, 4 * MIXW, KB + (size_t)l * 1048576, VTB + (size_t)l * 1048576, CAT, wave, lane);) }
                } else {
                    for (int u = c; u < nscan; u += G) { DO_SCAN(gdn_scan_unit(u, L + RING_OFF, QKVN, AB, OBUF, tid, wave, lane)); }
                    for (int u = c; u < 256; u += G) { PH_XA(xattn_unit(u, PROJ, GDN_LD, 4 * MIXW, KB + (size_t)l * 1048576, VTB + (size_t)l * 1048576, CAT, wave, lane);) }
                }
            }
            GRID_BAR();
            PH_GOUT(gdn_out_phase(gw, NGW, lane, OBUF, PROJ, INP(I_NORMG) + j2 * GHD, CAT);)
            GRID_BAR();
        }
        { pg8::Gemm g{CAT, WOUT + (size_t)l * DM * DM, MROWS, DM, DM}; pg8::StaticOrder S; S.init(MROWS, DM, G, c); pg8::EpiProj E{OUTb, DM, nullptr, -1};
          PH_WOUT((pg8::gemm_phase<pg8::EpiProj, pg8::StaticOrder, PG8_ALIGN, PG8_SP2>(L + RING_OFF, g, S, E))); }
        GRID_BAR();
        PH_NORM(norm_phase(gw, NGW, lane, OUTb, 1.0f, INP(I_MPOST) + (size_t)l * DM, Hbuf, Hbuf, INP(I_FPRE) + (size_t)(l * 2 + 1) * DM, Abuf);)
        GRID_BAR();
        FFN_GEMMS(1);
        if (l < DEPTH - 1) {
            PH_NORM(norm_phase(gw, NGW, lane, OUTb, 0.5f, INP(I_FPOST) + (size_t)(l * 2 + 1) * DM, Hbuf, Hbuf, INP(I_FPRE) + (size_t)((l + 1) * 2) * DM, Abuf);)
            GRID_BAR();
        } else {
            PH_NORM(norm_phase(gw, NGW, lane, OUTb, 0.5f, INP(I_FPOST) + (size_t)(l * 2 + 1) * DM, Hbuf, ((float*)karg_ptr(19)), nullptr, nullptr);)
        }
    }
#undef FFN_GEMMS
#undef GRID_BAR
#undef tid
#undef lane
#undef wave
#undef gw
#undef NGW
}

extern "C" void kernel_launch(void* const* d_in, const int* in_sizes, int n_in, void* d_out, int out_size, void* d_ws, size_t ws_size, hipStream_t stream) {
    static int grid = 0;
    if (grid == 0) {
        if (n_in != 19 || in_sizes[0] != MROWS * DM || out_size != MROWS * DM || ws_size < WS_END) {
            fprintf(stderr, "kernel_launch: unexpected problem (n_in %d, in0 %d, out %d, ws %zu, need %zu); nothing launched\n", n_in, n_in > 0 ? in_sizes[0] : -1, out_size, ws_size, (size_t)WS_END); grid = -1; return; }
        int dev = 0, cus = 0, per_cu = 0;
        if (hipGetDevice(&dev) != hipSuccess || hipDeviceGetAttribute(&cus, hipDeviceAttributeMultiprocessorCount, dev) != hipSuccess) { fprintf(stderr, "kernel_launch: device query failed\n"); grid = -1; return; }
        if (hipFuncSetAttribute((const void*)fwd_kernel, hipFuncAttributeMaxDynamicSharedMemorySize, LDS_BYTES) != hipSuccess) { fprintf(stderr, "kernel_launch: hipFuncSetAttribute failed\n"); grid = -1; return; }
        if (hipOccupancyMaxActiveBlocksPerMultiprocessor(&per_cu, (const void*)fwd_kernel, NWAVES * 64, LDS_BYTES) != hipSuccess || per_cu < 1)
            fprintf(stderr, "kernel_launch: note: occupancy query reports %d workgroups per CU\n", per_cu);
        (void)hipGetLastError();
        grid = cus;
    }
    if (grid < 0) return;
    if (hipMemsetAsync((char*)d_ws + WS_CTL, 0, CTL_ZERO_BYTES, stream) != hipSuccess) { fprintf(stderr, "kernel_launch: memset failed\n"); return; }
    Args a{};
    for (int i = 0; i < 19; ++i) a.in[i] = (const float*)d_in[i];
    a.out = (float*)d_out; a.ws = (unsigned char*)d_ws;
    hipLaunchKernelGGL(fwd_kernel, dim3(grid), dim3(NWAVES * 64), LDS_BYTES, stream, a);
    const hipError_t le = hipPeekAtLastError();
    if (le != hipSuccess) fprintf(stderr, "kernel_launch: launch failed: %s\n", hipGetErrorName(le));
}
```

```cpp
#include <hip/hip_runtime.h>
#include <cstdio>
#include <cstdint>
namespace pg8 {
#define PG8_LAS __attribute__((address_space(3)))
typedef unsigned short bf16_t;
typedef short bf16x8 __attribute__((ext_vector_type(8)));
typedef float f32x4 __attribute__((ext_vector_type(4)));
typedef unsigned u32x4 __attribute__((ext_vector_type(4)));
constexpr int BM = 256, BK = 64, HALF = 128, HTB = HALF * BK * 2  , STAGE_BYTES = 8 * HTB, NXCD = 8, WGM = 8;

__host__ __device__ __forceinline__ int lds_byte(int r, int c) { const int st = (r >> 4) * 2 + (c >> 5), rr = r & 15, cc = c & 31, ob = rr * 64 + cc * 2; return st * 1024 + (ob ^ (((ob >> 9) & 1) << 5)); }
__host__ __device__ __forceinline__ void stage_rc(int b, int& R, int& C) { const int st = b / 1024, sb = b % 1024, swz = sb ^ (((sb >> 9) & 1) << 5); R = (st >> 1) * 16 + swz / 64; C = (st & 1) * 32 + (swz % 64) / 2; }
__host__ __device__ __forceinline__ int perm32(int rho) { const int n = rho >> 4, i = rho & 15; return 8 * (i >> 2) + 4 * n + (i & 3); }

struct Unit { int pm, pn; };
struct Gemm { const bf16_t* A; const bf16_t* Bt; int M, N, K; };

struct StaticOrder {
    int nM, nN, nwg, G, c;
    __host__ __device__ void init(int M, int N, int G_, int c_) { nM = M / BM; nN = N / BM; nwg = nM * nN; G = G_; c = c_; }
    __host__ __device__ bool next(int i, Unit& u) const {
        const long L = (long)i * G + c; if (L >= nwg) return false;
        int wgid = (int)L; { const int q = nwg / NXCD, r = nwg % NXCD, xcd = wgid % NXCD, off = wgid / NXCD; wgid = (xcd < r ? xcd * (q + 1) : r * (q + 1) + (xcd - r) * q) + off; }
        const int nig = WGM * nN, gid = wgid / nig, fm = gid * WGM, gsz = (nM - fm) < WGM ? (nM - fm) : WGM;
        u.pm = fm + ((wgid % nig) % gsz); u.pn = (wgid % nig) / gsz; return true;
    }
    __device__ __forceinline__ void a_ready(const Unit&) const {}
    __device__ __forceinline__ void done(const Unit&) const {}
};

__device__ __forceinline__ unsigned cvt_pk_bf16(float lo, float hi) { unsigned r; asm volatile("v_cvt_pk_bf16_f32 %0, %1, %2" : "=v"(r) : "v"(lo), "v"(hi)); return r; }

struct EpiProj {
    static constexpr bool PERM = true, AFTER_DRAIN = false;
    bf16_t* O; int ldc; float* aux; int aux_pn;
    __device__ __forceinline__ void operator()(const f32x4 (&acc)[2][2][4][2], const Unit& u, int wr, int wc, int fr, int fq) const {
        const int row0 = u.pm * BM + wr * 64 + fr;
        if (u.pn == aux_pn) {
            if (wc < 2) {
#pragma unroll
                for (int ai = 0; ai < 2; ++ai)
#pragma unroll
                    for (int m = 0; m < 4; ++m) { float* rowp = aux + (size_t)(row0 + ai * HALF + m * 16) * 64 + wc * 32 + 8 * fq;
                        *(f32x4*)(rowp) = acc[ai][0][m][0]; *(f32x4*)(rowp + 4) = acc[ai][0][m][1]; }
            }
            return;
        }
        const int col0 = u.pn * BM + wc * 32 + 8 * fq;
#pragma unroll
        for (int ai = 0; ai < 2; ++ai)
#pragma unroll
            for (int m = 0; m < 4; ++m) { bf16_t* rowp = O + (size_t)(row0 + ai * HALF + m * 16) * ldc + col0;
#pragma unroll
                for (int bj = 0; bj < 2; ++bj) { const f32x4 v0 = acc[ai][bj][m][0], v1 = acc[ai][bj][m][1];
                    u32x4 w; w.x = cvt_pk_bf16(v0[0], v0[1]); w.y = cvt_pk_bf16(v0[2], v0[3]); w.z = cvt_pk_bf16(v1[0], v1[1]); w.w = cvt_pk_bf16(v1[2], v1[3]);
                    *(u32x4*)(rowp + bj * HALF) = w; } }
    }
};
struct EpiSwiGLU {
    static constexpr bool PERM = true, AFTER_DRAIN = false;
    bf16_t* O; int ldc;
    __device__ __forceinline__ void operator()(const f32x4 (&acc)[2][2][4][2], const Unit& u, int wr, int wc, int fr, int fq) const {
        const int row0 = u.pm * BM + wr * 64 + fr, col0 = u.pn * HALF + wc * 32 + 8 * fq;
#pragma unroll
        for (int ai = 0; ai < 2; ++ai)
#pragma unroll
            for (int m = 0; m < 4; ++m) { bf16_t* rowp = O + (size_t)(row0 + ai * HALF + m * 16) * ldc + col0;
                f32x4 r[2];
#pragma unroll
                for (int n = 0; n < 2; ++n)
#pragma unroll
                    for (int j = 0; j < 4; ++j) { const float g = acc[ai][0][m][n][j], up = acc[ai][1][m][n][j];
                        r[n][j] = g * up * __builtin_amdgcn_rcpf(1.0f + __builtin_amdgcn_exp2f(g * -1.44269504089f)); }
                u32x4 w; w.x = cvt_pk_bf16(r[0][0], r[0][1]); w.y = cvt_pk_bf16(r[0][2], r[0][3]); w.z = cvt_pk_bf16(r[1][0], r[1][1]); w.w = cvt_pk_bf16(r[1][2], r[1][3]);
                *(u32x4*)(rowp) = w; }
    }
};
struct EpiKV {
    static constexpr bool PERM = true, AFTER_DRAIN = false;
    bf16_t* Kb; bf16_t* VTb;
    __device__ __forceinline__ void operator()(const f32x4 (&acc)[2][2][4][2], const Unit& u, int wr, int wc, int fr, int fq) const {
        const int l = u.pm / 12, ri = u.pm % 12, rj = u.pn % 12;
        bf16_t* base = (ri < 4) ? Kb + (size_t)l * 1048576 + (size_t)(ri * 256) * 1024 + (rj - 4) * 256
                                : VTb + (size_t)l * 1048576 + (size_t)((ri - 8) * 256) * 1024 + rj * 256;
        const int row0 = wr * 64 + fr, col0 = wc * 32 + 8 * fq;
#pragma unroll
        for (int ai = 0; ai < 2; ++ai)
#pragma unroll
            for (int m = 0; m < 4; ++m) { bf16_t* rowp = base + (size_t)(row0 + ai * HALF + m * 16) * 1024 + col0;
#pragma unroll
                for (int bj = 0; bj < 2; ++bj) { const f32x4 v0 = acc[ai][bj][m][0], v1 = acc[ai][bj][m][1];
                    u32x4 w; w.x = cvt_pk_bf16(v0[0], v0[1]); w.y = cvt_pk_bf16(v0[2], v0[3]); w.z = cvt_pk_bf16(v1[0], v1[1]); w.w = cvt_pk_bf16(v1[2], v1[3]);
                    *(u32x4*)(rowp + bj * HALF) = w; } }
    }
};
struct KvOrder {
    int G, c;
    __device__ __forceinline__ bool next(int i, Unit& u) const {
        const int L = i * G + c; if (L >= 128) return false;
        const int l = L >> 5, r = L & 31;
        if (r < 16) { u.pm = 12 * l + (r >> 2); u.pn = 12 * l + 4 + (r & 3); }
        else { u.pm = 12 * l + 8 + ((r - 16) >> 2); u.pn = 12 * l + (r & 3); }
        return true;
    }
    __device__ __forceinline__ void a_ready(const Unit&) const {}
    __device__ __forceinline__ void done(const Unit&) const {}
};

template <class Epi, class Sched, bool ALIGN_EPI = false, bool SP2 = false>
__device__ __forceinline__ void gemm_phase(PG8_LAS unsigned char* lds, const Gemm g, const Sched& S, const Epi& E) {
    int tid_o = threadIdx.x; asm volatile("" : "+v"(tid_o));
    const int tid = tid_o, wid = __builtin_amdgcn_readfirstlane(tid >> 6), lane = tid & 63, wr = wid >> 2, wc = wid & 3, fr = lane & 15, fq = lane >> 4;
    const int K = g.K, nt = K / BK;
    unsigned voffA[2], voffB[2];
#pragma unroll
    for (int i = 0; i < 2; ++i) { int R, C; stage_rc(tid * 16 + i * 8192, R, C); const int Rb = Epi::PERM ? ((R & ~31) + perm32(R & 31)) : R;
        voffA[i] = (unsigned)(R * K + C) * 2u; voffB[i] = (unsigned)(Rb * K + C) * 2u; }
    const size_t kstep = (size_t)(BK * 2);
    const size_t hstep = (size_t)HALF * K * 2;
    const size_t tstep = 2 * hstep;
    const unsigned ldsw = (unsigned)wid * 1024u;
    const int aoff = lds_byte(wr * 64 + fr, fq * 8), boff = lds_byte(wc * 32 + fr, fq * 8);
#define PG8_SA(b, h) (((b) * 2 + (h)) * HTB)
#define PG8_SB(b, h) ((4 + (b) * 2 + (h)) * HTB)
#define PG8_STAGE(bufoff, gbase, voff) do { _Pragma("unroll") for (int _i = 0; _i < 2; ++_i) \
        __builtin_amdgcn_global_load_lds((const unsigned*)((const char*)(gbase) + (voff)[_i]), (PG8_LAS unsigned*)(lds + (bufoff) + ldsw + _i * 8192), 16, 0, 0); } while (0)
#define PG8_LDA(dst, b, h) do { _Pragma("unroll") for (int m = 0; m < 4; ++m) _Pragma("unroll") for (int k = 0; k < 2; ++k) dst[m][k] = *(const PG8_LAS bf16x8*)(lds + PG8_SA(b, h) + aoff + m * 2048 + k * 1024); } while (0)
#define PG8_LDB(dst, b, h) do { _Pragma("unroll") for (int n = 0; n < 2; ++n) _Pragma("unroll") for (int k = 0; k < 2; ++k) dst[n][k] = *(const PG8_LAS bf16x8*)(lds + PG8_SB(b, h) + boff + n * 2048 + k * 1024); } while (0)
#define PG8_MMA(ai, bj, At, Bt) do { __builtin_amdgcn_s_setprio(1); _Pragma("unroll") for (int m = 0; m < 4; ++m) _Pragma("unroll") for (int n = 0; n < 2; ++n) _Pragma("unroll") for (int k = 0; k < 2; ++k) \
        acc[ai][bj][m][n] = __builtin_amdgcn_mfma_f32_16x16x32_bf16(Bt[n][k], At[m][k], acc[ai][bj][m][n], 0, 0, 0); __builtin_amdgcn_s_setprio(0); } while (0)
#define PG8_WAIT_V(n) asm volatile("s_waitcnt vmcnt(" #n ")" ::: "memory")
#define PG8_WAIT_L(n) asm volatile("s_waitcnt lgkmcnt(" #n ")" ::: "memory")
#define PG8_BAR __builtin_amdgcn_s_barrier()
#define PG8_SCHED __builtin_amdgcn_sched_barrier(0)
    Unit cur, nxt; int ui = 0;
    if (!S.next(0, cur)) return;
    f32x4 acc[2][2][4][2];
#pragma unroll
    for (int a = 0; a < 2; ++a)
#pragma unroll
        for (int b = 0; b < 2; ++b)
#pragma unroll
            for (int m = 0; m < 4; ++m)
#pragma unroll
                for (int n = 0; n < 2; ++n) acc[a][b][m][n] = (f32x4){0.f, 0.f, 0.f, 0.f};
    bf16x8 At[4][2], B0[2][2], B1[2][2];
    const char* cA = (const char*)g.A + (size_t)cur.pm * tstep; const char* cB = (const char*)g.Bt + (size_t)cur.pn * tstep;
    S.a_ready(cur);
    if constexpr (SP2) {
        PG8_STAGE(PG8_SB(0, 0), cB, voffB); PG8_STAGE(PG8_SB(0, 1), cB + hstep, voffB); PG8_STAGE(PG8_SA(0, 0), cA, voffA); PG8_STAGE(PG8_SA(0, 1), cA + hstep, voffA);
        if (wr == 1) PG8_BAR;
        PG8_WAIT_V(2); PG8_BAR;
        PG8_STAGE(PG8_SB(1, 0), cB + kstep, voffB); PG8_STAGE(PG8_SA(1, 0), cA + kstep, voffA); PG8_STAGE(PG8_SB(1, 1), cB + hstep + kstep, voffB);
        PG8_WAIT_V(6); PG8_BAR;
    } else {
        PG8_STAGE(PG8_SB(0, 0), cB, voffB); PG8_STAGE(PG8_SA(0, 0), cA, voffA); PG8_STAGE(PG8_SB(0, 1), cB + hstep, voffB); PG8_STAGE(PG8_SA(0, 1), cA + hstep, voffA);
        if (wr == 1) PG8_BAR;
        PG8_WAIT_V(4); PG8_BAR;
        PG8_STAGE(PG8_SB(1, 0), cB + kstep, voffB); PG8_STAGE(PG8_SA(1, 0), cA + kstep, voffA); PG8_STAGE(PG8_SB(1, 1), cB + hstep + kstep, voffB);
        PG8_WAIT_V(6); PG8_BAR;
    }
    for (;;) {
        const bool has_next = S.next(ui + 1, nxt);
        const char* nA = has_next ? (const char*)g.A + (size_t)nxt.pm * tstep : cA; const char* nB = has_next ? (const char*)g.Bt + (size_t)nxt.pn * tstep : cB;
        for (int t = 0; t < nt; t += 2) {
            const bool last = (t == nt - 2);
            const char* a1 = cA + (size_t)(t + 1) * kstep;
            const char* a2 = last ? nA : cA + (size_t)(t + 2) * kstep; const char* b2 = last ? nB : cB + (size_t)(t + 2) * kstep;
            const char* a3 = a2 + kstep; const char* b3 = b2 + kstep;
            if (last && has_next) S.a_ready(nxt);
            if constexpr (SP2) {
            PG8_LDB(B0, 0, 0); PG8_LDB(B1, 0, 1); PG8_SCHED; PG8_LDA(At, 0, 0); PG8_STAGE(PG8_SA(1, 1), a1 + hstep, voffA);
            PG8_WAIT_V(8); PG8_WAIT_L(0); PG8_BAR; PG8_MMA(0, 0, At, B0); PG8_MMA(0, 1, At, B1); PG8_BAR; PG8_SCHED;
            PG8_LDA(At, 0, 1); PG8_STAGE(PG8_SB(0, 0), b2, voffB); PG8_STAGE(PG8_SB(0, 1), b2 + hstep, voffB); PG8_STAGE(PG8_SA(0, 0), a2, voffA);
            PG8_WAIT_V(8); PG8_WAIT_L(0); PG8_BAR; PG8_MMA(1, 0, At, B0); PG8_MMA(1, 1, At, B1); PG8_BAR; PG8_SCHED;
            PG8_LDB(B0, 1, 0); PG8_LDB(B1, 1, 1); PG8_SCHED; PG8_LDA(At, 1, 0); PG8_STAGE(PG8_SA(0, 1), a2 + hstep, voffA);
            PG8_WAIT_V(8); PG8_WAIT_L(0); PG8_BAR; PG8_MMA(0, 0, At, B0); PG8_MMA(0, 1, At, B1); PG8_BAR; PG8_SCHED;
            PG8_LDA(At, 1, 1); PG8_STAGE(PG8_SB(1, 0), b3, voffB); PG8_STAGE(PG8_SB(1, 1), b3 + hstep, voffB); PG8_STAGE(PG8_SA(1, 0), a3, voffA);
            PG8_WAIT_V(8); PG8_WAIT_L(0); PG8_BAR; PG8_MMA(1, 0, At, B0); PG8_MMA(1, 1, At, B1); PG8_BAR; PG8_SCHED;
            } else {
            PG8_LDB(B0, 0, 0); PG8_SCHED; PG8_LDA(At, 0, 0); PG8_STAGE(PG8_SA(1, 1), a1 + hstep, voffA);
            PG8_WAIT_L(8); PG8_BAR; PG8_WAIT_L(0); PG8_MMA(0, 0, At, B0); PG8_BAR; PG8_SCHED;
            PG8_LDB(B1, 0, 1); PG8_STAGE(PG8_SB(0, 0), b2, voffB);
            PG8_BAR; PG8_WAIT_L(0); PG8_MMA(0, 1, At, B1); PG8_BAR;
            PG8_LDA(At, 0, 1); PG8_STAGE(PG8_SA(0, 0), a2, voffA);
            PG8_BAR; PG8_WAIT_L(0); PG8_MMA(1, 0, At, B0); PG8_BAR; PG8_SCHED;
            PG8_STAGE(PG8_SB(0, 1), b2 + hstep, voffB);
            PG8_WAIT_V(6); PG8_BAR; PG8_MMA(1, 1, At, B1); PG8_BAR;
            PG8_LDB(B0, 1, 0); PG8_SCHED; PG8_LDA(At, 1, 0); PG8_STAGE(PG8_SA(0, 1), a2 + hstep, voffA);
            PG8_WAIT_L(8); PG8_BAR; PG8_WAIT_L(0); PG8_MMA(0, 0, At, B0); PG8_BAR; PG8_SCHED;
            PG8_LDB(B1, 1, 1); PG8_STAGE(PG8_SB(1, 0), b3, voffB);
            PG8_BAR; PG8_WAIT_L(0); PG8_MMA(0, 1, At, B1); PG8_BAR;
            PG8_LDA(At, 1, 1); PG8_STAGE(PG8_SA(1, 0), a3, voffA);
            PG8_BAR; PG8_WAIT_L(0); PG8_MMA(1, 0, At, B0); PG8_BAR; PG8_SCHED;
            PG8_STAGE(PG8_SB(1, 1), b3 + hstep, voffB);
            PG8_WAIT_V(6); PG8_BAR; PG8_MMA(1, 1, At, B1); PG8_BAR;
            }
        }
        if constexpr (ALIGN_EPI) { if (wr == 0) PG8_BAR; }
        if constexpr (!Epi::AFTER_DRAIN) { E(acc, cur, wr, wc, fr, fq); S.done(cur); }
        if (!has_next) break;
#pragma unroll
        for (int a = 0; a < 2; ++a)
#pragma unroll
            for (int b = 0; b < 2; ++b)
#pragma unroll
                for (int m = 0; m < 4; ++m)
#pragma unroll
                    for (int n = 0; n < 2; ++n) acc[a][b][m][n] = (f32x4){0.f, 0.f, 0.f, 0.f};
        cur = nxt; cA = nA; cB = nB; ++ui;
        if constexpr (ALIGN_EPI) { if (wr == 1) PG8_BAR; }
    }
    PG8_WAIT_V(0);
    if constexpr (!ALIGN_EPI) { if (wr == 0) PG8_BAR; }
    PG8_BAR;
    if constexpr (Epi::AFTER_DRAIN) { E.fused(acc, cur, wr, wc, fr, fq, lds, wid, lane); S.done(cur); }
#undef PG8_SA
#undef PG8_SB
#undef PG8_STAGE
#undef PG8_LDA
#undef PG8_LDB
#undef PG8_MMA
#undef PG8_WAIT_V
#undef PG8_WAIT_L
#undef PG8_BAR
#undef PG8_SCHED
}
}

#ifndef PG8_SP2
#define PG8_SP2 true
#endif
#ifndef PG8_ALIGN
#define PG8_ALIGN true
#endif

constexpr int NWAVES = 8;
constexpr int DM = 4096, NBATCH = 4, SEQ = 2048, MROWS = NBATCH * SEQ, DEPTH = 4;
constexpr int MEMT = 256, XH = 4, XW = 1024, XHD = 256, MIXW = 3072, DFF = 6144;
constexpr int GH = 24, GHD = 128;
constexpr int SC_IN = 3 * MIXW + XW;
constexpr int GDN_SRC = 4 * MIXW + 2 * GH + XW;
constexpr int GDN_LD = 4 * MIXW + XW;
constexpr int GDN_N = GDN_LD + 256;
constexpr float EPS = 1e-6f;

constexpr size_t MiB = 1u << 20;
constexpr size_t WS_CTL = 0, CTL_ZERO_BYTES = 1 * MiB;
constexpr size_t WS_H = 1 * MiB;
constexpr size_t WS_A = WS_H + 128 * MiB;
constexpr size_t WS_OUT = WS_A + 64 * MiB;
constexpr size_t WS_CAT = WS_OUT + 64 * MiB;
constexpr size_t WS_ACT = WS_CAT + 64 * MiB;
constexpr size_t WS_PROJ = WS_ACT + 96 * MiB;
constexpr size_t WS_AUX = WS_PROJ + 208 * MiB;
constexpr size_t WS_AB = WS_AUX + 2 * MiB;
constexpr size_t WS_QKV = WS_AB + 2 * MiB;
constexpr size_t WS_O = WS_QKV + 144 * MiB;
constexpr size_t WS_KVOPS = WS_O + 96 * MiB;
constexpr size_t WS_KB = WS_KVOPS + 96 * MiB;
constexpr size_t WS_VTB = WS_KB + 8 * MiB;
constexpr size_t WS_WGU = WS_VTB + 8 * MiB;
constexpr size_t WS_WDN = WS_WGU + 768 * MiB;
constexpr size_t WS_WOUT = WS_WDN + 384 * MiB;
constexpr size_t WS_WSC = WS_WOUT + 128 * MiB;
constexpr size_t WS_WGDN = WS_WSC + 160 * MiB;
constexpr size_t WS_END = WS_WGDN + 212 * MiB;
constexpr int CW_BAR = 4096;

constexpr int RING_OFF = 0, RING_BYTES = 131072;
constexpr int XP_SCR = 64 * 65 * 4;
constexpr int LDSCTL_OFF = 8 * XP_SCR, MISC_OFF = LDSCTL_OFF + 320;
static_assert(LDSCTL_OFF >= RING_BYTES, "LDS map");
constexpr int LDS_BYTES = 147456;

#define GAS __attribute__((address_space(1)))
#define LAS __attribute__((address_space(3)))
typedef unsigned short bf16;
typedef unsigned v4u __attribute__((ext_vector_type(4)));
typedef unsigned v2u __attribute__((ext_vector_type(2)));
typedef float f32x4 __attribute__((ext_vector_type(4)));
typedef float f32x2 __attribute__((ext_vector_type(2)));
typedef short bf16x8 __attribute__((ext_vector_type(8)));
#define LDS_WAIT() asm volatile("s_waitcnt lgkmcnt(0)" ::: "memory")
#define VM_WAIT() asm volatile("s_waitcnt vmcnt(0)" ::: "memory")
__device__ __forceinline__ unsigned pk2(float lo, float hi) { return pg8::cvt_pk_bf16(lo, hi); }
__device__ __forceinline__ float bflo(unsigned u) { return __uint_as_float(u << 16); }
__device__ __forceinline__ float bfhi(unsigned u) { return __uint_as_float(u & 0xffff0000u); }
__device__ __forceinline__ float silu_f(float x) { return x * __builtin_amdgcn_rcpf(1.0f + __builtin_amdgcn_exp2f(x * -1.44269504089f)); }

#define XB_TMO      128
#define XB_XCNT(j)  (256  + 64 * (j))
#define XB_XSUB(j)  (1280 + 64 * (j))
#define XB_XGEN(j)  (2304 + 64 * (j))
#define XB_TOP      3328
#define XB_TOPGEN   3392
#define XCD_BAR_WORDS 3456
#define XB_SPIN_CAP (1u << 18)

__device__ __forceinline__ unsigned xb_ld(unsigned* p)              { return __hip_atomic_load(p, __ATOMIC_RELAXED, __HIP_MEMORY_SCOPE_AGENT); }
__device__ __forceinline__ unsigned xb_add(unsigned* p, unsigned v) { return __hip_atomic_fetch_add(p, v, __ATOMIC_RELAXED, __HIP_MEMORY_SCOPE_AGENT); }
__device__ __forceinline__ unsigned xb_xcc_id() { return (unsigned)__builtin_amdgcn_s_getreg((3 << 11) | 20) & 0xFu; }
#define XB_SPIN(cond, bar) do { unsigned _sp = 0; while (cond) { __builtin_amdgcn_s_sleep(1); \
    if ((++_sp & 255u) == 0u) { if (xb_ld(&(bar)[XB_TMO])) break; if (_sp > XB_SPIN_CAP) { atomicAdd(&(bar)[XB_TMO], 1u); break; } } } } while (0)

struct XcdBarrier {
    unsigned* bar; unsigned x;
    volatile LAS unsigned* st;
};
__device__ __forceinline__ XcdBarrier xcd_barrier_post(unsigned* bar, volatile LAS unsigned* st) {
    XcdBarrier b; b.bar = bar; b.x = xb_xcc_id(); b.st = st;
    if (threadIdx.x == 0) (void)xb_add(&bar[XB_XCNT(b.x)], 1u);
    return b;
}
__device__ __forceinline__ void xcd_barrier_complete(unsigned* bar, unsigned x, unsigned& nloc, unsigned& nx) {
    const unsigned G = gridDim.x * gridDim.y * gridDim.z;
    unsigned sum, cnt, mine, sp = 0u;
    for (;;) {
        sum = 0u; cnt = 0u; mine = 0u;
#pragma unroll
        for (unsigned j = 0; j < 16; ++j) { const unsigned c = xb_ld(&bar[XB_XCNT(j)]); sum += c; cnt += (c > 0u) ? 1u : 0u; mine = (j == x) ? c : mine; }
        if (sum == G) break;
        __builtin_amdgcn_s_sleep(1);
        if ((++sp & 255u) == 0u) { if (xb_ld(&bar[XB_TMO])) break; if (sp > XB_SPIN_CAP) { atomicAdd(&bar[XB_TMO], 1u); break; } }
    }
    nloc = mine > 0u ? mine : 1u; nx = cnt > 0u ? cnt : 1u;
}
__device__ __forceinline__ void xcd_barrier(const XcdBarrier& b) {
    asm volatile("s_waitcnt vmcnt(0)" ::: "memory");
    __syncthreads();
    if (threadIdx.x == 0) {
        unsigned* bar = b.bar;
        __builtin_amdgcn_s_waitcnt(0);
        unsigned nloc = b.st[0], nx = b.st[1];
        if (nloc == 0u) { xcd_barrier_complete(bar, b.x, nloc, nx); b.st[0] = nloc; b.st[1] = nx; }
        const unsigned old = xb_add(&bar[XB_XSUB(b.x)], 1u);
        const unsigned gen = old / nloc;
        if (old + 1u == (gen + 1u) * nloc) {
            __builtin_amdgcn_fence(__ATOMIC_RELEASE, "agent");
            asm volatile("s_waitcnt vmcnt(0)" ::: "memory");
            const unsigned og = xb_add(&bar[XB_TOP], 1u);
            const unsigned tg = og / nx;
            if (og + 1u == (tg + 1u) * nx) xb_add(&bar[XB_TOPGEN], 1u);
            else XB_SPIN(xb_ld(&bar[XB_TOPGEN]) == tg, bar);
            __builtin_amdgcn_fence(__ATOMIC_ACQUIRE, "agent");
            xb_add(&bar[XB_XGEN(b.x)], 1u);
            asm volatile("s_waitcnt vmcnt(0)" ::: "memory");
        } else {
            XB_SPIN(xb_ld(&bar[XB_XGEN(b.x)]) == gen, bar);
            __builtin_amdgcn_fence(__ATOMIC_ACQUIRE, "agent");
            asm volatile("s_waitcnt vmcnt(0)" ::: "memory");
        }
    }
    __syncthreads();
}

__device__ __forceinline__ float wave_sum(float v) {
#pragma unroll
    for (int o = 1; o < 64; o <<= 1) v += __shfl_xor(v, o);
    return v;
}
__device__ __forceinline__ float grp16_sum(float v) {
#pragma unroll
    for (int o = 1; o < 16; o <<= 1) v += __shfl_xor(v, o);
    return v;
}
template <int CTRL> __device__ __forceinline__ float dpp_mov(float v) {
    return __builtin_bit_cast(float, __builtin_amdgcn_update_dpp(0, __builtin_bit_cast(int, v), CTRL, 0xF, 0xF, true));
}
__device__ __forceinline__ float grp8_sum(float v) {
    v += dpp_mov<0xB1>(v); v += dpp_mov<0x4E>(v); v += dpp_mov<0x141>(v); return v;
}

__device__ __forceinline__ void xpose_load(f32x4 (&v)[16], const float* W, int N, int col0, int nvalid, int k0, int n0, int lane) {
    const int nn = n0 + 4 * (lane & 15); const bool ok = nn < nvalid;
    const float* p = W + (size_t)(k0 + (lane >> 4)) * N + col0 + nn;
#pragma unroll
    for (int i = 0; i < 16; ++i) v[i] = ok ? __builtin_nontemporal_load((const GAS f32x4*)(p + (size_t)(4 * i) * N)) : (f32x4){0.f, 0.f, 0.f, 0.f};
}
__device__ __forceinline__ void xpose_store(const f32x4 (&v)[16], bf16* WT, int Kd, int drow0, LAS float* scr, int k0, int lane) {
    LAS float* w = scr + (lane >> 4) * 65 + 4 * (lane & 15);
#pragma unroll
    for (int i = 0; i < 16; ++i) { w[(4 * i) * 65 + 0] = v[i][0]; w[(4 * i) * 65 + 1] = v[i][1]; w[(4 * i) * 65 + 2] = v[i][2]; w[(4 * i) * 65 + 3] = v[i][3]; }
    LDS_WAIT(); asm volatile("" ::: "memory");
    const int c = lane & 7;
#pragma unroll
    for (int j = 0; j < 8; ++j) { const int n = (lane >> 3) + 8 * j; const LAS float* s = scr + (8 * c) * 65 + n;
        v4u o; o.x = pk2(s[0 * 65], s[1 * 65]); o.y = pk2(s[2 * 65], s[3 * 65]); o.z = pk2(s[4 * 65], s[5 * 65]); o.w = pk2(s[6 * 65], s[7 * 65]);
        *(GAS v4u*)(WT + (size_t)(drow0 + n) * Kd + k0 + 8 * c) = o; }
    LDS_WAIT(); asm volatile("" ::: "memory");
}

struct Args { const float* in[19]; float* out; unsigned char* ws; };
enum { I_X = 0, I_MEM, I_FPRE, I_FPOST, I_MPRE, I_MPOST, I_MEMG, I_WG, I_WU, I_WD, I_WKV, I_WOUT, I_SCIN, I_SCCONV, I_GDNIN, I_GDNCONV, I_ALOG, I_DTB, I_NORMG };

__device__ __forceinline__ void norm_phase(int gw, int NGW, int lane, const bf16* outb, float w, const float* g_post, const float* hsrc, float* hdst, const float* g_pre, bf16* Adst) {
    for (int row = gw; row < MROWS; row += NGW) {
        const float* hr = hsrc + (size_t)row * DM;
        f32x4 hv[16];
#pragma unroll
        for (int j = 0; j < 8; ++j) { const int e = (j * 64 + lane) * 8; hv[2 * j] = *(const GAS f32x4*)(hr + e); hv[2 * j + 1] = *(const GAS f32x4*)(hr + e + 4); }
        if (outb) {
            v4u ov[8]; float ss = 0.f;
#pragma unroll
            for (int j = 0; j < 8; ++j) { ov[j] = *(const GAS v4u*)(outb + (size_t)row * DM + (j * 64 + lane) * 8);
#pragma unroll
                for (int q = 0; q < 4; ++q) { const float a = bflo(ov[j][q]), b = bfhi(ov[j][q]); ss += a * a + b * b; } }
            ss = wave_sum(ss);
            const float sc = w / sqrtf(ss * (1.0f / DM) + EPS);
#pragma unroll
            for (int j = 0; j < 8; ++j) { const int e = (j * 64 + lane) * 8;
                const f32x4 g0 = *(const GAS f32x4*)(g_post + e), g1 = *(const GAS f32x4*)(g_post + e + 4);
                f32x4 o0, o1; o0[0] = bflo(ov[j][0]); o0[1] = bfhi(ov[j][0]); o0[2] = bflo(ov[j][1]); o0[3] = bfhi(ov[j][1]);
                o1[0] = bflo(ov[j][2]); o1[1] = bfhi(ov[j][2]); o1[2] = bflo(ov[j][3]); o1[3] = bfhi(ov[j][3]);
                hv[2 * j] += o0 * g0 * sc; hv[2 * j + 1] += o1 * g1 * sc; }
        }
        if (hdst) { float* hw = hdst + (size_t)row * DM;
#pragma unroll
            for (int j = 0; j < 8; ++j) { const int e = (j * 64 + lane) * 8; *(GAS f32x4*)(hw + e) = hv[2 * j]; *(GAS f32x4*)(hw + e + 4) = hv[2 * j + 1]; } }
        if (Adst) {
            float ss = 0.f;
#pragma unroll
            for (int j = 0; j < 16; ++j) ss += (hv[j][0] * hv[j][0] + hv[j][1] * hv[j][1]) + (hv[j][2] * hv[j][2] + hv[j][3] * hv[j][3]);
            ss = wave_sum(ss);
            const float sc = 1.0f / sqrtf(ss * (1.0f / DM) + EPS);
#pragma unroll
            for (int j = 0; j < 8; ++j) { const int e = (j * 64 + lane) * 8;
                const f32x4 g0 = *(const GAS f32x4*)(g_pre + e), g1 = *(const GAS f32x4*)(g_pre + e + 4);
                const f32x4 a0 = hv[2 * j] * g0 * sc, a1 = hv[2 * j + 1] * g1 * sc;
                v4u o; o.x = pk2(a0[0], a0[1]); o.y = pk2(a0[2], a0[3]); o.z = pk2(a1[0], a1[1]); o.w = pk2(a1[2], a1[3]);
                *(GAS v4u*)(Adst + (size_t)row * DM + e) = o; }
        }
    }
}

__device__ __forceinline__ void xattn_unit(int unit, const bf16* proj, int ldp, int xq_col0, const bf16* Kb, const bf16* VTb, bf16* cat, int wave, int lane) {
    const int rb = unit & 15, h = (unit >> 4) & 3, b = unit >> 6;
    const int r0 = b * SEQ + rb * 128 + wave * 16, c15 = lane & 15, q4 = lane >> 4;
    bf16x8 qf[8];
    const bf16* qp = proj + (size_t)(r0 + c15) * ldp + xq_col0 + h * XHD + 8 * q4;
#pragma unroll
    for (int s = 0; s < 8; ++s) qf[s] = *(const GAS bf16x8*)(qp + 32 * s);
    f32x4 st[16];
    const bf16* kp = Kb + (size_t)(b * MEMT + c15) * 1024 + h * XHD + 8 * q4;
#pragma unroll
    for (int kb = 0; kb < 16; ++kb) { f32x4 acc = {0.f, 0.f, 0.f, 0.f};
#pragma unroll
        for (int s = 0; s < 8; ++s) { const bf16x8 kf = *(const GAS bf16x8*)(kp + (size_t)(16 * kb) * 1024 + 32 * s);
            acc = __builtin_amdgcn_mfma_f32_16x16x32_bf16(kf, qf[s], acc, 0, 0, 0); }
        st[kb] = acc; }
    float mx = -3.0e38f;
#pragma unroll
    for (int kb = 0; kb < 16; ++kb)
#pragma unroll
        for (int j = 0; j < 4; ++j) mx = fmaxf(mx, st[kb][j]);
    mx = fmaxf(mx, __shfl_xor(mx, 16)); mx = fmaxf(mx, __shfl_xor(mx, 32));
    const float sc = 0.0625f * 1.44269504089f; float sum = 0.f;
#pragma unroll
    for (int kb = 0; kb < 16; ++kb)
#pragma unroll
        for (int j = 0; j < 4; ++j) { const float p = __builtin_amdgcn_exp2f((st[kb][j] - mx) * sc); st[kb][j] = p; sum += p; }
    sum += __shfl_xor(sum, 16); sum += __shfl_xor(sum, 32);
    const float inv = 1.0f / sum;
    bf16x8 pf[8];
#pragma unroll
    for (int s = 0; s < 8; ++s) { v4u w; w.x = pk2(st[2 * s][0], st[2 * s][1]); w.y = pk2(st[2 * s][2], st[2 * s][3]); w.z = pk2(st[2 * s + 1][0], st[2 * s + 1][1]); w.w = pk2(st[2 * s + 1][2], st[2 * s + 1][3]);
        pf[s] = __builtin_bit_cast(bf16x8, w); }
    const bf16* vp = VTb + (size_t)(h * XHD + c15) * 1024 + b * MEMT + 4 * q4;
    bf16* op = cat + (size_t)(r0 + c15) * DM + MIXW + h * XHD + 4 * q4;
#pragma unroll 4
    for (int db = 0; db < 16; ++db) { f32x4 acc = {0.f, 0.f, 0.f, 0.f};
#pragma unroll
        for (int s = 0; s < 8; ++s) { const v2u lo = *(const GAS v2u*)(vp + (size_t)(16 * db) * 1024 + 32 * s), hi = *(const GAS v2u*)(vp + (size_t)(16 * db) * 1024 + 32 * s + 16);
            v4u w; w.x = lo.x; w.y = lo.y; w.z = hi.x; w.w = hi.y;
            acc = __builtin_amdgcn_mfma_f32_16x16x32_bf16(__builtin_bit_cast(bf16x8, w), pf[s], acc, 0, 0, 0); }
        v2u o; o.x = pk2(acc[0] * inv, acc[1] * inv); o.y = pk2(acc[2] * inv, acc[3] * inv);
        *(GAS v2u*)(op + 16 * db) = o; }
}

__device__ __forceinline__ void sc_gate_phase(int gw, int NGW, int lane, const bf16* proj, const float* convw, bf16* cat) {
    for (int task = gw; task < (MROWS / 16) * 6; task += NGW) {
        const int row0 = (task / 6) * 16, c = (task % 6) * 512 + lane * 8;
        float cw[3][8];
#pragma unroll
        for (int j = 0; j < 3; ++j) { const f32x4 a = *(const GAS f32x4*)(convw + j * MIXW + c), b = *(const GAS f32x4*)(convw + j * MIXW + c + 4);
            cw[j][0] = a[0]; cw[j][1] = a[1]; cw[j][2] = a[2]; cw[j][3] = a[3]; cw[j][4] = b[0]; cw[j][5] = b[1]; cw[j][6] = b[2]; cw[j][7] = b[3]; }
        float u2[8], u1[8];
#pragma unroll
        for (int e = 0; e < 8; ++e) { u2[e] = 0.f; u1[e] = 0.f; }
        if ((row0 % SEQ) != 0) {
#pragma unroll
            for (int hrow = 0; hrow < 2; ++hrow) { const bf16* pr = proj + (size_t)(row0 - 2 + hrow) * SC_IN + c;
                const v4u cv = *(const GAS v4u*)(pr + MIXW), hv = *(const GAS v4u*)(pr + 2 * MIXW);
#pragma unroll
                for (int q = 0; q < 4; ++q) { const float a = bflo(cv[q]) * bflo(hv[q]), b = bfhi(cv[q]) * bfhi(hv[q]);
                    if (hrow == 0) { u2[2 * q] = a; u2[2 * q + 1] = b; } else { u1[2 * q] = a; u1[2 * q + 1] = b; } } }
        }
#pragma unroll 4
        for (int r = 0; r < 16; ++r) { const bf16* pr = proj + (size_t)(row0 + r) * SC_IN + c;
            const v4u bv = *(const GAS v4u*)(pr), cv = *(const GAS v4u*)(pr + MIXW), hv = *(const GAS v4u*)(pr + 2 * MIXW);
            float u0[8], y[8];
#pragma unroll
            for (int q = 0; q < 4; ++q) { u0[2 * q] = bflo(cv[q]) * bflo(hv[q]); u0[2 * q + 1] = bfhi(cv[q]) * bfhi(hv[q]); }
#pragma unroll
            for (int q = 0; q < 4; ++q) {
                y[2 * q] = bflo(bv[q]) * (cw[0][2 * q] * u2[2 * q] + cw[1][2 * q] * u1[2 * q] + cw[2][2 * q] * u0[2 * q]);
                y[2 * q + 1] = bfhi(bv[q]) * (cw[0][2 * q + 1] * u2[2 * q + 1] + cw[1][2 * q + 1] * u1[2 * q + 1] + cw[2][2 * q + 1] * u0[2 * q + 1]); }
            v4u o; o.x = pk2(y[0], y[1]); o.y = pk2(y[2], y[3]); o.z = pk2(y[4], y[5]); o.w = pk2(y[6], y[7]);
            *(GAS v4u*)(cat + (size_t)(row0 + r) * DM + c) = o;
#pragma unroll
            for (int e = 0; e < 8; ++e) { u2[e] = u1[e]; u1[e] = u0[e]; } }
    }
}

__device__ __forceinline__ void gdn_prep_phase(int gw, int NGW, int lane, const bf16* proj, const float* convw, bf16* qkvn, const float* aux, const float* alog, const float* dtb, float* ab) {
    for (int task = gw; task < (MROWS / 16) * 18; task += NGW) {
        const int row0 = (task / 18) * 16, slot = (task % 18) * 4 + (lane >> 4), type = slot / GH, ch = slot * GHD + (lane & 15) * 8;
        float cw[4][8];
#pragma unroll
        for (int j = 0; j < 4; ++j) { const f32x4 a = *(const GAS f32x4*)(convw + j * (3 * MIXW) + ch), b = *(const GAS f32x4*)(convw + j * (3 * MIXW) + ch + 4);
            cw[j][0] = a[0]; cw[j][1] = a[1]; cw[j][2] = a[2]; cw[j][3] = a[3]; cw[j][4] = b[0]; cw[j][5] = b[1]; cw[j][6] = b[2]; cw[j][7] = b[3]; }
        float w0[8], w1[8], w2[8];
#pragma unroll
        for (int e = 0; e < 8; ++e) { w0[e] = 0.f; w1[e] = 0.f; w2[e] = 0.f; }
        if ((row0 % SEQ) != 0) {
#pragma unroll
            for (int hrow = 0; hrow < 3; ++hrow) { const v4u xv = *(const GAS v4u*)(proj + (size_t)(row0 - 3 + hrow) * GDN_LD + ch);
#pragma unroll
                for (int q = 0; q < 4; ++q) { const float a = bflo(xv[q]), b = bfhi(xv[q]);
                    if (hrow == 0) { w0[2 * q] = a; w0[2 * q + 1] = b; } else if (hrow == 1) { w1[2 * q] = a; w1[2 * q + 1] = b; } else { w2[2 * q] = a; w2[2 * q + 1] = b; } } }
        }
        const float post = (type == 0) ? 0.08838834764831845f : 1.0f;
#pragma unroll 4
        for (int r = 0; r < 16; ++r) { const v4u xv = *(const GAS v4u*)(proj + (size_t)(row0 + r) * GDN_LD + ch);
            float x[8], y[8]; float ss = 0.f;
#pragma unroll
            for (int q = 0; q < 4; ++q) { x[2 * q] = bflo(xv[q]); x[2 * q + 1] = bfhi(xv[q]); }
#pragma unroll
            for (int e = 0; e < 8; ++e) { const float v = cw[0][e] * w0[e] + cw[1][e] * w1[e] + cw[2][e] * w2[e] + cw[3][e] * x[e]; y[e] = silu_f(v); ss += y[e] * y[e]; }
            if (type < 2) { ss = grp16_sum(ss); const float sc = post / sqrtf(ss + EPS);
#pragma unroll
                for (int e = 0; e < 8; ++e) y[e] *= sc; }
            v4u o; o.x = pk2(y[0], y[1]); o.y = pk2(y[2], y[3]); o.z = pk2(y[4], y[5]); o.w = pk2(y[6], y[7]);
            *(GAS v4u*)(qkvn + (size_t)(row0 + r) * (3 * MIXW) + ch) = o;
#pragma unroll
            for (int e = 0; e < 8; ++e) { w0[e] = w1[e]; w1[e] = w2[e]; w2[e] = x[e]; } }
    }
    for (int idx = gw * 64 + lane; idx < MROWS * GH; idx += NGW * 64) { const int row = idx / GH, h = idx % GH;
        const float bi = aux[(size_t)row * 64 + h], ai = aux[(size_t)row * 64 + GH + h] + dtb[h];
        const float sp = ai > 20.f ? ai : log1pf(expf(ai));
        ab[(size_t)row * 48 + h] = 1.0f / (1.0f + expf(-bi));
        ab[(size_t)row * 48 + GH + h] = expf(-expf(alog[h]) * sp); }
}

constexpr int SCAN_T = 32, SCAN_QK_LD = 264, SCAN_BUF_FLOATS = SCAN_T * SCAN_QK_LD + SCAN_T * 64 + SCAN_T * 2;
__device__ __forceinline__ void gdn_scan_unit(int unit, LAS unsigned char* ldsb, const bf16* qkvn, const float* ab, float* O, int tid, int wave, int lane) {
    const int bh = unit >> 1, half = unit & 1, b = bh / GH, h = bh % GH;
    const int s = lane & 7, colL = wave * 8 + (lane >> 3), jc = half * 64 + colL;
    LAS float* buf0 = (LAS float*)ldsb;
    float S[16];
#pragma unroll
    for (int i = 0; i < 16; ++i) S[i] = 0.f;
    const int t_a = tid >> 5, cc_a = tid & 31;
    const size_t rowbase = (size_t)b * SEQ;
    v4u rq0, rq1, rv; float rbd = 0.f;
    rq0 = (v4u){0u, 0u, 0u, 0u}; rq1 = rq0; rv = rq0;
#define SCAN_ISSUE(cidx) do { \
        const size_t r0_ = rowbase + (size_t)(cidx) * SCAN_T; \
        const int coff_ = (cc_a < 16) ? (h * GHD + cc_a * 8) : (MIXW + h * GHD + (cc_a - 16) * 8); \
        rq0 = *(const GAS v4u*)(qkvn + (r0_ + t_a) * (size_t)(3 * MIXW) + coff_); \
        rq1 = *(const GAS v4u*)(qkvn + (r0_ + t_a + 16) * (size_t)(3 * MIXW) + coff_); \
        if (tid < 256) rv = *(const GAS v4u*)(qkvn + (r0_ + (tid >> 3)) * (size_t)(3 * MIXW) + 2 * MIXW + h * GHD + half * 64 + (tid & 7) * 8); \
        else if (tid < 320) { const int t_ = (tid - 256) >> 1, which_ = tid & 1; rbd = ab[(r0_ + t_) * 48 + which_ * GH + h]; } \
    } while (0)
    SCAN_ISSUE(0);
    for (int c = 0; c < SEQ / SCAN_T; ++c) {
        LAS float* buf = buf0 + (c & 1) * SCAN_BUF_FLOATS;
        {
            LAS float* d0 = buf + t_a * SCAN_QK_LD + ((cc_a < 16) ? cc_a * 8 : 128 + (cc_a - 16) * 8);
            LAS float* d1 = d0 + 16 * SCAN_QK_LD;
            *(LAS f32x4*)(d0) = (f32x4){bflo(rq0[0]), bfhi(rq0[0]), bflo(rq0[1]), bfhi(rq0[1])}; *(LAS f32x4*)(d0 + 4) = (f32x4){bflo(rq0[2]), bfhi(rq0[2]), bflo(rq0[3]), bfhi(rq0[3])};
            *(LAS f32x4*)(d1) = (f32x4){bflo(rq1[0]), bfhi(rq1[0]), bflo(rq1[1]), bfhi(rq1[1])}; *(LAS f32x4*)(d1 + 4) = (f32x4){bflo(rq1[2]), bfhi(rq1[2]), bflo(rq1[3]), bfhi(rq1[3])};
            if (tid < 256) { LAS float* dv = buf + SCAN_T * SCAN_QK_LD + (tid >> 3) * 64 + (tid & 7) * 8;
                *(LAS f32x4*)(dv) = (f32x4){bflo(rv[0]), bfhi(rv[0]), bflo(rv[1]), bfhi(rv[1])}; *(LAS f32x4*)(dv + 4) = (f32x4){bflo(rv[2]), bfhi(rv[2]), bflo(rv[3]), bfhi(rv[3])}; }
            else if (tid < 320) buf[SCAN_T * SCAN_QK_LD + SCAN_T * 64 + (tid - 256)] = rbd;
        }
        __syncthreads();
        if (c + 1 < SEQ / SCAN_T) SCAN_ISSUE(c + 1);
        const LAS float* vb = buf + SCAN_T * SCAN_QK_LD; const LAS float* bd = vb + SCAN_T * 64;
        float* orow = O + (rowbase + (size_t)c * SCAN_T) * MIXW + h * GHD + jc;
#pragma unroll 2
        for (int t = 0; t < SCAN_T; ++t) {
            const LAS float* qk = buf + t * SCAN_QK_LD + 16 * s;
            f32x4 kk[4], qq[4];
#pragma unroll
            for (int i = 0; i < 4; ++i) { kk[i] = *(const LAS f32x4*)(qk + 128 + 4 * i); qq[i] = *(const LAS f32x4*)(qk + 4 * i); }
            const float v = vb[t * 64 + colL], beta = bd[2 * t], a = bd[2 * t + 1];
            float ks0 = 0.f, ks1 = 0.f;
#pragma unroll
            for (int i = 0; i < 4; ++i) { ks0 += kk[i][0] * S[4 * i] + kk[i][2] * S[4 * i + 2]; ks1 += kk[i][1] * S[4 * i + 1] + kk[i][3] * S[4 * i + 3]; }
            const float kS = grp8_sum(ks0 + ks1);
            const float cc = beta * (v - a * kS);
            float o0 = 0.f, o1 = 0.f;
#pragma unroll
            for (int i = 0; i < 4; ++i) {
                S[4 * i] = a * S[4 * i] + kk[i][0] * cc; S[4 * i + 1] = a * S[4 * i + 1] + kk[i][1] * cc; S[4 * i + 2] = a * S[4 * i + 2] + kk[i][2] * cc; S[4 * i + 3] = a * S[4 * i + 3] + kk[i][3] * cc;
                o0 += qq[i][0] * S[4 * i] + qq[i][2] * S[4 * i + 2]; o1 += qq[i][1] * S[4 * i + 1] + qq[i][3] * S[4 * i + 3]; }
            const float o = grp8_sum(o0 + o1);
            if (s == 0) orow[(size_t)t * MIXW] = o;
        }
    }
    __syncthreads();
#undef SCAN_ISSUE
}

__device__ __forceinline__ void gdn_out_phase(int gw, int NGW, int lane, const float* O, const bf16* proj, const float* normg, bf16* cat) {
    const int dl = (lane & 15) * 8;
    const f32x4 g0 = *(const GAS f32x4*)(normg + dl), g1 = *(const GAS f32x4*)(normg + dl + 4);
    for (int row = gw; row < MROWS; row += NGW) {
#pragma unroll 2
        for (int it = 0; it < 6; ++it) { const int ch = (it * 4 + (lane >> 4)) * GHD + dl;
            const f32x4 o0 = *(const GAS f32x4*)(O + (size_t)row * MIXW + ch), o1 = *(const GAS f32x4*)(O + (size_t)row * MIXW + ch + 4);
            const v4u zv = *(const GAS v4u*)(proj + (size_t)row * GDN_LD + 3 * MIXW + ch);
            float ss = (o0[0] * o0[0] + o0[1] * o0[1]) + (o0[2] * o0[2] + o0[3] * o0[3]) + (o1[0] * o1[0] + o1[1] * o1[1]) + (o1[2] * o1[2] + o1[3] * o1[3]);
            ss = grp16_sum(ss);
            const float r = 1.0f / sqrtf(ss * (1.0f / GHD) + EPS);
            float y[8];
            y[0] = o0[0] * r * g0[0] * silu_f(bflo(zv[0])); y[1] = o0[1] * r * g0[1] * silu_f(bfhi(zv[0])); y[2] = o0[2] * r * g0[2] * silu_f(bflo(zv[1])); y[3] = o0[3] * r * g0[3] * silu_f(bfhi(zv[1]));
            y[4] = o1[0] * r * g1[0] * silu_f(bflo(zv[2])); y[5] = o1[1] * r * g1[1] * silu_f(bfhi(zv[2])); y[6] = o1[2] * r * g1[2] * silu_f(bflo(zv[3])); y[7] = o1[3] * r * g1[3] * silu_f(bfhi(zv[3]));
            v4u w; w.x = pk2(y[0], y[1]); w.y = pk2(y[2], y[3]); w.z = pk2(y[4], y[5]); w.w = pk2(y[6], y[7]);
            *(GAS v4u*)(cat + (size_t)row * DM + ch) = w; }
    }
}

__device__ __forceinline__ int opq_v(int x) { asm volatile("" : "+v"(x)); return x; }
__device__ __forceinline__ int opq_s(int x) { asm volatile("" : "+s"(x)); return x; }
typedef unsigned char* const __attribute__((address_space(4)))* karg_tab_t;
__device__ __forceinline__ unsigned char* karg_ptr(int i) { asm volatile("" : "+s"(i)); return ((karg_tab_t)__builtin_amdgcn_kernarg_segment_ptr())[i]; }
#define INP(i) ((const float*)karg_ptr(i))
#define WSP(off) (karg_ptr(20) + (off))

__global__ void __launch_bounds__(NWAVES * 64, 2) fwd_kernel(Args args) {
    extern __shared__ __attribute__((aligned(16))) unsigned char lds[];
    LAS unsigned char* L = (LAS unsigned char*)lds;
    volatile LAS unsigned* MISC = (volatile LAS unsigned*)(L + MISC_OFF);
    const int tid0 = threadIdx.x;
    const int G = gridDim.x, c = blockIdx.x;
#define tid (opq_v(tid0))
#define lane (opq_v(tid0) & 63)
#define wave (__builtin_amdgcn_readfirstlane(opq_v(tid0) >> 6))
#define gw (opq_s(c) * NWAVES + __builtin_amdgcn_readfirstlane(opq_v(tid0) >> 6))
#define NGW (opq_s(G) * NWAVES)
    for (int u = tid0; u < (LDS_BYTES - LDSCTL_OFF) / 4; u += NWAVES * 64) ((LAS unsigned*)(L + LDSCTL_OFF))[u] = 0u;
    __syncthreads();
    (void)xcd_barrier_post((unsigned*)(WSP(WS_CTL)) + CW_BAR, MISC + 8);
#define GRID_BAR() do { XcdBarrier bar_; bar_.bar = (unsigned*)(WSP(WS_CTL)) + CW_BAR; bar_.x = xb_xcc_id(); bar_.st = MISC + 8; xcd_barrier(bar_); } while (0)
#ifdef TPROBE
#define TP_BEGIN(k) do { if ((k) == TPROBE && c == 0 && tid0 == 0) { const unsigned long long t_ = __builtin_amdgcn_s_memrealtime(); MISC[16] = (unsigned)t_; MISC[17] = (unsigned)(t_ >> 32); } } while (0)
#define TP_END(k) do { if ((k) == TPROBE && c == 0 && tid0 == 0) { const unsigned long long t_ = __builtin_amdgcn_s_memrealtime() - (((unsigned long long)MISC[17] << 32) | MISC[16]); \
        const unsigned long long a_ = ((((unsigned long long)MISC[19] << 32) | MISC[18])) + t_; MISC[18] = (unsigned)a_; MISC[19] = (unsigned)(a_ >> 32); } } while (0)
#else
#define TP_BEGIN(k) do {} while (0)
#define TP_END(k) do {} while (0)
#endif
#ifdef NO_P0
#define PH_P0(x)
#else
#define PH_P0(x) x
#endif
#ifdef NO_KV
#define PH_KV(x)
#else
#define PH_KV(x) x
#endif
#ifdef NO_GU
#define PH_GU(x)
#else
#define PH_GU(x) x
#endif
#ifdef NO_DN
#define PH_DN(x)
#else
#define PH_DN(x) x
#endif
#ifdef NO_NORM
#define PH_NORM(x)
#else
#define PH_NORM(x) x
#endif
#ifdef NO_SCIN
#define PH_SCIN(x)
#else
#define PH_SCIN(x) x
#endif
#ifdef NO_SCG
#define PH_SCG(x)
#else
#define PH_SCG(x) x
#endif
#ifdef NO_XA
#define PH_XA(x)
#else
#define PH_XA(x) x
#endif
#ifdef NO_GDNIN
#define PH_GDNIN(x)
#else
#define PH_GDNIN(x) x
#endif
#ifdef NO_PREP
#define PH_PREP(x)
#else
#define PH_PREP(x) x
#endif
#ifdef NO_GOUT
#define PH_GOUT(x)
#else
#define PH_GOUT(x) x
#endif
#ifdef NO_WOUT
#define PH_WOUT(x)
#else
#define PH_WOUT(x) x
#endif
#ifdef NO_SCAN
#define DO_SCAN(x)
#else
#define DO_SCAN(x) x
#endif

#define Hbuf ((float*)WSP(WS_H))
#define Abuf ((bf16*)WSP(WS_A))
#define OUTb ((bf16*)WSP(WS_OUT))
#define CAT ((bf16*)WSP(WS_CAT))
#define ACT ((bf16*)WSP(WS_ACT))
#define PROJ ((bf16*)WSP(WS_PROJ))
#define AUX ((float*)WSP(WS_AUX))
#define AB ((float*)WSP(WS_AB))
#define QKVN ((bf16*)WSP(WS_QKV))
#define OBUF ((float*)WSP(WS_O))
#define KVOPS ((bf16*)WSP(WS_KVOPS))
#define KB ((bf16*)WSP(WS_KB))
#define VTB ((bf16*)WSP(WS_VTB))
#define WGU ((bf16*)WSP(WS_WGU))
#define WDN ((bf16*)WSP(WS_WDN))
#define WOUT ((bf16*)WSP(WS_WOUT))
#define WSC ((bf16*)WSP(WS_WSC))
#define WGDN ((bf16*)WSP(WS_WGDN))

    TP_BEGIN(1);
#ifndef NO_P0
    {
        LAS float* scr = (LAS float*)(L + RING_OFF + wave * XP_SCR);
        long base = 0;
        for (int job = 0; job < 40; ++job) {
            const float* W; bf16* WT; int K, N, col0 = 0, ncols, nvalid, mode = 0, roff = 0;
            if (job < 8)       { W = INP(I_WG) + (size_t)job * DM * DFF; K = DM; N = DFF; ncols = DFF; WT = WGU + (size_t)job * 2 * DFF * DM; mode = 1; roff = 0; }
            else if (job < 16) { W = INP(I_WU) + (size_t)(job - 8) * DM * DFF; K = DM; N = DFF; ncols = DFF; WT = WGU + (size_t)(job - 8) * 2 * DFF * DM; mode = 1; roff = 128; }
            else if (job < 24) { W = INP(I_WD) + (size_t)(job - 16) * DFF * DM; K = DFF; N = DM; ncols = DM; WT = WDN + (size_t)(job - 16) * DM * DFF; }
            else if (job < 28) { W = INP(I_WOUT) + (size_t)(job - 24) * DM * DM; K = DM; N = DM; ncols = DM; WT = WOUT + (size_t)(job - 24) * DM * DM; }
            else if (job < 32) { W = INP(I_WKV) + (size_t)(job - 28) * DM * 2 * XW; K = DM; N = 2 * XW; ncols = 2 * XW; WT = KVOPS + ((size_t)(job - 28) * 3072 + 1024) * DM; }
            else if (job < 34) { W = INP(I_SCIN) + (size_t)(job - 32) * DM * SC_IN; K = DM; N = SC_IN; ncols = SC_IN; WT = WSC + (size_t)(job - 32) * SC_IN * DM; }
            else if (job < 36) { W = INP(I_GDNIN) + (size_t)(job - 34) * DM * GDN_SRC; K = DM; N = GDN_SRC; ncols = 4 * MIXW; WT = WGDN + (size_t)(job - 34) * GDN_N * DM; }
            else if (job < 38) { W = INP(I_GDNIN) + (size_t)(job - 36) * DM * GDN_SRC; K = DM; N = GDN_SRC; col0 = 4 * MIXW + 2 * GH; ncols = XW; WT = WGDN + (size_t)(job - 36) * GDN_N * DM; roff = 4 * MIXW; }
            else               { W = INP(I_GDNIN) + (size_t)(job - 38) * DM * GDN_SRC; K = DM; N = GDN_SRC; col0 = 4 * MIXW; ncols = 64; WT = WGDN + (size_t)(job - 38) * GDN_N * DM; roff = GDN_LD; }
            nvalid = (job >= 38) ? 2 * GH : ncols;
            const int nblk = ncols / 64, items = (K / 64) * nblk;
            int first = (int)(((long)gw - base) % NGW); if (first < 0) first += NGW;
            const int step = NGW;
#define XP_DROW(nb_) (mode ? (256 * ((nb_) >> 1) + 64 * ((nb_) & 1) + roff) : (64 * (nb_) + roff))
            if (first < items) {
                f32x4 va[16], vb[16];
                int it = first;
                xpose_load(va, W, N, col0, nvalid, 64 * (it / nblk), 64 * (it % nblk), lane);
                for (;;) {
                    const int it1 = it + step;
                    if (it1 < items) xpose_load(vb, W, N, col0, nvalid, 64 * (it1 / nblk), 64 * (it1 % nblk), lane);
                    xpose_store(va, WT, K, XP_DROW(it % nblk), scr, 64 * (it / nblk), lane);
                    if (it1 >= items) break;
                    const int it2 = it1 + step;
                    if (it2 < items) xpose_load(va, W, N, col0, nvalid, 64 * (it2 / nblk), 64 * (it2 % nblk), lane);
                    xpose_store(vb, WT, K, XP_DROW(it1 % nblk), scr, 64 * (it1 / nblk), lane);
                    if (it2 >= items) break;
                    it = it2;
                }
            }
#undef XP_DROW
            base += items;
        }
        for (int r = gw; r < 2 * 192; r += NGW) { bf16* p = WGDN + ((size_t)(r / 192) * GDN_N + GDN_LD + 64 + (r % 192)) * DM;
#pragma unroll
            for (int j = 0; j < 8; ++j) *(GAS v4u*)(p + (j * 64 + lane) * 8) = (v4u){0u, 0u, 0u, 0u}; }
        for (int r = gw; r < NBATCH * MEMT; r += NGW) { const float* mr = INP(I_MEM) + (size_t)r * DM;
            f32x4 v[16]; float ss = 0.f;
#pragma unroll
            for (int j = 0; j < 16; ++j) { v[j] = *(const GAS f32x4*)(mr + (j * 64 + lane) * 4); ss += (v[j][0] * v[j][0] + v[j][1] * v[j][1]) + (v[j][2] * v[j][2] + v[j][3] * v[j][3]); }
            ss = wave_sum(ss); const float sc = 1.0f / sqrtf(ss * (1.0f / DM) + EPS);
            for (int l = 0; l < DEPTH; ++l) { const float* g = INP(I_MEMG) + (size_t)l * DM; bf16* dst = KVOPS + ((size_t)l * 3072 + r) * DM;
#pragma unroll
                for (int j = 0; j < 16; ++j) { const f32x4 gg = *(const GAS f32x4*)(g + (j * 64 + lane) * 4); const f32x4 a = v[j] * gg * sc;
                    v2u o; o.x = pk2(a[0], a[1]); o.y = pk2(a[2], a[3]); *(GAS v2u*)(dst + (j * 64 + lane) * 4) = o; } } }
        norm_phase(gw, NGW, lane, nullptr, 0.f, nullptr, INP(I_X), Hbuf, INP(I_FPRE), Abuf);
    }
#endif
    GRID_BAR();
    TP_END(1);

    TP_BEGIN(3);
    {
        pg8::Gemm g{KVOPS, KVOPS, 4 * 3072, 4 * 3072, DM}; pg8::KvOrder S{G, c}; pg8::EpiKV E{KB, VTB};
        PH_KV((pg8::gemm_phase<pg8::EpiKV, pg8::KvOrder, PG8_ALIGN, PG8_SP2>(L + RING_OFF, g, S, E)));
    }
    TP_END(3);

#define FFN_GEMMS(f_) do { \
        TP_BEGIN(3); \
        { pg8::Gemm g{Abuf, WGU + (size_t)(l * 2 + (f_)) * 2 * DFF * DM, MROWS, 2 * DFF, DM}; pg8::StaticOrder S; S.init(MROWS, 2 * DFF, G, c); pg8::EpiSwiGLU E{ACT, DFF}; \
          PH_GU((pg8::gemm_phase<pg8::EpiSwiGLU, pg8::StaticOrder, PG8_ALIGN, PG8_SP2>(L + RING_OFF, g, S, E))); } \
        GRID_BAR(); \
        { pg8::Gemm g{ACT, WDN + (size_t)(l * 2 + (f_)) * DM * DFF, MROWS, DM, DFF}; pg8::StaticOrder S; S.init(MROWS, DM, G, c); pg8::EpiProj E{OUTb, DM, nullptr, -1}; \
          PH_DN((pg8::gemm_phase<pg8::EpiProj, pg8::StaticOrder, PG8_ALIGN, PG8_SP2>(L + RING_OFF, g, S, E))); } \
        GRID_BAR(); \
        TP_END(3); \
    } while (0)

    for (int l = 0; l < DEPTH; ++l) {
        const int j2 = l >> 1; const bool gdn = (l & 1) != 0;
        FFN_GEMMS(0);
        TP_BEGIN(6);
        PH_NORM(norm_phase(gw, NGW, lane, OUTb, 0.5f, INP(I_FPOST) + (size_t)(l * 2) * DM, Hbuf, Hbuf, INP(I_MPRE) + (size_t)l * DM, Abuf);)
        GRID_BAR();
        TP_END(6);
        if (!gdn) {
            TP_BEGIN(3);
            { pg8::Gemm g{Abuf, WSC + (size_t)j2 * SC_IN * DM, MROWS, SC_IN, DM}; pg8::StaticOrder S; S.init(MROWS, SC_IN, G, c); pg8::EpiProj E{PROJ, SC_IN, nullptr, -1};
              PH_SCIN((pg8::gemm_phase<pg8::EpiProj, pg8::StaticOrder, PG8_ALIGN, PG8_SP2>(L + RING_OFF, g, S, E))); }
            GRID_BAR();
            TP_END(3);
            TP_BEGIN(4);
            PH_SCG(sc_gate_phase(gw, NGW, lane, PROJ, INP(I_SCCONV) + (size_t)j2 * 3 * MIXW, CAT);)
            for (int u = c; u < 256; u += G) { PH_XA(xattn_unit(u, PROJ, SC_IN, 3 * MIXW, KB + (size_t)l * 1048576, VTB + (size_t)l * 1048576, CAT, wave, lane);) }
            GRID_BAR();
            TP_END(4);
        } else {
            TP_BEGIN(3);
            { pg8::Gemm g{Abuf, WGDN + (size_t)j2 * GDN_N * DM, MROWS, GDN_N, DM}; pg8::StaticOrder S; S.init(MROWS, GDN_N, G, c); pg8::EpiProj E{PROJ, GDN_LD, AUX, GDN_LD / 256};
              PH_GDNIN((pg8::gemm_phase<pg8::EpiProj, pg8::StaticOrder, PG8_ALIGN, PG8_SP2>(L + RING_OFF, g, S, E))); }
            GRID_BAR();
            TP_END(3);
            TP_BEGIN(5);
            PH_PREP(gdn_prep_phase(gw, NGW, lane, PROJ, INP(I_GDNCONV) + (size_t)j2 * 4 * 3 * MIXW, QKVN, AUX, INP(I_ALOG) + j2 * GH, INP(I_DTB) + j2 * GH, AB);)
            GRID_BAR();
            TP_END(5);
            TP_BEGIN(2);
            {
                const int nscan = NBATCH * GH * 2;
                if (G > nscan) {
                    if (c < nscan) { DO_SCAN(gdn_scan_unit(c, L + RING_OFF, QKVN, AB, OBUF, tid, wave, lane)); }
                    else for (int u = c - nscan; u < 256; u += G - nscan) { PH_XA(xattn_unit(u, PROJ, GDN_LD, 4 * MIXW, KB + (size_t)l * 1048576, VTB + (size_t)l * 1048576, CAT, wave, lane);) }
                } else {
                    for (int u = c; u < nscan; u += G) { DO_SCAN(gdn_scan_unit(u, L + RING_OFF, QKVN, AB, OBUF, tid, wave, lane)); }
                    for (int u = c; u < 256; u += G) { PH_XA(xattn_unit(u, PROJ, GDN_LD, 4 * MIXW, KB + (size_t)l * 1048576, VTB + (size_t)l * 1048576, CAT, wave, lane);) }
                }
            }
            GRID_BAR();
            TP_END(2);
            TP_BEGIN(5);
            PH_GOUT(gdn_out_phase(gw, NGW, lane, OBUF, PROJ, INP(I_NORMG) + j2 * GHD, CAT);)
            GRID_BAR();
            TP_END(5);
        }
        TP_BEGIN(3);
        { pg8::Gemm g{CAT, WOUT + (size_t)l * DM * DM, MROWS, DM, DM}; pg8::StaticOrder S; S.init(MROWS, DM, G, c); pg8::EpiProj E{OUTb, DM, nullptr, -1};
          PH_WOUT((pg8::gemm_phase<pg8::EpiProj, pg8::StaticOrder, PG8_ALIGN, PG8_SP2>(L + RING_OFF, g, S, E))); }
        GRID_BAR();
        TP_END(3);
        TP_BEGIN(6);
        PH_NORM(norm_phase(gw, NGW, lane, OUTb, 1.0f, INP(I_MPOST) + (size_t)l * DM, Hbuf, Hbuf, INP(I_FPRE) + (size_t)(l * 2 + 1) * DM, Abuf);)
        GRID_BAR();
        TP_END(6);
        FFN_GEMMS(1);
        TP_BEGIN(6);
        if (l < DEPTH - 1) {
            PH_NORM(norm_phase(gw, NGW, lane, OUTb, 0.5f, INP(I_FPOST) + (size_t)(l * 2 + 1) * DM, Hbuf, Hbuf, INP(I_FPRE) + (size_t)((l + 1) * 2) * DM, Abuf);)
            GRID_BAR();
        } else {
            PH_NORM(norm_phase(gw, NGW, lane, OUTb, 0.5f, INP(I_FPOST) + (size_t)(l * 2 + 1) * DM, Hbuf, ((float*)karg_ptr(19)), nullptr, nullptr);)
        }
        TP_END(6);
    }
#ifdef TPROBE
    if (c == 0 && tid0 == 0) { const unsigned long long a_ = (((unsigned long long)MISC[19] << 32) | MISC[18]); const unsigned long long t0_ = __builtin_amdgcn_s_memrealtime();
        while (__builtin_amdgcn_s_memrealtime() - t0_ < a_) __builtin_amdgcn_s_sleep(8); }
#endif
#undef FFN_GEMMS
#undef GRID_BAR
#undef tid
#undef lane
#undef wave
#undef gw
#undef NGW
}

extern "C" void kernel_launch(void* const* d_in, const int* in_sizes, int n_in, void* d_out, int out_size, void* d_ws, size_t ws_size, hipStream_t stream) {
    static int grid = 0;
    if (grid == 0) {
        if (n_in != 19 || in_sizes[0] != MROWS * DM || out_size != MROWS * DM || ws_size < WS_END) {
            fprintf(stderr, "kernel_launch: unexpected problem (n_in %d, in0 %d, out %d, ws %zu, need %zu); nothing launched\n", n_in, n_in > 0 ? in_sizes[0] : -1, out_size, ws_size, (size_t)WS_END); grid = -1; return; }
        int dev = 0, cus = 0, per_cu = 0;
        if (hipGetDevice(&dev) != hipSuccess || hipDeviceGetAttribute(&cus, hipDeviceAttributeMultiprocessorCount, dev) != hipSuccess) { fprintf(stderr, "kernel_launch: device query failed\n"); grid = -1; return; }
        if (hipFuncSetAttribute((const void*)fwd_kernel, hipFuncAttributeMaxDynamicSharedMemorySize, LDS_BYTES) != hipSuccess) { fprintf(stderr, "kernel_launch: hipFuncSetAttribute failed\n"); grid = -1; return; }
        if (hipOccupancyMaxActiveBlocksPerMultiprocessor(&per_cu, (const void*)fwd_kernel, NWAVES * 64, LDS_BYTES) != hipSuccess || per_cu < 1)
            fprintf(stderr, "kernel_launch: note: occupancy query reports %d workgroups per CU\n", per_cu);
        (void)hipGetLastError();
        grid = cus;
    }
    if (grid < 0) return;
    if (hipMemsetAsync((char*)d_ws + WS_CTL, 0, CTL_ZERO_BYTES, stream) != hipSuccess) { fprintf(stderr, "kernel_launch: memset failed\n"); return; }
    Args a{};
    for (int i = 0; i < 19; ++i) a.in[i] = (const float*)d_in[i];
    a.out = (float*)d_out; a.ws = (unsigned char*)d_ws;
    hipLaunchKernelGGL(fwd_kernel, dim3(grid), dim3(NWAVES * 64), LDS_BYTES, stream, a);
    const hipError_t le = hipPeekAtLastError();
    if (le != hipSuccess) fprintf(stderr, "kernel_launch: launch failed: %s\n", hipGetErrorName(le));
}
```

```cpp
#include <hip/hip_runtime.h>
#include <cstdio>
#include <cstdint>
namespace pg8 {
#define PG8_LAS __attribute__((address_space(3)))
typedef unsigned short bf16_t;
typedef short bf16x8 __attribute__((ext_vector_type(8)));
typedef float f32x4 __attribute__((ext_vector_type(4)));
typedef unsigned u32x4 __attribute__((ext_vector_type(4)));
constexpr int BM = 256, BK = 64, HALF = 128, HTB = HALF * BK * 2  , STAGE_BYTES = 8 * HTB, NXCD = 8, WGM = 8;

__host__ __device__ __forceinline__ int lds_byte(int r, int c) { const int st = (r >> 4) * 2 + (c >> 5), rr = r & 15, cc = c & 31, ob = rr * 64 + cc * 2; return st * 1024 + (ob ^ (((ob >> 9) & 1) << 5)); }
__host__ __device__ __forceinline__ void stage_rc(int b, int& R, int& C) { const int st = b / 1024, sb = b % 1024, swz = sb ^ (((sb >> 9) & 1) << 5); R = (st >> 1) * 16 + swz / 64; C = (st & 1) * 32 + (swz % 64) / 2; }
__host__ __device__ __forceinline__ int perm32(int rho) { const int n = rho >> 4, i = rho & 15; return 8 * (i >> 2) + 4 * n + (i & 3); }

struct Unit { int pm, pn; };
struct Gemm { const bf16_t* A; const bf16_t* Bt; int M, N, K; };

struct StaticOrder {
    int nM, nN, nwg, G, c;
    __host__ __device__ void init(int M, int N, int G_, int c_) { nM = M / BM; nN = N / BM; nwg = nM * nN; G = G_; c = c_; }
    __host__ __device__ bool next(int i, Unit& u) const {
        const long L = (long)i * G + c; if (L >= nwg) return false;
        int wgid = (int)L; { const int q = nwg / NXCD, r = nwg % NXCD, xcd = wgid % NXCD, off = wgid / NXCD; wgid = (xcd < r ? xcd * (q + 1) : r * (q + 1) + (xcd - r) * q) + off; }
        const int nig = WGM * nN, gid = wgid / nig, fm = gid * WGM, gsz = (nM - fm) < WGM ? (nM - fm) : WGM;
        u.pm = fm + ((wgid % nig) % gsz); u.pn = (wgid % nig) / gsz; return true;
    }
    __device__ __forceinline__ void a_ready(const Unit&) const {}
    __device__ __forceinline__ void done(const Unit&) const {}
};

__device__ __forceinline__ unsigned cvt_pk_bf16(float lo, float hi) { unsigned r; asm volatile("v_cvt_pk_bf16_f32 %0, %1, %2" : "=v"(r) : "v"(lo), "v"(hi)); return r; }

struct EpiProj {
    static constexpr bool PERM = true, AFTER_DRAIN = false;
    bf16_t* O; int ldc; float* aux; int aux_pn;
    __device__ __forceinline__ void operator()(const f32x4 (&acc)[2][2][4][2], const Unit& u, int wr, int wc, int fr, int fq) const {
        const int row0 = u.pm * BM + wr * 64 + fr;
        if (u.pn == aux_pn) {
            if (wc < 2) {
#pragma unroll
                for (int ai = 0; ai < 2; ++ai)
#pragma unroll
                    for (int m = 0; m < 4; ++m) { float* rowp = aux + (size_t)(row0 + ai * HALF + m * 16) * 64 + wc * 32 + 8 * fq;
                        *(f32x4*)(rowp) = acc[ai][0][m][0]; *(f32x4*)(rowp + 4) = acc[ai][0][m][1]; }
            }
            return;
        }
        const int col0 = u.pn * BM + wc * 32 + 8 * fq;
#pragma unroll
        for (int ai = 0; ai < 2; ++ai)
#pragma unroll
            for (int m = 0; m < 4; ++m) { bf16_t* rowp = O + (size_t)(row0 + ai * HALF + m * 16) * ldc + col0;
#pragma unroll
                for (int bj = 0; bj < 2; ++bj) { const f32x4 v0 = acc[ai][bj][m][0], v1 = acc[ai][bj][m][1];
                    u32x4 w; w.x = cvt_pk_bf16(v0[0], v0[1]); w.y = cvt_pk_bf16(v0[2], v0[3]); w.z = cvt_pk_bf16(v1[0], v1[1]); w.w = cvt_pk_bf16(v1[2], v1[3]);
                    *(u32x4*)(rowp + bj * HALF) = w; } }
    }
};
struct EpiSwiGLU {
    static constexpr bool PERM = true, AFTER_DRAIN = false;
    bf16_t* O; int ldc;
    __device__ __forceinline__ void operator()(const f32x4 (&acc)[2][2][4][2], const Unit& u, int wr, int wc, int fr, int fq) const {
        const int row0 = u.pm * BM + wr * 64 + fr, col0 = u.pn * HALF + wc * 32 + 8 * fq;
#pragma unroll
        for (int ai = 0; ai < 2; ++ai)
#pragma unroll
            for (int m = 0; m < 4; ++m) { bf16_t* rowp = O + (size_t)(row0 + ai * HALF + m * 16) * ldc + col0;
                f32x4 r[2];
#pragma unroll
                for (int n = 0; n < 2; ++n)
#pragma unroll
                    for (int j = 0; j < 4; ++j) { const float g = acc[ai][0][m][n][j], up = acc[ai][1][m][n][j];
                        r[n][j] = g * up * __builtin_amdgcn_rcpf(1.0f + __builtin_amdgcn_exp2f(g * -1.44269504089f)); }
                u32x4 w; w.x = cvt_pk_bf16(r[0][0], r[0][1]); w.y = cvt_pk_bf16(r[0][2], r[0][3]); w.z = cvt_pk_bf16(r[1][0], r[1][1]); w.w = cvt_pk_bf16(r[1][2], r[1][3]);
                *(u32x4*)(rowp) = w; }
    }
};
struct EpiKV {
    static constexpr bool PERM = true, AFTER_DRAIN = false;
    bf16_t* Kb; bf16_t* VTb;
    __device__ __forceinline__ void operator()(const f32x4 (&acc)[2][2][4][2], const Unit& u, int wr, int wc, int fr, int fq) const {
        const int l = u.pm / 12, ri = u.pm % 12, rj = u.pn % 12;
        bf16_t* base = (ri < 4) ? Kb + (size_t)l * 1048576 + (size_t)(ri * 256) * 1024 + (rj - 4) * 256
                                : VTb + (size_t)l * 1048576 + (size_t)((ri - 8) * 256) * 1024 + rj * 256;
        const int row0 = wr * 64 + fr, col0 = wc * 32 + 8 * fq;
#pragma unroll
        for (int ai = 0; ai < 2; ++ai)
#pragma unroll
            for (int m = 0; m < 4; ++m) { bf16_t* rowp = base + (size_t)(row0 + ai * HALF + m * 16) * 1024 + col0;
#pragma unroll
                for (int bj = 0; bj < 2; ++bj) { const f32x4 v0 = acc[ai][bj][m][0], v1 = acc[ai][bj][m][1];
                    u32x4 w; w.x = cvt_pk_bf16(v0[0], v0[1]); w.y = cvt_pk_bf16(v0[2], v0[3]); w.z = cvt_pk_bf16(v1[0], v1[1]); w.w = cvt_pk_bf16(v1[2], v1[3]);
                    *(u32x4*)(rowp + bj * HALF) = w; } }
    }
};
struct KvOrder {
    int G, c;
    __device__ __forceinline__ bool next(int i, Unit& u) const {
        const int L = i * G + c; if (L >= 128) return false;
        const int l = L >> 5, r = L & 31;
        if (r < 16) { u.pm = 12 * l + (r >> 2); u.pn = 12 * l + 4 + (r & 3); }
        else { u.pm = 12 * l + 8 + ((r - 16) >> 2); u.pn = 12 * l + (r & 3); }
        return true;
    }
    __device__ __forceinline__ void a_ready(const Unit&) const {}
    __device__ __forceinline__ void done(const Unit&) const {}
};

template <class Epi, class Sched, bool ALIGN_EPI = false, bool SP2 = false>
__device__ __forceinline__ void gemm_phase(PG8_LAS unsigned char* lds, const Gemm g, const Sched& S, const Epi& E) {
    int tid_o = threadIdx.x; asm volatile("" : "+v"(tid_o));
    const int tid = tid_o, wid = __builtin_amdgcn_readfirstlane(tid >> 6), lane = tid & 63, wr = wid >> 2, wc = wid & 3, fr = lane & 15, fq = lane >> 4;
    const int K = g.K, nt = K / BK;
    unsigned voffA[2], voffB[2];
#pragma unroll
    for (int i = 0; i < 2; ++i) { int R, C; stage_rc(tid * 16 + i * 8192, R, C); const int Rb = Epi::PERM ? ((R & ~31) + perm32(R & 31)) : R;
        voffA[i] = (unsigned)(R * K + C) * 2u; voffB[i] = (unsigned)(Rb * K + C) * 2u; }
    const size_t kstep = (size_t)(BK * 2);
    const size_t hstep = (size_t)HALF * K * 2;
    const size_t tstep = 2 * hstep;
    const unsigned ldsw = (unsigned)wid * 1024u;
    const int aoff = lds_byte(wr * 64 + fr, fq * 8), boff = lds_byte(wc * 32 + fr, fq * 8);
#define PG8_SA(b, h) (((b) * 2 + (h)) * HTB)
#define PG8_SB(b, h) ((4 + (b) * 2 + (h)) * HTB)
#define PG8_STAGE(bufoff, gbase, voff) do { _Pragma("unroll") for (int _i = 0; _i < 2; ++_i) \
        __builtin_amdgcn_global_load_lds((const unsigned*)((const char*)(gbase) + (voff)[_i]), (PG8_LAS unsigned*)(lds + (bufoff) + ldsw + _i * 8192), 16, 0, 0); } while (0)
#define PG8_LDA(dst, b, h) do { _Pragma("unroll") for (int m = 0; m < 4; ++m) _Pragma("unroll") for (int k = 0; k < 2; ++k) dst[m][k] = *(const PG8_LAS bf16x8*)(lds + PG8_SA(b, h) + aoff + m * 2048 + k * 1024); } while (0)
#define PG8_LDB(dst, b, h) do { _Pragma("unroll") for (int n = 0; n < 2; ++n) _Pragma("unroll") for (int k = 0; k < 2; ++k) dst[n][k] = *(const PG8_LAS bf16x8*)(lds + PG8_SB(b, h) + boff + n * 2048 + k * 1024); } while (0)
#define PG8_MMA(ai, bj, At, Bt) do { __builtin_amdgcn_s_setprio(1); _Pragma("unroll") for (int m = 0; m < 4; ++m) _Pragma("unroll") for (int n = 0; n < 2; ++n) _Pragma("unroll") for (int k = 0; k < 2; ++k) \
        acc[ai][bj][m][n] = __builtin_amdgcn_mfma_f32_16x16x32_bf16(Bt[n][k], At[m][k], acc[ai][bj][m][n], 0, 0, 0); __builtin_amdgcn_s_setprio(0); } while (0)
#define PG8_WAIT_V(n) asm volatile("s_waitcnt vmcnt(" #n ")" ::: "memory")
#define PG8_WAIT_L(n) asm volatile("s_waitcnt lgkmcnt(" #n ")" ::: "memory")
#define PG8_BAR __builtin_amdgcn_s_barrier()
#define PG8_SCHED __builtin_amdgcn_sched_barrier(0)
    Unit cur, nxt; int ui = 0;
    if (!S.next(0, cur)) return;
    f32x4 acc[2][2][4][2];
#pragma unroll
    for (int a = 0; a < 2; ++a)
#pragma unroll
        for (int b = 0; b < 2; ++b)
#pragma unroll
            for (int m = 0; m < 4; ++m)
#pragma unroll
                for (int n = 0; n < 2; ++n) acc[a][b][m][n] = (f32x4){0.f, 0.f, 0.f, 0.f};
    bf16x8 At[4][2], B0[2][2], B1[2][2];
    const char* cA = (const char*)g.A + (size_t)cur.pm * tstep; const char* cB = (const char*)g.Bt + (size_t)cur.pn * tstep;
    S.a_ready(cur);
    if constexpr (SP2) {
        PG8_STAGE(PG8_SB(0, 0), cB, voffB); PG8_STAGE(PG8_SB(0, 1), cB + hstep, voffB); PG8_STAGE(PG8_SA(0, 0), cA, voffA); PG8_STAGE(PG8_SA(0, 1), cA + hstep, voffA);
        if (wr == 1) PG8_BAR;
        PG8_WAIT_V(2); PG8_BAR;
        PG8_STAGE(PG8_SB(1, 0), cB + kstep, voffB); PG8_STAGE(PG8_SA(1, 0), cA + kstep, voffA); PG8_STAGE(PG8_SB(1, 1), cB + hstep + kstep, voffB);
        PG8_WAIT_V(6); PG8_BAR;
    } else {
        PG8_STAGE(PG8_SB(0, 0), cB, voffB); PG8_STAGE(PG8_SA(0, 0), cA, voffA); PG8_STAGE(PG8_SB(0, 1), cB + hstep, voffB); PG8_STAGE(PG8_SA(0, 1), cA + hstep, voffA);
        if (wr == 1) PG8_BAR;
        PG8_WAIT_V(4); PG8_BAR;
        PG8_STAGE(PG8_SB(1, 0), cB + kstep, voffB); PG8_STAGE(PG8_SA(1, 0), cA + kstep, voffA); PG8_STAGE(PG8_SB(1, 1), cB + hstep + kstep, voffB);
        PG8_WAIT_V(6); PG8_BAR;
    }
    for (;;) {
        const bool has_next = S.next(ui + 1, nxt);
        const char* nA = has_next ? (const char*)g.A + (size_t)nxt.pm * tstep : cA; const char* nB = has_next ? (const char*)g.Bt + (size_t)nxt.pn * tstep : cB;
        for (int t = 0; t < nt; t += 2) {
            const bool last = (t == nt - 2);
            const char* a1 = cA + (size_t)(t + 1) * kstep;
            const char* a2 = last ? nA : cA + (size_t)(t + 2) * kstep; const char* b2 = last ? nB : cB + (size_t)(t + 2) * kstep;
            const char* a3 = a2 + kstep; const char* b3 = b2 + kstep;
            if (last && has_next) S.a_ready(nxt);
            if constexpr (SP2) {
            PG8_LDB(B0, 0, 0); PG8_LDB(B1, 0, 1); PG8_SCHED; PG8_LDA(At, 0, 0); PG8_STAGE(PG8_SA(1, 1), a1 + hstep, voffA);
            PG8_WAIT_V(8); PG8_WAIT_L(0); PG8_BAR; PG8_MMA(0, 0, At, B0); PG8_MMA(0, 1, At, B1); PG8_BAR; PG8_SCHED;
            PG8_LDA(At, 0, 1); PG8_STAGE(PG8_SB(0, 0), b2, voffB); PG8_STAGE(PG8_SB(0, 1), b2 + hstep, voffB); PG8_STAGE(PG8_SA(0, 0), a2, voffA);
            PG8_WAIT_V(8); PG8_WAIT_L(0); PG8_BAR; PG8_MMA(1, 0, At, B0); PG8_MMA(1, 1, At, B1); PG8_BAR; PG8_SCHED;
            PG8_LDB(B0, 1, 0); PG8_LDB(B1, 1, 1); PG8_SCHED; PG8_LDA(At, 1, 0); PG8_STAGE(PG8_SA(0, 1), a2 + hstep, voffA);
            PG8_WAIT_V(8); PG8_WAIT_L(0); PG8_BAR; PG8_MMA(0, 0, At, B0); PG8_MMA(0, 1, At, B1); PG8_BAR; PG8_SCHED;
            PG8_LDA(At, 1, 1); PG8_STAGE(PG8_SB(1, 0), b3, voffB); PG8_STAGE(PG8_SB(1, 1), b3 + hstep, voffB); PG8_STAGE(PG8_SA(1, 0), a3, voffA);
            PG8_WAIT_V(8); PG8_WAIT_L(0); PG8_BAR; PG8_MMA(1, 0, At, B0); PG8_MMA(1, 1, At, B1); PG8_BAR; PG8_SCHED;
            } else {
            PG8_LDB(B0, 0, 0); PG8_SCHED; PG8_LDA(At, 0, 0); PG8_STAGE(PG8_SA(1, 1), a1 + hstep, voffA);
            PG8_WAIT_L(8); PG8_BAR; PG8_WAIT_L(0); PG8_MMA(0, 0, At, B0); PG8_BAR; PG8_SCHED;
            PG8_LDB(B1, 0, 1); PG8_STAGE(PG8_SB(0, 0), b2, voffB);
            PG8_BAR; PG8_WAIT_L(0); PG8_MMA(0, 1, At, B1); PG8_BAR;
            PG8_LDA(At, 0, 1); PG8_STAGE(PG8_SA(0, 0), a2, voffA);
            PG8_BAR; PG8_WAIT_L(0); PG8_MMA(1, 0, At, B0); PG8_BAR; PG8_SCHED;
            PG8_STAGE(PG8_SB(0, 1), b2 + hstep, voffB);
            PG8_WAIT_V(6); PG8_BAR; PG8_MMA(1, 1, At, B1); PG8_BAR;
            PG8_LDB(B0, 1, 0); PG8_SCHED; PG8_LDA(At, 1, 0); PG8_STAGE(PG8_SA(0, 1), a2 + hstep, voffA);
            PG8_WAIT_L(8); PG8_BAR; PG8_WAIT_L(0); PG8_MMA(0, 0, At, B0); PG8_BAR; PG8_SCHED;
            PG8_LDB(B1, 1, 1); PG8_STAGE(PG8_SB(1, 0), b3, voffB);
            PG8_BAR; PG8_WAIT_L(0); PG8_MMA(0, 1, At, B1); PG8_BAR;
            PG8_LDA(At, 1, 1); PG8_STAGE(PG8_SA(1, 0), a3, voffA);
            PG8_BAR; PG8_WAIT_L(0); PG8_MMA(1, 0, At, B0); PG8_BAR; PG8_SCHED;
            PG8_STAGE(PG8_SB(1, 1), b3 + hstep, voffB);
            PG8_WAIT_V(6); PG8_BAR; PG8_MMA(1, 1, At, B1); PG8_BAR;
            }
        }
        if constexpr (ALIGN_EPI) { if (wr == 0) PG8_BAR; }
        if constexpr (!Epi::AFTER_DRAIN) { E(acc, cur, wr, wc, fr, fq); S.done(cur); }
        if (!has_next) break;
#pragma unroll
        for (int a = 0; a < 2; ++a)
#pragma unroll
            for (int b = 0; b < 2; ++b)
#pragma unroll
                for (int m = 0; m < 4; ++m)
#pragma unroll
                    for (int n = 0; n < 2; ++n) acc[a][b][m][n] = (f32x4){0.f, 0.f, 0.f, 0.f};
        cur = nxt; cA = nA; cB = nB; ++ui;
        if constexpr (ALIGN_EPI) { if (wr == 1) PG8_BAR; }
    }
    PG8_WAIT_V(0);
    if constexpr (!ALIGN_EPI) { if (wr == 0) PG8_BAR; }
    PG8_BAR;
    if constexpr (Epi::AFTER_DRAIN) { E.fused(acc, cur, wr, wc, fr, fq, lds, wid, lane); S.done(cur); }
#undef PG8_SA
#undef PG8_SB
#undef PG8_STAGE
#undef PG8_LDA
#undef PG8_LDB
#undef PG8_MMA
#undef PG8_WAIT_V
#undef PG8_WAIT_L
#undef PG8_BAR
#undef PG8_SCHED
}
}

#ifndef PG8_SP2
#define PG8_SP2 true
#endif
#ifndef PG8_ALIGN
#define PG8_ALIGN true
#endif

constexpr int NWAVES = 8;
constexpr int DM = 4096, NBATCH = 4, SEQ = 2048, MROWS = NBATCH * SEQ, DEPTH = 4;
constexpr int MEMT = 256, XH = 4, XW = 1024, XHD = 256, MIXW = 3072, DFF = 6144;
constexpr int GH = 24, GHD = 128;
constexpr int SC_IN = 3 * MIXW + XW;
constexpr int GDN_SRC = 4 * MIXW + 2 * GH + XW;
constexpr int GDN_LD = 4 * MIXW + XW;
constexpr int GDN_N = GDN_LD + 256;
constexpr float EPS = 1e-6f;

constexpr size_t MiB = 1u << 20;
constexpr size_t WS_CTL = 0, CTL_ZERO_BYTES = 1 * MiB;
constexpr size_t WS_H = 1 * MiB;
constexpr size_t WS_A = WS_H + 128 * MiB;
constexpr size_t WS_OUT = WS_A + 64 * MiB;
constexpr size_t WS_CAT = WS_OUT + 64 * MiB;
constexpr size_t WS_ACT = WS_CAT + 64 * MiB;
constexpr size_t WS_PROJ = WS_ACT + 96 * MiB;
constexpr size_t WS_AUX = WS_PROJ + 208 * MiB;
constexpr size_t WS_AB = WS_AUX + 2 * MiB;
constexpr size_t WS_QKV = WS_AB + 2 * MiB;
constexpr size_t WS_O = WS_QKV + 144 * MiB;
constexpr size_t WS_KVOPS = WS_O + 96 * MiB;
constexpr size_t WS_KB = WS_KVOPS + 96 * MiB;
constexpr size_t WS_VTB = WS_KB + 8 * MiB;
constexpr size_t WS_WGU = WS_VTB + 8 * MiB;
constexpr size_t WS_WDN = WS_WGU + 768 * MiB;
constexpr size_t WS_WOUT = WS_WDN + 384 * MiB;
constexpr size_t WS_WSC = WS_WOUT + 128 * MiB;
constexpr size_t WS_WGDN = WS_WSC + 160 * MiB;
constexpr size_t WS_CHB = WS_WGDN + 212 * MiB;
constexpr size_t WS_UT = WS_CHB + 168 * MiB;
constexpr size_t WS_CD = WS_UT + 96 * MiB;
constexpr size_t WS_END = WS_CD + 1 * MiB;
constexpr int CW_BAR = 4096;

constexpr int RING_OFF = 0, RING_BYTES = 131072;
constexpr int XP_SCR = 64 * 65 * 4;
constexpr int LDSCTL_OFF = 139264, MISC_OFF = LDSCTL_OFF + 320;
static_assert(LDSCTL_OFF >= 8 * XP_SCR, "LDS map");
static_assert(LDSCTL_OFF >= RING_BYTES, "LDS map");
constexpr int LDS_BYTES = 147456;

#define GAS __attribute__((address_space(1)))
#define LAS __attribute__((address_space(3)))
typedef unsigned short bf16;
typedef unsigned v4u __attribute__((ext_vector_type(4)));
typedef unsigned v2u __attribute__((ext_vector_type(2)));
typedef float f32x4 __attribute__((ext_vector_type(4)));
typedef float f32x2 __attribute__((ext_vector_type(2)));
typedef short bf16x8 __attribute__((ext_vector_type(8)));
#define LDS_WAIT() asm volatile("s_waitcnt lgkmcnt(0)" ::: "memory")
#define VM_WAIT() asm volatile("s_waitcnt vmcnt(0)" ::: "memory")
__device__ __forceinline__ unsigned pk2(float lo, float hi) { return pg8::cvt_pk_bf16(lo, hi); }
__device__ __forceinline__ float bflo(unsigned u) { return __uint_as_float(u << 16); }
__device__ __forceinline__ float bfhi(unsigned u) { return __uint_as_float(u & 0xffff0000u); }
__device__ __forceinline__ float silu_f(float x) { return x * __builtin_amdgcn_rcpf(1.0f + __builtin_amdgcn_exp2f(x * -1.44269504089f)); }
__device__ __forceinline__ int opq_v(int x) { asm volatile("" : "+v"(x)); return x; }
__device__ __forceinline__ int opq_s(int x) { asm volatile("" : "+s"(x)); return x; }

#define XB_TMO      128
#define XB_XCNT(j)  (256  + 64 * (j))
#define XB_XSUB(j)  (1280 + 64 * (j))
#define XB_XGEN(j)  (2304 + 64 * (j))
#define XB_TOP      3328
#define XB_TOPGEN   3392
#define XCD_BAR_WORDS 3456
#define XB_SPIN_CAP (1u << 18)

__device__ __forceinline__ unsigned xb_ld(unsigned* p)              { return __hip_atomic_load(p, __ATOMIC_RELAXED, __HIP_MEMORY_SCOPE_AGENT); }
__device__ __forceinline__ unsigned xb_add(unsigned* p, unsigned v) { return __hip_atomic_fetch_add(p, v, __ATOMIC_RELAXED, __HIP_MEMORY_SCOPE_AGENT); }
__device__ __forceinline__ unsigned xb_xcc_id() { return (unsigned)__builtin_amdgcn_s_getreg((3 << 11) | 20) & 0xFu; }
#define XB_SPIN(cond, bar) do { unsigned _sp = 0; while (cond) { __builtin_amdgcn_s_sleep(1); \
    if ((++_sp & 255u) == 0u) { if (xb_ld(&(bar)[XB_TMO])) break; if (_sp > XB_SPIN_CAP) { atomicAdd(&(bar)[XB_TMO], 1u); break; } } } } while (0)

struct XcdBarrier {
    unsigned* bar; unsigned x;
    volatile LAS unsigned* st;
};
__device__ __forceinline__ XcdBarrier xcd_barrier_post(unsigned* bar, volatile LAS unsigned* st) {
    XcdBarrier b; b.bar = bar; b.x = xb_xcc_id(); b.st = st;
    if (threadIdx.x == 0) (void)xb_add(&bar[XB_XCNT(b.x)], 1u);
    return b;
}
__device__ __forceinline__ void xcd_barrier_complete(unsigned* bar, unsigned x, unsigned& nloc, unsigned& nx) {
    const unsigned G = gridDim.x * gridDim.y * gridDim.z;
    unsigned sum, cnt, mine, sp = 0u;
    for (;;) {
        sum = 0u; cnt = 0u; mine = 0u;
#pragma unroll
        for (unsigned j = 0; j < 16; ++j) { const unsigned c = xb_ld(&bar[XB_XCNT(j)]); sum += c; cnt += (c > 0u) ? 1u : 0u; mine = (j == x) ? c : mine; }
        if (sum == G) break;
        __builtin_amdgcn_s_sleep(1);
        if ((++sp & 255u) == 0u) { if (xb_ld(&bar[XB_TMO])) break; if (sp > XB_SPIN_CAP) { atomicAdd(&bar[XB_TMO], 1u); break; } }
    }
    nloc = mine > 0u ? mine : 1u; nx = cnt > 0u ? cnt : 1u;
}
__device__ __forceinline__ void xcd_barrier(const XcdBarrier& b) {
    asm volatile("s_waitcnt vmcnt(0)" ::: "memory");
    __syncthreads();
    if (threadIdx.x == 0) {
        unsigned* bar = b.bar;
        __builtin_amdgcn_s_waitcnt(0);
        unsigned nloc = b.st[0], nx = b.st[1];
        if (nloc == 0u) { xcd_barrier_complete(bar, b.x, nloc, nx); b.st[0] = nloc; b.st[1] = nx; }
        const unsigned old = xb_add(&bar[XB_XSUB(b.x)], 1u);
        const unsigned gen = old / nloc;
        if (old + 1u == (gen + 1u) * nloc) {
            __builtin_amdgcn_fence(__ATOMIC_RELEASE, "agent");
            asm volatile("s_waitcnt vmcnt(0)" ::: "memory");
            const unsigned og = xb_add(&bar[XB_TOP], 1u);
            const unsigned tg = og / nx;
            if (og + 1u == (tg + 1u) * nx) xb_add(&bar[XB_TOPGEN], 1u);
            else XB_SPIN(xb_ld(&bar[XB_TOPGEN]) == tg, bar);
            __builtin_amdgcn_fence(__ATOMIC_ACQUIRE, "agent");
            xb_add(&bar[XB_XGEN(b.x)], 1u);
            asm volatile("s_waitcnt vmcnt(0)" ::: "memory");
        } else {
            XB_SPIN(xb_ld(&bar[XB_XGEN(b.x)]) == gen, bar);
            __builtin_amdgcn_fence(__ATOMIC_ACQUIRE, "agent");
            asm volatile("s_waitcnt vmcnt(0)" ::: "memory");
        }
    }
    __syncthreads();
}

__device__ __forceinline__ float wave_sum(float v) {
#pragma unroll
    for (int o = 1; o < 64; o <<= 1) v += __shfl_xor(v, o);
    return v;
}
__device__ __forceinline__ float grp16_sum(float v) {
#pragma unroll
    for (int o = 1; o < 16; o <<= 1) v += __shfl_xor(v, o);
    return v;
}
template <int CTRL> __device__ __forceinline__ float dpp_mov(float v) {
    return __builtin_bit_cast(float, __builtin_amdgcn_update_dpp(0, __builtin_bit_cast(int, v), CTRL, 0xF, 0xF, true));
}
__device__ __forceinline__ float grp8_sum(float v) {
    v += dpp_mov<0xB1>(v); v += dpp_mov<0x4E>(v); v += dpp_mov<0x141>(v); return v;
}

__device__ __forceinline__ void xpose_load(f32x4 (&v)[16], const float* W, int N, int col0, int nvalid, int k0, int n0, int lane) {
    const int nn = n0 + 4 * (lane & 15); const bool ok = nn < nvalid;
    const float* p = W + (size_t)(k0 + (lane >> 4)) * N + col0 + nn;
#pragma unroll
    for (int i = 0; i < 16; ++i) v[i] = ok ? __builtin_nontemporal_load((const GAS f32x4*)(p + (size_t)(4 * i) * N)) : (f32x4){0.f, 0.f, 0.f, 0.f};
}
__device__ __forceinline__ void xpose_store(const f32x4 (&v)[16], bf16* WT, int Kd, int drow0, LAS float* scr, int k0, int lane) {
    LAS float* w = scr + (lane >> 4) * 65 + 4 * (lane & 15);
#pragma unroll
    for (int i = 0; i < 16; ++i) { w[(4 * i) * 65 + 0] = v[i][0]; w[(4 * i) * 65 + 1] = v[i][1]; w[(4 * i) * 65 + 2] = v[i][2]; w[(4 * i) * 65 + 3] = v[i][3]; }
    LDS_WAIT(); asm volatile("" ::: "memory");
    const int c = lane & 7;
#pragma unroll
    for (int j = 0; j < 8; ++j) { const int n = (lane >> 3) + 8 * j; const LAS float* s = scr + (8 * c) * 65 + n;
        v4u o; o.x = pk2(s[0 * 65], s[1 * 65]); o.y = pk2(s[2 * 65], s[3 * 65]); o.z = pk2(s[4 * 65], s[5 * 65]); o.w = pk2(s[6 * 65], s[7 * 65]);
        *(GAS v4u*)(WT + (size_t)(drow0 + n) * Kd + k0 + 8 * c) = o; }
    LDS_WAIT(); asm volatile("" ::: "memory");
}

struct Args { const float* in[19]; float* out; unsigned char* ws; };
enum { I_X = 0, I_MEM, I_FPRE, I_FPOST, I_MPRE, I_MPOST, I_MEMG, I_WG, I_WU, I_WD, I_WKV, I_WOUT, I_SCIN, I_SCCONV, I_GDNIN, I_GDNCONV, I_ALOG, I_DTB, I_NORMG };

__device__ __forceinline__ void norm_phase(int gw, int NGW, int lane, const bf16* outb, float w, const float* g_post, const float* hsrc, float* hdst, const float* g_pre, bf16* Adst) {
    for (int row = gw; row < MROWS; row += NGW) {
        const float* hr = hsrc + (size_t)row * DM;
        f32x4 hv[16];
#pragma unroll
        for (int j = 0; j < 8; ++j) { const int e = (j * 64 + lane) * 8; hv[2 * j] = *(const GAS f32x4*)(hr + e); hv[2 * j + 1] = *(const GAS f32x4*)(hr + e + 4); }
        if (outb) {
            v4u ov[8]; float ss = 0.f;
#pragma unroll
            for (int j = 0; j < 8; ++j) { ov[j] = *(const GAS v4u*)(outb + (size_t)row * DM + (j * 64 + lane) * 8);
#pragma unroll
                for (int q = 0; q < 4; ++q) { const float a = bflo(ov[j][q]), b = bfhi(ov[j][q]); ss += a * a + b * b; } }
            ss = wave_sum(ss);
            const float sc = w / sqrtf(ss * (1.0f / DM) + EPS);
#pragma unroll
            for (int j = 0; j < 8; ++j) { const int e = (j * 64 + lane) * 8;
                const f32x4 g0 = *(const GAS f32x4*)(g_post + e), g1 = *(const GAS f32x4*)(g_post + e + 4);
                f32x4 o0, o1; o0[0] = bflo(ov[j][0]); o0[1] = bfhi(ov[j][0]); o0[2] = bflo(ov[j][1]); o0[3] = bfhi(ov[j][1]);
                o1[0] = bflo(ov[j][2]); o1[1] = bfhi(ov[j][2]); o1[2] = bflo(ov[j][3]); o1[3] = bfhi(ov[j][3]);
                hv[2 * j] += o0 * g0 * sc; hv[2 * j + 1] += o1 * g1 * sc; }
        }
        if (hdst) { float* hw = hdst + (size_t)row * DM;
#pragma unroll
            for (int j = 0; j < 8; ++j) { const int e = (j * 64 + lane) * 8; *(GAS f32x4*)(hw + e) = hv[2 * j]; *(GAS f32x4*)(hw + e + 4) = hv[2 * j + 1]; } }
        if (Adst) {
            float ss = 0.f;
#pragma unroll
            for (int j = 0; j < 16; ++j) ss += (hv[j][0] * hv[j][0] + hv[j][1] * hv[j][1]) + (hv[j][2] * hv[j][2] + hv[j][3] * hv[j][3]);
            ss = wave_sum(ss);
            const float sc = 1.0f / sqrtf(ss * (1.0f / DM) + EPS);
#pragma unroll
            for (int j = 0; j < 8; ++j) { const int e = (j * 64 + lane) * 8;
                const f32x4 g0 = *(const GAS f32x4*)(g_pre + e), g1 = *(const GAS f32x4*)(g_pre + e + 4);
                const f32x4 a0 = hv[2 * j] * g0 * sc, a1 = hv[2 * j + 1] * g1 * sc;
                v4u o; o.x = pk2(a0[0], a0[1]); o.y = pk2(a0[2], a0[3]); o.z = pk2(a1[0], a1[1]); o.w = pk2(a1[2], a1[3]);
                *(GAS v4u*)(Adst + (size_t)row * DM + e) = o; }
        }
    }
}

__device__ __forceinline__ void xattn_unit(int unit, const bf16* proj, int ldp, int xq_col0, const bf16* Kb, const bf16* VTb, bf16* cat, int wave, int lane) {
    const int rb = unit & 15, h = (unit >> 4) & 3, b = unit >> 6;
    const int r0 = b * SEQ + rb * 128 + wave * 16, c15 = lane & 15, q4 = lane >> 4;
    bf16x8 qf[8];
    const bf16* qp = proj + (size_t)(r0 + c15) * ldp + xq_col0 + h * XHD + 8 * q4;
#pragma unroll
    for (int s = 0; s < 8; ++s) qf[s] = *(const GAS bf16x8*)(qp + 32 * s);
    f32x4 st[16];
    const bf16* kp = Kb + (size_t)(b * MEMT + c15) * 1024 + h * XHD + 8 * q4;
#pragma unroll
    for (int kb = 0; kb < 16; ++kb) { f32x4 acc = {0.f, 0.f, 0.f, 0.f};
#pragma unroll
        for (int s = 0; s < 8; ++s) { const bf16x8 kf = *(const GAS bf16x8*)(kp + (size_t)(16 * kb) * 1024 + 32 * s);
            acc = __builtin_amdgcn_mfma_f32_16x16x32_bf16(kf, qf[s], acc, 0, 0, 0); }
        st[kb] = acc; }
    float mx = -3.0e38f;
#pragma unroll
    for (int kb = 0; kb < 16; ++kb)
#pragma unroll
        for (int j = 0; j < 4; ++j) mx = fmaxf(mx, st[kb][j]);
    mx = fmaxf(mx, __shfl_xor(mx, 16)); mx = fmaxf(mx, __shfl_xor(mx, 32));
    const float sc = 0.0625f * 1.44269504089f; float sum = 0.f;
#pragma unroll
    for (int kb = 0; kb < 16; ++kb)
#pragma unroll
        for (int j = 0; j < 4; ++j) { const float p = __builtin_amdgcn_exp2f((st[kb][j] - mx) * sc); st[kb][j] = p; sum += p; }
    sum += __shfl_xor(sum, 16); sum += __shfl_xor(sum, 32);
    const float inv = 1.0f / sum;
    bf16x8 pf[8];
#pragma unroll
    for (int s = 0; s < 8; ++s) { v4u w; w.x = pk2(st[2 * s][0], st[2 * s][1]); w.y = pk2(st[2 * s][2], st[2 * s][3]); w.z = pk2(st[2 * s + 1][0], st[2 * s + 1][1]); w.w = pk2(st[2 * s + 1][2], st[2 * s + 1][3]);
        pf[s] = __builtin_bit_cast(bf16x8, w); }
    const bf16* vp = VTb + (size_t)(h * XHD + c15) * 1024 + b * MEMT + 4 * q4;
    bf16* op = cat + (size_t)(r0 + c15) * DM + MIXW + h * XHD + 4 * q4;
#pragma unroll 4
    for (int db = 0; db < 16; ++db) { f32x4 acc = {0.f, 0.f, 0.f, 0.f};
#pragma unroll
        for (int s = 0; s < 8; ++s) { const v2u lo = *(const GAS v2u*)(vp + (size_t)(16 * db) * 1024 + 32 * s), hi = *(const GAS v2u*)(vp + (size_t)(16 * db) * 1024 + 32 * s + 16);
            v4u w; w.x = lo.x; w.y = lo.y; w.z = hi.x; w.w = hi.y;
            acc = __builtin_amdgcn_mfma_f32_16x16x32_bf16(__builtin_bit_cast(bf16x8, w), pf[s], acc, 0, 0, 0); }
        v2u o; o.x = pk2(acc[0] * inv, acc[1] * inv); o.y = pk2(acc[2] * inv, acc[3] * inv);
        *(GAS v2u*)(op + 16 * db) = o; }
}

__device__ __forceinline__ void sc_gate_phase(int gw, int NGW, int lane, const bf16* proj, const float* convw, bf16* cat) {
    for (int task = gw; task < (MROWS / 16) * 6; task += NGW) {
        const int row0 = (task / 6) * 16, c = (task % 6) * 512 + lane * 8;
        float cw[3][8];
#pragma unroll
        for (int j = 0; j < 3; ++j) { const f32x4 a = *(const GAS f32x4*)(convw + j * MIXW + c), b = *(const GAS f32x4*)(convw + j * MIXW + c + 4);
            cw[j][0] = a[0]; cw[j][1] = a[1]; cw[j][2] = a[2]; cw[j][3] = a[3]; cw[j][4] = b[0]; cw[j][5] = b[1]; cw[j][6] = b[2]; cw[j][7] = b[3]; }
        float u2[8], u1[8];
#pragma unroll
        for (int e = 0; e < 8; ++e) { u2[e] = 0.f; u1[e] = 0.f; }
        if ((row0 % SEQ) != 0) {
#pragma unroll
            for (int hrow = 0; hrow < 2; ++hrow) { const bf16* pr = proj + (size_t)(row0 - 2 + hrow) * SC_IN + c;
                const v4u cv = *(const GAS v4u*)(pr + MIXW), hv = *(const GAS v4u*)(pr + 2 * MIXW);
#pragma unroll
                for (int q = 0; q < 4; ++q) { const float a = bflo(cv[q]) * bflo(hv[q]), b = bfhi(cv[q]) * bfhi(hv[q]);
                    if (hrow == 0) { u2[2 * q] = a; u2[2 * q + 1] = b; } else { u1[2 * q] = a; u1[2 * q + 1] = b; } } }
        }
#pragma unroll 4
        for (int r = 0; r < 16; ++r) { const bf16* pr = proj + (size_t)(row0 + r) * SC_IN + c;
            const v4u bv = *(const GAS v4u*)(pr), cv = *(const GAS v4u*)(pr + MIXW), hv = *(const GAS v4u*)(pr + 2 * MIXW);
            float u0[8], y[8];
#pragma unroll
            for (int q = 0; q < 4; ++q) { u0[2 * q] = bflo(cv[q]) * bflo(hv[q]); u0[2 * q + 1] = bfhi(cv[q]) * bfhi(hv[q]); }
#pragma unroll
            for (int q = 0; q < 4; ++q) {
                y[2 * q] = bflo(bv[q]) * (cw[0][2 * q] * u2[2 * q] + cw[1][2 * q] * u1[2 * q] + cw[2][2 * q] * u0[2 * q]);
                y[2 * q + 1] = bfhi(bv[q]) * (cw[0][2 * q + 1] * u2[2 * q + 1] + cw[1][2 * q + 1] * u1[2 * q + 1] + cw[2][2 * q + 1] * u0[2 * q + 1]); }
            v4u o; o.x = pk2(y[0], y[1]); o.y = pk2(y[2], y[3]); o.z = pk2(y[4], y[5]); o.w = pk2(y[6], y[7]);
            *(GAS v4u*)(cat + (size_t)(row0 + r) * DM + c) = o;
#pragma unroll
            for (int e = 0; e < 8; ++e) { u2[e] = u1[e]; u1[e] = u0[e]; } }
    }
}

__device__ __forceinline__ void gdn_prep_phase(int gw, int NGW, int lane, const bf16* proj, const float* convw, bf16* qkvn, const float* aux, const float* alog, const float* dtb, float* ab) {
    for (int task = gw; task < (MROWS / 16) * 18; task += NGW) {
        const int row0 = (task / 18) * 16, slot = (task % 18) * 4 + (lane >> 4), type = slot / GH, ch = slot * GHD + (lane & 15) * 8;
        float cw[4][8];
#pragma unroll
        for (int j = 0; j < 4; ++j) { const f32x4 a = *(const GAS f32x4*)(convw + j * (3 * MIXW) + ch), b = *(const GAS f32x4*)(convw + j * (3 * MIXW) + ch + 4);
            cw[j][0] = a[0]; cw[j][1] = a[1]; cw[j][2] = a[2]; cw[j][3] = a[3]; cw[j][4] = b[0]; cw[j][5] = b[1]; cw[j][6] = b[2]; cw[j][7] = b[3]; }
        float w0[8], w1[8], w2[8];
#pragma unroll
        for (int e = 0; e < 8; ++e) { w0[e] = 0.f; w1[e] = 0.f; w2[e] = 0.f; }
        if ((row0 % SEQ) != 0) {
#pragma unroll
            for (int hrow = 0; hrow < 3; ++hrow) { const v4u xv = *(const GAS v4u*)(proj + (size_t)(row0 - 3 + hrow) * GDN_LD + ch);
#pragma unroll
                for (int q = 0; q < 4; ++q) { const float a = bflo(xv[q]), b = bfhi(xv[q]);
                    if (hrow == 0) { w0[2 * q] = a; w0[2 * q + 1] = b; } else if (hrow == 1) { w1[2 * q] = a; w1[2 * q + 1] = b; } else { w2[2 * q] = a; w2[2 * q + 1] = b; } } }
        }
        const float post = (type == 0) ? 0.08838834764831845f : 1.0f;
#pragma unroll 4
        for (int r = 0; r < 16; ++r) { const v4u xv = *(const GAS v4u*)(proj + (size_t)(row0 + r) * GDN_LD + ch);
            float x[8], y[8]; float ss = 0.f;
#pragma unroll
            for (int q = 0; q < 4; ++q) { x[2 * q] = bflo(xv[q]); x[2 * q + 1] = bfhi(xv[q]); }
#pragma unroll
            for (int e = 0; e < 8; ++e) { const float v = cw[0][e] * w0[e] + cw[1][e] * w1[e] + cw[2][e] * w2[e] + cw[3][e] * x[e]; y[e] = silu_f(v); ss += y[e] * y[e]; }
            if (type < 2) { ss = grp16_sum(ss); const float sc = post / sqrtf(ss + EPS);
#pragma unroll
                for (int e = 0; e < 8; ++e) y[e] *= sc; }
            v4u o; o.x = pk2(y[0], y[1]); o.y = pk2(y[2], y[3]); o.z = pk2(y[4], y[5]); o.w = pk2(y[6], y[7]);
            *(GAS v4u*)(qkvn + (size_t)(row0 + r) * (3 * MIXW) + ch) = o;
#pragma unroll
            for (int e = 0; e < 8; ++e) { w0[e] = w1[e]; w1[e] = w2[e]; w2[e] = x[e]; } }
    }
    for (int idx = gw * 64 + lane; idx < MROWS * GH; idx += NGW * 64) { const int row = idx / GH, h = idx % GH;
        const float bi = aux[(size_t)row * 64 + h], ai = aux[(size_t)row * 64 + GH + h] + dtb[h];
        const float sp = ai > 20.f ? ai : log1pf(expf(ai));
        ab[(size_t)row * 48 + h] = 1.0f / (1.0f + expf(-bi));
        ab[(size_t)row * 48 + GH + h] = -expf(alog[h]) * sp; }
}

constexpr int NCHUNK = SEQ / 64;
constexpr int CHB_WC = 0, CHB_QD = 16384, CHB_IN = 32768, CHB_KT = 40960, CHB_BYTES = 57344;
constexpr int P2_PITCH = 272;
constexpr int P2_GC = 0, P2_BETA = 256, P2_EG = 512, P2_Q = 768, P2_K = P2_Q + 64 * P2_PITCH, P2_V = P2_K + 64 * P2_PITCH, P2_A = P2_V + 64 * P2_PITCH, P2_HALF = P2_A + 16384;
__device__ __forceinline__ unsigned short bf1(float x) { return (unsigned short)(pk2(x, 0.f) & 0xffffu); }
__device__ __forceinline__ float ldbf(const LAS unsigned char* p) { return __uint_as_float((unsigned)(*(const LAS unsigned short*)p) << 16); }

__device__ __forceinline__ void gdn_chunk_phase(int c, int G, int tid, LAS unsigned char* ldsb, const bf16* qkvn, const float* ab, unsigned char* chb, float* utb, float* cdb) {
    const int half = __builtin_amdgcn_readfirstlane(tid >> 8), w4 = __builtin_amdgcn_readfirstlane((tid >> 6) & 3);
    const int role = half ? (w4 - 2) : w4;
    const int ew = half ? w4 : (w4 - 2);
    const int npair = (NBATCH * GH * NCHUNK) / 2;
    for (int pr = c; pr < npair; pr += G) {
        const int ci = pr * 2 + half;
        const int n = ci % NCHUNK, bh = ci / NCHUNK, h = bh % GH, b = bh / GH;
        const size_t row0 = (size_t)b * SEQ + (size_t)n * 64;
        unsigned char* blob = chb + (size_t)ci * CHB_BYTES;
#define P2_FRESH() unsigned lbv = (unsigned)(size_t)(ldsb + half * P2_HALF), afv = lbv + P2_A; asm volatile("" : "+v"(lbv)); asm volatile("" : "+v"(afv)); \
        LAS unsigned char* lb = (LAS unsigned char*)(size_t)lbv; LAS float* Af = (LAS float*)(size_t)afv; LAS float* gcs = (LAS float*)(lb + P2_GC); LAS float* bts = (LAS float*)(lb + P2_BETA); LAS float* egs = (LAS float*)(lb + P2_EG); \
        const int t = opq_v(tid) & 255, lane = t & 63; (void)Af; (void)gcs; (void)bts; (void)egs; (void)lane
        { P2_FRESH();
#pragma unroll
        for (int e = 0; e < 12; ++e) { const int p = t + 256 * e; const int which = p >> 10, r = (p >> 4) & 63, c16 = p & 15;
            const v4u x = *(const GAS v4u*)(qkvn + (row0 + r) * (size_t)(3 * MIXW) + which * MIXW + h * GHD + c16 * 8);
            *(LAS v4u*)(lb + P2_Q + which * (64 * P2_PITCH) + r * P2_PITCH + c16 * 16) = x; }
        if (w4 == 0) { float g = ab[(row0 + lane) * 48 + GH + h]; const float be = ab[(row0 + lane) * 48 + h];
#pragma unroll
            for (int o = 1; o < 64; o <<= 1) { const float y = __shfl_up(g, o); if (lane >= o) g += y; }
            gcs[lane] = g; bts[lane] = be; egs[lane] = __expf(g); }
        }
        __syncthreads();
        { P2_FRESH();
            const int i15 = lane & 15, q4 = lane >> 4;
            bf16x8 kA[4], qA[4];
#pragma unroll
            for (int s = 0; s < 4; ++s) { kA[s] = *(const LAS bf16x8*)(lb + P2_K + (16 * w4 + i15) * P2_PITCH + (32 * s + 8 * q4) * 2);
                                          qA[s] = *(const LAS bf16x8*)(lb + P2_Q + (16 * w4 + i15) * P2_PITCH + (32 * s + 8 * q4) * 2); }
            bf16* In = (bf16*)(blob + CHB_IN);
#pragma unroll
            for (int nb = 0; nb < 4; ++nb) {
                const int jg = 16 * nb + i15;
                if (nb <= w4) {
                    f32x4 akk = {0.f, 0.f, 0.f, 0.f}, aqk = {0.f, 0.f, 0.f, 0.f};
#pragma unroll
                    for (int s = 0; s < 4; ++s) { const bf16x8 kB = *(const LAS bf16x8*)(lb + P2_K + (16 * nb + i15) * P2_PITCH + (32 * s + 8 * q4) * 2);
                        akk = __builtin_amdgcn_mfma_f32_16x16x32_bf16(kA[s], kB, akk, 0, 0, 0); aqk = __builtin_amdgcn_mfma_f32_16x16x32_bf16(qA[s], kB, aqk, 0, 0, 0); }
                    const float gj = gcs[jg];
#pragma unroll
                    for (int r = 0; r < 4; ++r) { const int ig = 16 * w4 + 4 * q4 + r;
                        const float dec = (ig >= jg) ? __expf(gcs[ig] - gj) : 0.f;
                        Af[ig * 64 + jg] = (ig > jg) ? bts[ig] * akk[r] * dec : 0.f;
                        *(GAS unsigned short*)(In + ig * 64 + jg) = bf1(aqk[r] * dec); }
                } else {
#pragma unroll
                    for (int r = 0; r < 4; ++r) { const int ig = 16 * w4 + 4 * q4 + r; *(GAS unsigned short*)(In + ig * 64 + jg) = 0; }
                }
            }
        }
        __syncthreads();
        if (role == 0 || role == 1) { P2_FRESH();
            f32x2 x[64];
            const LAS unsigned char* tp = lb + (role ? P2_K : P2_V) + lane * 2;
#pragma unroll
            for (int g8 = 0; g8 < 8; ++g8) {
#pragma unroll
                for (int ii = 0; ii < 8; ++ii) { const int i = 8 * g8 + ii; const float e = egs[i], sc = bts[i] * (role ? e : 1.0f);
                    x[i] = (f32x2){ldbf(tp + i * P2_PITCH) * sc, ldbf(tp + i * P2_PITCH + 128) * sc}; asm volatile("" : "+v"(x[i])); }
                __builtin_amdgcn_sched_barrier(0);
            }
            f32x4 cur[4], nxt[4];
            cur[0] = *(const LAS f32x4*)(Af + 64);
#define P2_ROWS(NSEG, ILO, IHI) \
            _Pragma("unroll") for (int i = (ILO); i <= (IHI); ++i) { \
                f32x2 a0 = x[i], a1 = {0.f, 0.f}; \
                _Pragma("unroll") for (int sg = 0; sg < (NSEG); ++sg) { \
                    const bool more = (sg + 1 < (NSEG)); const int ni = more ? i : i + 1, nsg = more ? sg + 1 : 0; \
                    if (ni < 64) { _Pragma("unroll") for (int q = 0; q < 4; ++q) if (16 * nsg + 4 * q < ni) nxt[q] = *(const LAS f32x4*)(Af + ni * 64 + 16 * nsg + 4 * q); } \
                    __builtin_amdgcn_sched_barrier(0); \
                    _Pragma("unroll") for (int jj = 0; jj < (more ? 16 : i - 16 * sg); ++jj) { const int j = 16 * sg + jj; const float aij = cur[jj >> 2][jj & 3]; if (j & 1) a1 -= x[j] * aij; else a0 -= x[j] * aij; } \
                    __builtin_amdgcn_sched_barrier(0); \
                    _Pragma("unroll") for (int q = 0; q < 4; ++q) cur[q] = nxt[q]; \
                } \
                x[i] = a0 + a1; \
            }
            P2_ROWS(1, 1, 16)
            P2_ROWS(2, 17, 32)
            P2_ROWS(3, 33, 48)
            P2_ROWS(4, 49, 63)
#undef P2_ROWS
            if (role == 0) { float* up = utb + (size_t)ci * 8192 + lane * 64;
#pragma unroll
                for (int i = 0; i < 16; ++i) { *(GAS f32x4*)(up + 4 * i) = (f32x4){x[4 * i][0], x[4 * i + 1][0], x[4 * i + 2][0], x[4 * i + 3][0]};
                                               *(GAS f32x4*)(up + 4096 + 4 * i) = (f32x4){x[4 * i][1], x[4 * i + 1][1], x[4 * i + 2][1], x[4 * i + 3][1]}; } }
            else { bf16* wp = (bf16*)(blob + CHB_WC) + lane;
#pragma unroll
                for (int i = 0; i < 64; ++i) { *(GAS unsigned short*)(wp + i * 128) = bf1(x[i][0]); *(GAS unsigned short*)(wp + i * 128 + 64) = bf1(x[i][1]); } }
        } else { P2_FRESH();
            const int t2 = ew * 64 + lane;
#pragma unroll
            for (int ps = 0; ps < 2; ++ps) { const int tt = t2 + 128 * ps; const int i = tt >> 2, cseg = (tt & 3) * 32; const float e = egs[i];
#pragma unroll
                for (int q = 0; q < 4; ++q) { const v4u xv = *(const LAS v4u*)(lb + P2_Q + i * P2_PITCH + (cseg + 8 * q) * 2);
                    v4u o; o.x = pk2(bflo(xv.x) * e, bfhi(xv.x) * e); o.y = pk2(bflo(xv.y) * e, bfhi(xv.y) * e); o.z = pk2(bflo(xv.z) * e, bfhi(xv.z) * e); o.w = pk2(bflo(xv.w) * e, bfhi(xv.w) * e);
                    *(GAS v4u*)(blob + CHB_QD + (i * 128 + cseg + 8 * q) * 2) = o; } }
            const float gl = gcs[63];
#pragma unroll
            for (int ps = 0; ps < 2; ++ps) { const int d = t2, hh = ps;
#pragma unroll
                for (int q = 0; q < 4; ++q) { float y[8];
#pragma unroll
                    for (int jj = 0; jj < 8; ++jj) { const int i = 32 * hh + 8 * q + jj; y[jj] = ldbf(lb + P2_K + i * P2_PITCH + d * 2) * __expf(gl - gcs[i]); }
                    v4u o; o.x = pk2(y[0], y[1]); o.y = pk2(y[2], y[3]); o.z = pk2(y[4], y[5]); o.w = pk2(y[6], y[7]);
                    *(GAS v4u*)(blob + CHB_KT + (d * 64 + 32 * hh + 8 * q) * 2) = o; } }
            if (t2 == 0) cdb[ci] = __expf(gl);
        }
        __syncthreads();
    }
#undef P2_FRESH
}

constexpr int S2_WC = 0, S2_QD = 18432, S2_IN = 36864, S2_KT = 47104, S2_BUF = 67584;
__device__ __forceinline__ bf16x8 s2_frag(const LAS unsigned char* p) {
    const v2u lo = *(const LAS v2u*)(p), hi = *(const LAS v2u*)(p + 32); v4u w; w.x = lo.x; w.y = lo.y; w.z = hi.x; w.w = hi.y; return __builtin_bit_cast(bf16x8, w);
}
__device__ __forceinline__ bf16x8 s2_pack(const f32x4& a, const f32x4& b) { v4u w; w.x = pk2(a[0], a[1]); w.y = pk2(a[2], a[3]); w.z = pk2(b[0], b[1]); w.w = pk2(b[2], b[3]); return __builtin_bit_cast(bf16x8, w); }
__device__ __forceinline__ void gdn_scan2_unit(int bh, LAS unsigned char* ldsb, const unsigned char* chb, const float* utb, const float* cdb, float* O, int tid, int wave, int lane) {
    const int b = bh / GH, h = bh % GH, i15 = lane & 15, q4 = lane >> 4, n0 = wave * 16;
    const size_t ci0 = (size_t)bh * NCHUNK;
    f32x4 S[8];
#pragma unroll
    for (int kb = 0; kb < 8; ++kb) S[kb] = (f32x4){0.f, 0.f, 0.f, 0.f};
    v4u r[7]; f32x4 utn[4];
#define S2_ISSUE(cc_) do { const unsigned char* bp_ = chb + (ci0 + (cc_)) * CHB_BYTES + tid * 16; \
        _Pragma("unroll") for (int e = 0; e < 7; ++e) r[e] = *(const GAS v4u*)(bp_ + e * 8192); \
        const float* up_ = utb + (ci0 + (cc_)) * 8192 + (n0 + i15) * 64 + 4 * q4; \
        _Pragma("unroll") for (int mb = 0; mb < 4; ++mb) utn[mb] = *(const GAS f32x4*)(up_ + 16 * mb); } while (0)
    S2_ISSUE(0);
    for (int cc = 0; cc < NCHUNK; ++cc) {
        LAS unsigned char* buf = ldsb + (cc & 1) * S2_BUF;
        *(LAS v4u*)(buf + S2_WC + (tid >> 4) * 288 + (tid & 15) * 16) = r[0];
        *(LAS v4u*)(buf + S2_WC + ((tid + 512) >> 4) * 288 + (tid & 15) * 16) = r[1];
        *(LAS v4u*)(buf + S2_QD + (tid >> 4) * 288 + (tid & 15) * 16) = r[2];
        *(LAS v4u*)(buf + S2_QD + ((tid + 512) >> 4) * 288 + (tid & 15) * 16) = r[3];
        *(LAS v4u*)(buf + S2_IN + (tid >> 3) * 160 + (tid & 7) * 16) = r[4];
        *(LAS v4u*)(buf + S2_KT + (tid >> 3) * 160 + (tid & 7) * 16) = r[5];
        *(LAS v4u*)(buf + S2_KT + ((tid + 512) >> 3) * 160 + (tid & 7) * 16) = r[6];
        f32x4 ut[4];
#pragma unroll
        for (int mb = 0; mb < 4; ++mb) ut[mb] = utn[mb];
        const float cd = cdb[ci0 + cc];
        __syncthreads();
        if (cc + 1 < NCHUNK) S2_ISSUE(cc + 1);
        bf16x8 sb[4];
#pragma unroll
        for (int s = 0; s < 4; ++s) sb[s] = s2_pack(S[2 * s], S[2 * s + 1]);
        f32x4 vn[4];
#pragma unroll
        for (int mb = 0; mb < 4; ++mb) { f32x4 acc = {0.f, 0.f, 0.f, 0.f};
#pragma unroll
            for (int s = 0; s < 4; ++s) acc = __builtin_amdgcn_mfma_f32_16x16x32_bf16(s2_frag(buf + S2_WC + (16 * mb + i15) * 288 + (32 * s + 4 * q4) * 2), sb[s], acc, 0, 0, 0);
            vn[mb] = ut[mb] - acc; }
        bf16x8 vb[2];
        vb[0] = s2_pack(vn[0], vn[1]); vb[1] = s2_pack(vn[2], vn[3]);
        float* op = O + ((size_t)b * SEQ + (size_t)cc * 64 + 4 * q4) * MIXW + h * GHD + n0 + i15;
#pragma unroll
        for (int mb = 0; mb < 4; ++mb) { f32x4 acc = {0.f, 0.f, 0.f, 0.f};
#pragma unroll
            for (int s = 0; s < 4; ++s) acc = __builtin_amdgcn_mfma_f32_16x16x32_bf16(s2_frag(buf + S2_QD + (16 * mb + i15) * 288 + (32 * s + 4 * q4) * 2), sb[s], acc, 0, 0, 0);
#pragma unroll
            for (int s2 = 0; s2 < 2; ++s2) acc = __builtin_amdgcn_mfma_f32_16x16x32_bf16(s2_frag(buf + S2_IN + (16 * mb + i15) * 160 + (32 * s2 + 4 * q4) * 2), vb[s2], acc, 0, 0, 0);
#pragma unroll
            for (int j = 0; j < 4; ++j) op[(size_t)(16 * mb + j) * MIXW] = acc[j]; }
#pragma unroll
        for (int kb = 0; kb < 8; ++kb) { f32x4 acc = S[kb] * cd;
#pragma unroll
            for (int s2 = 0; s2 < 2; ++s2) acc = __builtin_amdgcn_mfma_f32_16x16x32_bf16(s2_frag(buf + S2_KT + (16 * kb + i15) * 160 + (32 * s2 + 4 * q4) * 2), vb[s2], acc, 0, 0, 0);
            S[kb] = acc; }
    }
    __syncthreads();
#undef S2_ISSUE
}

__device__ __forceinline__ void gdn_out_phase(int gw, int NGW, int lane, const float* O, const bf16* proj, const float* normg, bf16* cat) {
    const int dl = (lane & 15) * 8;
    const f32x4 g0 = *(const GAS f32x4*)(normg + dl), g1 = *(const GAS f32x4*)(normg + dl + 4);
    for (int row = gw; row < MROWS; row += NGW) {
#pragma unroll 2
        for (int it = 0; it < 6; ++it) { const int ch = (it * 4 + (lane >> 4)) * GHD + dl;
            const f32x4 o0 = *(const GAS f32x4*)(O + (size_t)row * MIXW + ch), o1 = *(const GAS f32x4*)(O + (size_t)row * MIXW + ch + 4);
            const v4u zv = *(const GAS v4u*)(proj + (size_t)row * GDN_LD + 3 * MIXW + ch);
            float ss = (o0[0] * o0[0] + o0[1] * o0[1]) + (o0[2] * o0[2] + o0[3] * o0[3]) + (o1[0] * o1[0] + o1[1] * o1[1]) + (o1[2] * o1[2] + o1[3] * o1[3]);
            ss = grp16_sum(ss);
            const float r = 1.0f / sqrtf(ss * (1.0f / GHD) + EPS);
            float y[8];
            y[0] = o0[0] * r * g0[0] * silu_f(bflo(zv[0])); y[1] = o0[1] * r * g0[1] * silu_f(bfhi(zv[0])); y[2] = o0[2] * r * g0[2] * silu_f(bflo(zv[1])); y[3] = o0[3] * r * g0[3] * silu_f(bfhi(zv[1]));
            y[4] = o1[0] * r * g1[0] * silu_f(bflo(zv[2])); y[5] = o1[1] * r * g1[1] * silu_f(bfhi(zv[2])); y[6] = o1[2] * r * g1[2] * silu_f(bflo(zv[3])); y[7] = o1[3] * r * g1[3] * silu_f(bfhi(zv[3]));
            v4u w; w.x = pk2(y[0], y[1]); w.y = pk2(y[2], y[3]); w.z = pk2(y[4], y[5]); w.w = pk2(y[6], y[7]);
            *(GAS v4u*)(cat + (size_t)row * DM + ch) = w; }
    }
}

typedef unsigned char* const __attribute__((address_space(4)))* karg_tab_t;
__device__ __forceinline__ unsigned char* karg_ptr(int i) { asm volatile("" : "+s"(i)); return ((karg_tab_t)__builtin_amdgcn_kernarg_segment_ptr())[i]; }
#define INP(i) ((const float*)karg_ptr(i))
#define WSP(off) (karg_ptr(20) + (off))

__global__ void __launch_bounds__(NWAVES * 64, 2) fwd_kernel(Args args) {
    extern __shared__ __attribute__((aligned(16))) unsigned char lds[];
    LAS unsigned char* L = (LAS unsigned char*)lds;
    volatile LAS unsigned* MISC = (volatile LAS unsigned*)(L + MISC_OFF);
    const int tid0 = threadIdx.x;
    const int G = gridDim.x, c = blockIdx.x;
#define tid (opq_v(tid0))
#define lane (opq_v(tid0) & 63)
#define wave (__builtin_amdgcn_readfirstlane(opq_v(tid0) >> 6))
#define gw (opq_s(c) * NWAVES + __builtin_amdgcn_readfirstlane(opq_v(tid0) >> 6))
#define NGW (opq_s(G) * NWAVES)
    for (int u = tid0; u < (LDS_BYTES - LDSCTL_OFF) / 4; u += NWAVES * 64) ((LAS unsigned*)(L + LDSCTL_OFF))[u] = 0u;
    __syncthreads();
    (void)xcd_barrier_post((unsigned*)(WSP(WS_CTL)) + CW_BAR, MISC + 8);
#define GRID_BAR() do { XcdBarrier bar_; bar_.bar = (unsigned*)(WSP(WS_CTL)) + CW_BAR; bar_.x = xb_xcc_id(); bar_.st = MISC + 8; xcd_barrier(bar_); } while (0)
#if defined(TPROBE) && TPROBE == 8
#define TP_BEGIN(k) do { if ((k) == 3 && c == 0 && tid0 == 0) { const unsigned long long t_ = __builtin_amdgcn_s_memrealtime(), y_ = __builtin_amdgcn_s_memtime(); MISC[16] = (unsigned)t_; MISC[17] = (unsigned)(t_ >> 32); MISC[20] = (unsigned)y_; MISC[21] = (unsigned)(y_ >> 32); } } while (0)
#define TP_END(k) do { if ((k) == 3 && c == 0 && tid0 == 0) { const unsigned long long t_ = __builtin_amdgcn_s_memrealtime() - (((unsigned long long)MISC[17] << 32) | MISC[16]), y_ = __builtin_amdgcn_s_memtime() - (((unsigned long long)MISC[21] << 32) | MISC[20]); \
        const unsigned long long a_ = ((((unsigned long long)MISC[19] << 32) | MISC[18])) + t_, b_ = ((((unsigned long long)MISC[23] << 32) | MISC[22])) + y_; MISC[18] = (unsigned)a_; MISC[19] = (unsigned)(a_ >> 32); MISC[22] = (unsigned)b_; MISC[23] = (unsigned)(b_ >> 32); } } while (0)
#elif defined(TPROBE)
#define TP_BEGIN(k) do { if ((k) == TPROBE && c == 0 && tid0 == 0) { const unsigned long long t_ = __builtin_amdgcn_s_memrealtime(); MISC[16] = (unsigned)t_; MISC[17] = (unsigned)(t_ >> 32); } } while (0)
#define TP_END(k) do { if ((k) == TPROBE && c == 0 && tid0 == 0) { const unsigned long long t_ = __builtin_amdgcn_s_memrealtime() - (((unsigned long long)MISC[17] << 32) | MISC[16]); \
        const unsigned long long a_ = ((((unsigned long long)MISC[19] << 32) | MISC[18])) + t_; MISC[18] = (unsigned)a_; MISC[19] = (unsigned)(a_ >> 32); } } while (0)
#else
#define TP_BEGIN(k) do {} while (0)
#define TP_END(k) do {} while (0)
#endif
#ifdef NO_P0
#define PH_P0(x)
#else
#define PH_P0(x) x
#endif
#ifdef NO_KV
#define PH_KV(x)
#else
#define PH_KV(x) x
#endif
#ifdef NO_GU
#define PH_GU(x)
#else
#define PH_GU(x) x
#endif
#ifdef NO_DN
#define PH_DN(x)
#else
#define PH_DN(x) x
#endif
#ifdef NO_NORM
#define PH_NORM(x)
#else
#define PH_NORM(x) x
#endif
#ifdef NO_SCIN
#define PH_SCIN(x)
#else
#define PH_SCIN(x) x
#endif
#ifdef NO_SCG
#define PH_SCG(x)
#else
#define PH_SCG(x) x
#endif
#ifdef NO_XA
#define PH_XA(x)
#else
#define PH_XA(x) x
#endif
#ifdef NO_GDNIN
#define PH_GDNIN(x)
#else
#define PH_GDNIN(x) x
#endif
#ifdef NO_PREP
#define PH_PREP(x)
#else
#define PH_PREP(x) x
#endif
#ifdef NO_GOUT
#define PH_GOUT(x)
#else
#define PH_GOUT(x) x
#endif
#ifdef NO_WOUT
#define PH_WOUT(x)
#else
#define PH_WOUT(x) x
#endif
#ifdef NO_SCAN
#define DO_SCAN(x)
#else
#define DO_SCAN(x) x
#endif

#define Hbuf ((float*)WSP(WS_H))
#define Abuf ((bf16*)WSP(WS_A))
#define OUTb ((bf16*)WSP(WS_OUT))
#define CAT ((bf16*)WSP(WS_CAT))
#define ACT ((bf16*)WSP(WS_ACT))
#define PROJ ((bf16*)WSP(WS_PROJ))
#define AUX ((float*)WSP(WS_AUX))
#define AB ((float*)WSP(WS_AB))
#define QKVN ((bf16*)WSP(WS_QKV))
#define OBUF ((float*)WSP(WS_O))
#define KVOPS ((bf16*)WSP(WS_KVOPS))
#define KB ((bf16*)WSP(WS_KB))
#define VTB ((bf16*)WSP(WS_VTB))
#define WGU ((bf16*)WSP(WS_WGU))
#define WDN ((bf16*)WSP(WS_WDN))
#define WOUT ((bf16*)WSP(WS_WOUT))
#define WSC ((bf16*)WSP(WS_WSC))
#define WGDN ((bf16*)WSP(WS_WGDN))
#define CHB ((unsigned char*)WSP(WS_CHB))
#define UTB ((float*)WSP(WS_UT))
#define CDB ((float*)WSP(WS_CD))

    TP_BEGIN(1);
#ifndef NO_P0
    {
        LAS float* scr = (LAS float*)(L + RING_OFF + wave * XP_SCR);
        long base = 0;
        for (int job = 0; job < 40; ++job) {
            const float* W; bf16* WT; int K, N, col0 = 0, ncols, nvalid, mode = 0, roff = 0;
            if (job < 8)       { W = INP(I_WG) + (size_t)job * DM * DFF; K = DM; N = DFF; ncols = DFF; WT = WGU + (size_t)job * 2 * DFF * DM; mode = 1; roff = 0; }
            else if (job < 16) { W = INP(I_WU) + (size_t)(job - 8) * DM * DFF; K = DM; N = DFF; ncols = DFF; WT = WGU + (size_t)(job - 8) * 2 * DFF * DM; mode = 1; roff = 128; }
            else if (job < 24) { W = INP(I_WD) + (size_t)(job - 16) * DFF * DM; K = DFF; N = DM; ncols = DM; WT = WDN + (size_t)(job - 16) * DM * DFF; }
            else if (job < 28) { W = INP(I_WOUT) + (size_t)(job - 24) * DM * DM; K = DM; N = DM; ncols = DM; WT = WOUT + (size_t)(job - 24) * DM * DM; }
            else if (job < 32) { W = INP(I_WKV) + (size_t)(job - 28) * DM * 2 * XW; K = DM; N = 2 * XW; ncols = 2 * XW; WT = KVOPS + ((size_t)(job - 28) * 3072 + 1024) * DM; }
            else if (job < 34) { W = INP(I_SCIN) + (size_t)(job - 32) * DM * SC_IN; K = DM; N = SC_IN; ncols = SC_IN; WT = WSC + (size_t)(job - 32) * SC_IN * DM; }
            else if (job < 36) { W = INP(I_GDNIN) + (size_t)(job - 34) * DM * GDN_SRC; K = DM; N = GDN_SRC; ncols = 4 * MIXW; WT = WGDN + (size_t)(job - 34) * GDN_N * DM; }
            else if (job < 38) { W = INP(I_GDNIN) + (size_t)(job - 36) * DM * GDN_SRC; K = DM; N = GDN_SRC; col0 = 4 * MIXW + 2 * GH; ncols = XW; WT = WGDN + (size_t)(job - 36) * GDN_N * DM; roff = 4 * MIXW; }
            else               { W = INP(I_GDNIN) + (size_t)(job - 38) * DM * GDN_SRC; K = DM; N = GDN_SRC; col0 = 4 * MIXW; ncols = 64; WT = WGDN + (size_t)(job - 38) * GDN_N * DM; roff = GDN_LD; }
            nvalid = (job >= 38) ? 2 * GH : ncols;
            const int nblk = ncols / 64, items = (K / 64) * nblk;
            int first = (int)(((long)gw - base) % NGW); if (first < 0) first += NGW;
            const int step = NGW;
#define XP_DROW(nb_) (mode ? (256 * ((nb_) >> 1) + 64 * ((nb_) & 1) + roff) : (64 * (nb_) + roff))
            if (first < items) {
                f32x4 va[16], vb[16];
                int it = first;
                xpose_load(va, W, N, col0, nvalid, 64 * (it / nblk), 64 * (it % nblk), lane);
                for (;;) {
                    const int it1 = it + step;
                    if (it1 < items) xpose_load(vb, W, N, col0, nvalid, 64 * (it1 / nblk), 64 * (it1 % nblk), lane);
                    xpose_store(va, WT, K, XP_DROW(it % nblk), scr, 64 * (it / nblk), lane);
                    if (it1 >= items) break;
                    const int it2 = it1 + step;
                    if (it2 < items) xpose_load(va, W, N, col0, nvalid, 64 * (it2 / nblk), 64 * (it2 % nblk), lane);
                    xpose_store(vb, WT, K, XP_DROW(it1 % nblk), scr, 64 * (it1 / nblk), lane);
                    if (it2 >= items) break;
                    it = it2;
                }
            }
#undef XP_DROW
            base += items;
        }
        for (int r = gw; r < 2 * 192; r += NGW) { bf16* p = WGDN + ((size_t)(r / 192) * GDN_N + GDN_LD + 64 + (r % 192)) * DM;
#pragma unroll
            for (int j = 0; j < 8; ++j) *(GAS v4u*)(p + (j * 64 + lane) * 8) = (v4u){0u, 0u, 0u, 0u}; }
        for (int r = gw; r < NBATCH * MEMT; r += NGW) { const float* mr = INP(I_MEM) + (size_t)r * DM;
            f32x4 v[16]; float ss = 0.f;
#pragma unroll
            for (int j = 0; j < 16; ++j) { v[j] = *(const GAS f32x4*)(mr + (j * 64 + lane) * 4); ss += (v[j][0] * v[j][0] + v[j][1] * v[j][1]) + (v[j][2] * v[j][2] + v[j][3] * v[j][3]); }
            ss = wave_sum(ss); const float sc = 1.0f / sqrtf(ss * (1.0f / DM) + EPS);
            for (int l = 0; l < DEPTH; ++l) { const float* g = INP(I_MEMG) + (size_t)l * DM; bf16* dst = KVOPS + ((size_t)l * 3072 + r) * DM;
#pragma unroll
                for (int j = 0; j < 16; ++j) { const f32x4 gg = *(const GAS f32x4*)(g + (j * 64 + lane) * 4); const f32x4 a = v[j] * gg * sc;
                    v2u o; o.x = pk2(a[0], a[1]); o.y = pk2(a[2], a[3]); *(GAS v2u*)(dst + (j * 64 + lane) * 4) = o; } } }
        norm_phase(gw, NGW, lane, nullptr, 0.f, nullptr, INP(I_X), Hbuf, INP(I_FPRE), Abuf);
    }
#endif
    GRID_BAR();
    TP_END(1);

    TP_BEGIN(3);
    {
        pg8::Gemm g{KVOPS, KVOPS, 4 * 3072, 4 * 3072, DM}; pg8::KvOrder S{opq_s(G), opq_s(c)}; pg8::EpiKV E{KB, VTB};
        PH_KV((pg8::gemm_phase<pg8::EpiKV, pg8::KvOrder, PG8_ALIGN, PG8_SP2>(L + RING_OFF, g, S, E)));
    }
    TP_END(3);

#define FFN_GEMMS(f_) do { \
        TP_BEGIN(3); \
        { pg8::Gemm g{Abuf, WGU + (size_t)(l * 2 + (f_)) * 2 * DFF * DM, MROWS, 2 * DFF, DM}; pg8::StaticOrder S; S.init(MROWS, 2 * DFF, opq_s(G), opq_s(c)); pg8::EpiSwiGLU E{ACT, DFF}; \
          PH_GU((pg8::gemm_phase<pg8::EpiSwiGLU, pg8::StaticOrder, PG8_ALIGN, PG8_SP2>(L + RING_OFF, g, S, E))); } \
        GRID_BAR(); \
        { pg8::Gemm g{ACT, WDN + (size_t)(l * 2 + (f_)) * DM * DFF, MROWS, DM, DFF}; pg8::StaticOrder S; S.init(MROWS, DM, opq_s(G), opq_s(c)); pg8::EpiProj E{OUTb, DM, nullptr, -1}; \
          PH_DN((pg8::gemm_phase<pg8::EpiProj, pg8::StaticOrder, PG8_ALIGN, PG8_SP2>(L + RING_OFF, g, S, E))); } \
        GRID_BAR(); \
        TP_END(3); \
    } while (0)

    for (int l = 0; l < DEPTH; ++l) {
        const int j2 = l >> 1; const bool gdn = (l & 1) != 0;
        FFN_GEMMS(0);
        TP_BEGIN(6);
        PH_NORM(norm_phase(gw, NGW, lane, OUTb, 0.5f, INP(I_FPOST) + (size_t)(l * 2) * DM, Hbuf, Hbuf, INP(I_MPRE) + (size_t)l * DM, Abuf);)
        GRID_BAR();
        TP_END(6);
        if (!gdn) {
            TP_BEGIN(3);
            { pg8::Gemm g{Abuf, WSC + (size_t)j2 * SC_IN * DM, MROWS, SC_IN, DM}; pg8::StaticOrder S; S.init(MROWS, SC_IN, opq_s(G), opq_s(c)); pg8::EpiProj E{PROJ, SC_IN, nullptr, -1};
              PH_SCIN((pg8::gemm_phase<pg8::EpiProj, pg8::StaticOrder, PG8_ALIGN, PG8_SP2>(L + RING_OFF, g, S, E))); }
            GRID_BAR();
            TP_END(3);
            TP_BEGIN(4);
            PH_SCG(sc_gate_phase(gw, NGW, lane, PROJ, INP(I_SCCONV) + (size_t)j2 * 3 * MIXW, CAT);)
            for (int u = opq_s(c); u < 256; u += opq_s(G)) { PH_XA(xattn_unit(u, PROJ, SC_IN, 3 * MIXW, KB + (size_t)l * 1048576, VTB + (size_t)l * 1048576, CAT, wave, lane);) }
            GRID_BAR();
            TP_END(4);
        } else {
            TP_BEGIN(3);
            { pg8::Gemm g{Abuf, WGDN + (size_t)j2 * GDN_N * DM, MROWS, GDN_N, DM}; pg8::StaticOrder S; S.init(MROWS, GDN_N, opq_s(G), opq_s(c)); pg8::EpiProj E{PROJ, GDN_LD, AUX, GDN_LD / 256};
              PH_GDNIN((pg8::gemm_phase<pg8::EpiProj, pg8::StaticOrder, PG8_ALIGN, PG8_SP2>(L + RING_OFF, g, S, E))); }
            GRID_BAR();
            TP_END(3);
            TP_BEGIN(5);
            PH_PREP(gdn_prep_phase(gw, NGW, lane, PROJ, INP(I_GDNCONV) + (size_t)j2 * 4 * 3 * MIXW, QKVN, AUX, INP(I_ALOG) + j2 * GH, INP(I_DTB) + j2 * GH, AB);)
            GRID_BAR();
            TP_END(5);
            TP_BEGIN(2);
            DO_SCAN(gdn_chunk_phase(opq_s(c), opq_s(G), tid, L + RING_OFF, QKVN, AB, CHB, UTB, CDB));
            GRID_BAR();
            TP_END(2);
            TP_BEGIN(7);
            {
                const int nscan = NBATCH * GH;
                const int cq = opq_s(c);
                if (opq_s(G) == 256) {
                    if (cq < nscan) { DO_SCAN(gdn_scan2_unit(cq, L + RING_OFF, CHB, UTB, CDB, OBUF, tid, wave, lane)); }
                    else for (int u = cq - nscan; u < 256; u += 256 - nscan) { PH_XA(xattn_unit(u, PROJ, GDN_LD, 4 * MIXW, KB + (size_t)l * 1048576, VTB + (size_t)l * 1048576, CAT, wave, lane);) }
                } else {
                    for (int u = opq_s(c); u < nscan; u += opq_s(G)) { DO_SCAN(gdn_scan2_unit(u, L + RING_OFF, CHB, UTB, CDB, OBUF, tid, wave, lane)); }
                    for (int u = opq_s(c); u < 256; u += opq_s(G)) { PH_XA(xattn_unit(u, PROJ, GDN_LD, 4 * MIXW, KB + (size_t)l * 1048576, VTB + (size_t)l * 1048576, CAT, wave, lane);) }
                }
            }
            GRID_BAR();
            TP_END(7);
            TP_BEGIN(5);
            PH_GOUT(gdn_out_phase(gw, NGW, lane, OBUF, PROJ, INP(I_NORMG) + j2 * GHD, CAT);)
            GRID_BAR();
            TP_END(5);
        }
        TP_BEGIN(3);
        { pg8::Gemm g{CAT, WOUT + (size_t)l * DM * DM, MROWS, DM, DM}; pg8::StaticOrder S; S.init(MROWS, DM, opq_s(G), opq_s(c)); pg8::EpiProj E{OUTb, DM, nullptr, -1};
          PH_WOUT((pg8::gemm_phase<pg8::EpiProj, pg8::StaticOrder, PG8_ALIGN, PG8_SP2>(L + RING_OFF, g, S, E))); }
        GRID_BAR();
        TP_END(3);
        TP_BEGIN(6);
        PH_NORM(norm_phase(gw, NGW, lane, OUTb, 1.0f, INP(I_MPOST) + (size_t)l * DM, Hbuf, Hbuf, INP(I_FPRE) + (size_t)(l * 2 + 1) * DM, Abuf);)
        GRID_BAR();
        TP_END(6);
        FFN_GEMMS(1);
        TP_BEGIN(6);
        if (l < DEPTH - 1) {
            PH_NORM(norm_phase(gw, NGW, lane, OUTb, 0.5f, INP(I_FPOST) + (size_t)(l * 2 + 1) * DM, Hbuf, Hbuf, INP(I_FPRE) + (size_t)((l + 1) * 2) * DM, Abuf);)
            GRID_BAR();
        } else {
            PH_NORM(norm_phase(gw, NGW, lane, OUTb, 0.5f, INP(I_FPOST) + (size_t)(l * 2 + 1) * DM, Hbuf, ((float*)karg_ptr(19)), nullptr, nullptr);)
        }
        TP_END(6);
    }
#ifdef TPROBE
    if (c == 0 && tid0 == 0) { unsigned long long a_ = (((unsigned long long)MISC[19] << 32) | MISC[18]); const unsigned long long t0_ = __builtin_amdgcn_s_memrealtime();
#if TPROBE == 8
        { const unsigned long long b_ = (((unsigned long long)MISC[23] << 32) | MISC[22]); a_ = b_ * 10000ull / (a_ ? a_ : 1ull); }
#endif
        while (__builtin_amdgcn_s_memrealtime() - t0_ < a_) __builtin_amdgcn_s_sleep(8); }
#endif
#undef FFN_GEMMS
#undef GRID_BAR
#undef tid
#undef lane
#undef wave
#undef gw
#undef NGW
}

extern "C" void kernel_launch(void* const* d_in, const int* in_sizes, int n_in, void* d_out, int out_size, void* d_ws, size_t ws_size, hipStream_t stream) {
    static int grid = 0;
    if (grid == 0) {
        if (n_in != 19 || in_sizes[0] != MROWS * DM || out_size != MROWS * DM || ws_size < WS_END) {
            fprintf(stderr, "kernel_launch: unexpected problem (n_in %d, in0 %d, out %d, ws %zu, need %zu); nothing launched\n", n_in, n_in > 0 ? in_sizes[0] : -1, out_size, ws_size, (size_t)WS_END); grid = -1; return; }
        int dev = 0, cus = 0, per_cu = 0;
        if (hipGetDevice(&dev) != hipSuccess || hipDeviceGetAttribute(&cus, hipDeviceAttributeMultiprocessorCount, dev) != hipSuccess) { fprintf(stderr, "kernel_launch: device query failed\n"); grid = -1; return; }
        if (hipFuncSetAttribute((const void*)fwd_kernel, hipFuncAttributeMaxDynamicSharedMemorySize, LDS_BYTES) != hipSuccess) { fprintf(stderr, "kernel_launch: hipFuncSetAttribute failed\n"); grid = -1; return; }
        if (hipOccupancyMaxActiveBlocksPerMultiprocessor(&per_cu, (const void*)fwd_kernel, NWAVES * 64, LDS_BYTES) != hipSuccess || per_cu < 1)
            fprintf(stderr, "kernel_launch: note: occupancy query reports %d workgroups per CU\n", per_cu);
        (void)hipGetLastError();
        grid = cus;
    }
    if (grid < 0) return;
    if (hipMemsetAsync((char*)d_ws + WS_CTL, 0, CTL_ZERO_BYTES, stream) != hipSuccess) { fprintf(stderr, "kernel_launch: memset failed\n"); return; }
    Args a{};
    for (int i = 0; i < 19; ++i) a.in[i] = (const float*)d_in[i];
    a.out = (float*)d_out; a.ws = (unsigned char*)d_ws;
    hipLaunchKernelGGL(fwd_kernel, dim3(grid), dim3(NWAVES * 64), LDS_BYTES, stream, a);
    const hipError_t le = hipPeekAtLastError();
    if (le != hipSuccess) fprintf(stderr, "kernel_launch: launch failed: %s\n", hipGetErrorName(le));
}
```

```cpp
#include <hip/hip_runtime.h>
#include <cstdio>
#include <cstdint>
namespace pg8 {
#define PG8_LAS __attribute__((address_space(3)))
typedef unsigned short bf16_t;
typedef short bf16x8 __attribute__((ext_vector_type(8)));
typedef float f32x4 __attribute__((ext_vector_type(4)));
typedef unsigned u32x4 __attribute__((ext_vector_type(4)));
constexpr int BM = 256, BK = 64, HALF = 128, HTB = HALF * BK * 2  , STAGE_BYTES = 8 * HTB, NXCD = 8, WGM = 8;

__host__ __device__ __forceinline__ int lds_byte(int r, int c) { const int st = (r >> 4) * 2 + (c >> 5), rr = r & 15, cc = c & 31, ob = rr * 64 + cc * 2; return st * 1024 + (ob ^ (((ob >> 9) & 1) << 5)); }
__host__ __device__ __forceinline__ void stage_rc(int b, int& R, int& C) { const int st = b / 1024, sb = b % 1024, swz = sb ^ (((sb >> 9) & 1) << 5); R = (st >> 1) * 16 + swz / 64; C = (st & 1) * 32 + (swz % 64) / 2; }
__host__ __device__ __forceinline__ int perm32(int rho) { const int n = rho >> 4, i = rho & 15; return 8 * (i >> 2) + 4 * n + (i & 3); }

struct Unit { int pm, pn; };
struct Gemm { const bf16_t* A; const bf16_t* Bt; int M, N, K; };

struct StaticOrder {
    int nM, nN, nwg, G, c;
    __host__ __device__ void init(int M, int N, int G_, int c_) { nM = M / BM; nN = N / BM; nwg = nM * nN; G = G_; c = c_; }
    __host__ __device__ bool next(int i, Unit& u) const {
        const long L = (long)i * G + c; if (L >= nwg) return false;
        int wgid = (int)L; { const int q = nwg / NXCD, r = nwg % NXCD, xcd = wgid % NXCD, off = wgid / NXCD; wgid = (xcd < r ? xcd * (q + 1) : r * (q + 1) + (xcd - r) * q) + off; }
        const int nig = WGM * nN, gid = wgid / nig, fm = gid * WGM, gsz = (nM - fm) < WGM ? (nM - fm) : WGM;
        u.pm = fm + ((wgid % nig) % gsz); u.pn = (wgid % nig) / gsz; return true;
    }
    __device__ __forceinline__ void a_ready(const Unit&) const {}
    __device__ __forceinline__ void done(const Unit&) const {}
};

__device__ __forceinline__ unsigned cvt_pk_bf16(float lo, float hi) { unsigned r; asm volatile("v_cvt_pk_bf16_f32 %0, %1, %2" : "=v"(r) : "v"(lo), "v"(hi)); return r; }

struct EpiProj {
    static constexpr bool PERM = true, AFTER_DRAIN = false;
    bf16_t* O; int ldc; float* aux; int aux_pn;
    __device__ __forceinline__ void operator()(const f32x4 (&acc)[2][2][4][2], const Unit& u, int wr, int wc, int fr, int fq) const {
        const int row0 = u.pm * BM + wr * 64 + fr;
        if (u.pn == aux_pn) {
            if (wc < 2) {
#pragma unroll
                for (int ai = 0; ai < 2; ++ai)
#pragma unroll
                    for (int m = 0; m < 4; ++m) { float* rowp = aux + (size_t)(row0 + ai * HALF + m * 16) * 64 + wc * 32 + 8 * fq;
                        *(f32x4*)(rowp) = acc[ai][0][m][0]; *(f32x4*)(rowp + 4) = acc[ai][0][m][1]; }
            }
            return;
        }
        const int col0 = u.pn * BM + wc * 32 + 8 * fq;
#pragma unroll
        for (int ai = 0; ai < 2; ++ai)
#pragma unroll
            for (int m = 0; m < 4; ++m) { bf16_t* rowp = O + (size_t)(row0 + ai * HALF + m * 16) * ldc + col0;
#pragma unroll
                for (int bj = 0; bj < 2; ++bj) { const f32x4 v0 = acc[ai][bj][m][0], v1 = acc[ai][bj][m][1];
                    u32x4 w; w.x = cvt_pk_bf16(v0[0], v0[1]); w.y = cvt_pk_bf16(v0[2], v0[3]); w.z = cvt_pk_bf16(v1[0], v1[1]); w.w = cvt_pk_bf16(v1[2], v1[3]);
                    *(u32x4*)(rowp + bj * HALF) = w; } }
    }
};
struct EpiSwiGLU {
    static constexpr bool PERM = true, AFTER_DRAIN = false;
    bf16_t* O; int ldc;
    __device__ __forceinline__ void operator()(const f32x4 (&acc)[2][2][4][2], const Unit& u, int wr, int wc, int fr, int fq) const {
        const int row0 = u.pm * BM + wr * 64 + fr, col0 = u.pn * HALF + wc * 32 + 8 * fq;
#pragma unroll
        for (int ai = 0; ai < 2; ++ai)
#pragma unroll
            for (int m = 0; m < 4; ++m) { bf16_t* rowp = O + (size_t)(row0 + ai * HALF + m * 16) * ldc + col0;
                f32x4 r[2];
#pragma unroll
                for (int n = 0; n < 2; ++n)
#pragma unroll
                    for (int j = 0; j < 4; ++j) { const float g = acc[ai][0][m][n][j], up = acc[ai][1][m][n][j];
                        r[n][j] = g * up * __builtin_amdgcn_rcpf(1.0f + __builtin_amdgcn_exp2f(g * -1.44269504089f)); }
                u32x4 w; w.x = cvt_pk_bf16(r[0][0], r[0][1]); w.y = cvt_pk_bf16(r[0][2], r[0][3]); w.z = cvt_pk_bf16(r[1][0], r[1][1]); w.w = cvt_pk_bf16(r[1][2], r[1][3]);
                *(u32x4*)(rowp) = w; }
    }
};
struct EpiKV {
    static constexpr bool PERM = true, AFTER_DRAIN = false;
    bf16_t* Kb; bf16_t* VTb;
    __device__ __forceinline__ void operator()(const f32x4 (&acc)[2][2][4][2], const Unit& u, int wr, int wc, int fr, int fq) const {
        const int l = u.pm / 12, ri = u.pm % 12, rj = u.pn % 12;
        bf16_t* base = (ri < 4) ? Kb + (size_t)l * 1048576 + (size_t)(ri * 256) * 1024 + (rj - 4) * 256
                                : VTb + (size_t)l * 1048576 + (size_t)((ri - 8) * 256) * 1024 + rj * 256;
        const int row0 = wr * 64 + fr, col0 = wc * 32 + 8 * fq;
        const int p0 = 8 * ((2 * fq) & 3) + 4 * (fq >> 1), p1 = 8 * ((2 * fq + 1) & 3) + 4 * (fq >> 1);
        typedef unsigned u32x2e __attribute__((ext_vector_type(2)));
#pragma unroll
        for (int ai = 0; ai < 2; ++ai)
#pragma unroll
            for (int m = 0; m < 4; ++m) { bf16_t* rowp = base + (size_t)(row0 + ai * HALF + m * 16) * 1024;
#pragma unroll
                for (int bj = 0; bj < 2; ++bj) { const f32x4 v0 = acc[ai][bj][m][0], v1 = acc[ai][bj][m][1];
                    u32x4 w; w.x = cvt_pk_bf16(v0[0], v0[1]); w.y = cvt_pk_bf16(v0[2], v0[3]); w.z = cvt_pk_bf16(v1[0], v1[1]); w.w = cvt_pk_bf16(v1[2], v1[3]);
                    if (ri < 4) *(u32x4*)(rowp + col0 + bj * HALF) = w;
                    else { *(u32x2e*)(rowp + wc * 32 + bj * HALF + p0) = (u32x2e){w.x, w.y}; *(u32x2e*)(rowp + wc * 32 + bj * HALF + p1) = (u32x2e){w.z, w.w}; } } }
    }
};
struct KvOrder {
    int G, c;
    __device__ __forceinline__ bool next(int i, Unit& u) const {
        const int L = i * G + c; if (L >= 128) return false;
        const int l = L >> 5, r = L & 31;
        if (r < 16) { u.pm = 12 * l + (r >> 2); u.pn = 12 * l + 4 + (r & 3); }
        else { u.pm = 12 * l + 8 + ((r - 16) >> 2); u.pn = 12 * l + (r & 3); }
        return true;
    }
    __device__ __forceinline__ void a_ready(const Unit&) const {}
    __device__ __forceinline__ void done(const Unit&) const {}
};

template <class Epi, class Sched, bool ALIGN_EPI = false, bool SP2 = false>
__device__ __forceinline__ void gemm_phase(PG8_LAS unsigned char* lds, const Gemm g, const Sched& S, const Epi& E) {
    int tid_o = threadIdx.x; asm volatile("" : "+v"(tid_o));
    const int tid = tid_o, wid = __builtin_amdgcn_readfirstlane(tid >> 6), lane = tid & 63, wr = wid >> 2, wc = wid & 3, fr = lane & 15, fq = lane >> 4;
    const int K = g.K, nt = K / BK;
    unsigned voffA[2], voffB[2];
#pragma unroll
    for (int i = 0; i < 2; ++i) { int R, C; stage_rc(tid * 16 + i * 8192, R, C); const int Rb = Epi::PERM ? ((R & ~31) + perm32(R & 31)) : R;
        voffA[i] = (unsigned)(R * K + C) * 2u; voffB[i] = (unsigned)(Rb * K + C) * 2u; }
    const size_t kstep = (size_t)(BK * 2);
    const size_t hstep = (size_t)HALF * K * 2;
    const size_t tstep = 2 * hstep;
    const unsigned ldsw = (unsigned)wid * 1024u;
    const int aoff = lds_byte(wr * 64 + fr, fq * 8), boff = lds_byte(wc * 32 + fr, fq * 8);
#define PG8_SA(b, h) (((b) * 2 + (h)) * HTB)
#define PG8_SB(b, h) ((4 + (b) * 2 + (h)) * HTB)
#define PG8_STAGE(bufoff, gbase, voff) do { _Pragma("unroll") for (int _i = 0; _i < 2; ++_i) \
        __builtin_amdgcn_global_load_lds((const unsigned*)((const char*)(gbase) + (voff)[_i]), (PG8_LAS unsigned*)(lds + (bufoff) + ldsw + _i * 8192), 16, 0, 0); } while (0)
#define PG8_LDA(dst, b, h) do { _Pragma("unroll") for (int m = 0; m < 4; ++m) _Pragma("unroll") for (int k = 0; k < 2; ++k) dst[m][k] = *(const PG8_LAS bf16x8*)(lds + PG8_SA(b, h) + aoff + m * 2048 + k * 1024); } while (0)
#define PG8_LDB(dst, b, h) do { _Pragma("unroll") for (int n = 0; n < 2; ++n) _Pragma("unroll") for (int k = 0; k < 2; ++k) dst[n][k] = *(const PG8_LAS bf16x8*)(lds + PG8_SB(b, h) + boff + n * 2048 + k * 1024); } while (0)
#define PG8_MMA(ai, bj, At, Bt) do { __builtin_amdgcn_s_setprio(1); _Pragma("unroll") for (int m = 0; m < 4; ++m) _Pragma("unroll") for (int n = 0; n < 2; ++n) _Pragma("unroll") for (int k = 0; k < 2; ++k) \
        acc[ai][bj][m][n] = __builtin_amdgcn_mfma_f32_16x16x32_bf16(Bt[n][k], At[m][k], acc[ai][bj][m][n], 0, 0, 0); __builtin_amdgcn_s_setprio(0); } while (0)
#define PG8_WAIT_V(n) asm volatile("s_waitcnt vmcnt(" #n ")" ::: "memory")
#define PG8_WAIT_L(n) asm volatile("s_waitcnt lgkmcnt(" #n ")" ::: "memory")
#define PG8_BAR __builtin_amdgcn_s_barrier()
#define PG8_SCHED __builtin_amdgcn_sched_barrier(0)
    Unit cur, nxt; int ui = 0;
    if (!S.next(0, cur)) return;
    f32x4 acc[2][2][4][2];
#pragma unroll
    for (int a = 0; a < 2; ++a)
#pragma unroll
        for (int b = 0; b < 2; ++b)
#pragma unroll
            for (int m = 0; m < 4; ++m)
#pragma unroll
                for (int n = 0; n < 2; ++n) acc[a][b][m][n] = (f32x4){0.f, 0.f, 0.f, 0.f};
    bf16x8 At[4][2], B0[2][2], B1[2][2];
    const char* cA = (const char*)g.A + (size_t)cur.pm * tstep; const char* cB = (const char*)g.Bt + (size_t)cur.pn * tstep;
    S.a_ready(cur);
    if constexpr (SP2) {
        PG8_STAGE(PG8_SB(0, 0), cB, voffB); PG8_STAGE(PG8_SB(0, 1), cB + hstep, voffB); PG8_STAGE(PG8_SA(0, 0), cA, voffA); PG8_STAGE(PG8_SA(0, 1), cA + hstep, voffA);
        if (wr == 1) PG8_BAR;
        PG8_WAIT_V(2); PG8_BAR;
        PG8_STAGE(PG8_SB(1, 0), cB + kstep, voffB); PG8_STAGE(PG8_SA(1, 0), cA + kstep, voffA); PG8_STAGE(PG8_SB(1, 1), cB + hstep + kstep, voffB);
        PG8_WAIT_V(6); PG8_BAR;
    } else {
        PG8_STAGE(PG8_SB(0, 0), cB, voffB); PG8_STAGE(PG8_SA(0, 0), cA, voffA); PG8_STAGE(PG8_SB(0, 1), cB + hstep, voffB); PG8_STAGE(PG8_SA(0, 1), cA + hstep, voffA);
        if (wr == 1) PG8_BAR;
        PG8_WAIT_V(4); PG8_BAR;
        PG8_STAGE(PG8_SB(1, 0), cB + kstep, voffB); PG8_STAGE(PG8_SA(1, 0), cA + kstep, voffA); PG8_STAGE(PG8_SB(1, 1), cB + hstep + kstep, voffB);
        PG8_WAIT_V(6); PG8_BAR;
    }
    for (;;) {
        const bool has_next = S.next(ui + 1, nxt);
        const char* nA = has_next ? (const char*)g.A + (size_t)nxt.pm * tstep : cA; const char* nB = has_next ? (const char*)g.Bt + (size_t)nxt.pn * tstep : cB;
        for (int t = 0; t < nt; t += 2) {
            const bool last = (t == nt - 2);
            const char* a1 = cA + (size_t)(t + 1) * kstep;
            const char* a2 = last ? nA : cA + (size_t)(t + 2) * kstep; const char* b2 = last ? nB : cB + (size_t)(t + 2) * kstep;
            const char* a3 = a2 + kstep; const char* b3 = b2 + kstep;
            if (last && has_next) S.a_ready(nxt);
            if constexpr (SP2) {
            PG8_LDB(B0, 0, 0); PG8_LDB(B1, 0, 1); PG8_SCHED; PG8_LDA(At, 0, 0); PG8_STAGE(PG8_SA(1, 1), a1 + hstep, voffA);
            PG8_WAIT_V(8); PG8_WAIT_L(0); PG8_BAR; PG8_MMA(0, 0, At, B0); PG8_MMA(0, 1, At, B1); PG8_BAR; PG8_SCHED;
            PG8_LDA(At, 0, 1); PG8_STAGE(PG8_SB(0, 0), b2, voffB); PG8_STAGE(PG8_SB(0, 1), b2 + hstep, voffB); PG8_STAGE(PG8_SA(0, 0), a2, voffA);
            PG8_WAIT_V(8); PG8_WAIT_L(0); PG8_BAR; PG8_MMA(1, 0, At, B0); PG8_MMA(1, 1, At, B1); PG8_BAR; PG8_SCHED;
            PG8_LDB(B0, 1, 0); PG8_LDB(B1, 1, 1); PG8_SCHED; PG8_LDA(At, 1, 0); PG8_STAGE(PG8_SA(0, 1), a2 + hstep, voffA);
            PG8_WAIT_V(8); PG8_WAIT_L(0); PG8_BAR; PG8_MMA(0, 0, At, B0); PG8_MMA(0, 1, At, B1); PG8_BAR; PG8_SCHED;
            PG8_LDA(At, 1, 1); PG8_STAGE(PG8_SB(1, 0), b3, voffB); PG8_STAGE(PG8_SB(1, 1), b3 + hstep, voffB); PG8_STAGE(PG8_SA(1, 0), a3, voffA);
            PG8_WAIT_V(8); PG8_WAIT_L(0); PG8_BAR; PG8_MMA(1, 0, At, B0); PG8_MMA(1, 1, At, B1); PG8_BAR; PG8_SCHED;
            } else {
            PG8_LDB(B0, 0, 0); PG8_SCHED; PG8_LDA(At, 0, 0); PG8_STAGE(PG8_SA(1, 1), a1 + hstep, voffA);
            PG8_WAIT_L(8); PG8_BAR; PG8_WAIT_L(0); PG8_MMA(0, 0, At, B0); PG8_BAR; PG8_SCHED;
            PG8_LDB(B1, 0, 1); PG8_STAGE(PG8_SB(0, 0), b2, voffB);
            PG8_BAR; PG8_WAIT_L(0); PG8_MMA(0, 1, At, B1); PG8_BAR;
            PG8_LDA(At, 0, 1); PG8_STAGE(PG8_SA(0, 0), a2, voffA);
            PG8_BAR; PG8_WAIT_L(0); PG8_MMA(1, 0, At, B0); PG8_BAR; PG8_SCHED;
            PG8_STAGE(PG8_SB(0, 1), b2 + hstep, voffB);
            PG8_WAIT_V(6); PG8_BAR; PG8_MMA(1, 1, At, B1); PG8_BAR;
            PG8_LDB(B0, 1, 0); PG8_SCHED; PG8_LDA(At, 1, 0); PG8_STAGE(PG8_SA(0, 1), a2 + hstep, voffA);
            PG8_WAIT_L(8); PG8_BAR; PG8_WAIT_L(0); PG8_MMA(0, 0, At, B0); PG8_BAR; PG8_SCHED;
            PG8_LDB(B1, 1, 1); PG8_STAGE(PG8_SB(1, 0), b3, voffB);
            PG8_BAR; PG8_WAIT_L(0); PG8_MMA(0, 1, At, B1); PG8_BAR;
            PG8_LDA(At, 1, 1); PG8_STAGE(PG8_SA(1, 0), a3, voffA);
            PG8_BAR; PG8_WAIT_L(0); PG8_MMA(1, 0, At, B0); PG8_BAR; PG8_SCHED;
            PG8_STAGE(PG8_SB(1, 1), b3 + hstep, voffB);
            PG8_WAIT_V(6); PG8_BAR; PG8_MMA(1, 1, At, B1); PG8_BAR;
            }
        }
        if constexpr (ALIGN_EPI) { if (wr == 0) PG8_BAR; }
        if constexpr (!Epi::AFTER_DRAIN) { E(acc, cur, wr, wc, fr, fq); S.done(cur); }
        if (!has_next) break;
#pragma unroll
        for (int a = 0; a < 2; ++a)
#pragma unroll
            for (int b = 0; b < 2; ++b)
#pragma unroll
                for (int m = 0; m < 4; ++m)
#pragma unroll
                    for (int n = 0; n < 2; ++n) acc[a][b][m][n] = (f32x4){0.f, 0.f, 0.f, 0.f};
        cur = nxt; cA = nA; cB = nB; ++ui;
        if constexpr (ALIGN_EPI) { if (wr == 1) PG8_BAR; }
    }
    PG8_WAIT_V(0);
    if constexpr (!ALIGN_EPI) { if (wr == 0) PG8_BAR; }
    PG8_BAR;
    if constexpr (Epi::AFTER_DRAIN) { E.fused(acc, cur, wr, wc, fr, fq, lds, wid, lane); S.done(cur); }
#undef PG8_SA
#undef PG8_SB
#undef PG8_STAGE
#undef PG8_LDA
#undef PG8_LDB
#undef PG8_MMA
#undef PG8_WAIT_V
#undef PG8_WAIT_L
#undef PG8_BAR
#undef PG8_SCHED
}
}

#ifndef PG8_SP2
#define PG8_SP2 true
#endif
#ifndef PG8_ALIGN
#define PG8_ALIGN true
#endif

constexpr int NWAVES = 8;
constexpr int DM = 4096, NBATCH = 4, SEQ = 2048, MROWS = NBATCH * SEQ, DEPTH = 4;
constexpr int MEMT = 256, XH = 4, XW = 1024, XHD = 256, MIXW = 3072, DFF = 6144;
constexpr int GH = 24, GHD = 128;
constexpr int SC_IN = 3 * MIXW + XW;
constexpr int GDN_SRC = 4 * MIXW + 2 * GH + XW;
constexpr int GDN_LD = 4 * MIXW + XW;
constexpr int GDN_N = GDN_LD + 256;
constexpr float EPS = 1e-6f;

constexpr size_t MiB = 1u << 20;
constexpr size_t WS_CTL = 0, CTL_ZERO_BYTES = 1 * MiB;
constexpr size_t WS_H = 1 * MiB;
constexpr size_t WS_A = WS_H + 128 * MiB;
constexpr size_t WS_OUT = WS_A + 64 * MiB;
constexpr size_t WS_CAT = WS_OUT + 64 * MiB;
constexpr size_t WS_ACT = WS_CAT + 64 * MiB;
constexpr size_t WS_PROJ = WS_ACT + 96 * MiB;
constexpr size_t WS_AUX = WS_PROJ + 208 * MiB;
constexpr size_t WS_AB = WS_AUX + 2 * MiB;
constexpr size_t WS_QKV = WS_AB + 2 * MiB;
constexpr size_t WS_O = WS_QKV + 144 * MiB;
constexpr size_t WS_KVOPS = WS_O + 96 * MiB;
constexpr size_t WS_KB = WS_KVOPS + 96 * MiB;
constexpr size_t WS_VTB = WS_KB + 8 * MiB;
constexpr size_t WS_WGU = WS_VTB + 8 * MiB;
constexpr size_t WS_WDN = WS_WGU + 768 * MiB;
constexpr size_t WS_WOUT = WS_WDN + 384 * MiB;
constexpr size_t WS_WSC = WS_WOUT + 128 * MiB;
constexpr size_t WS_WGDN = WS_WSC + 160 * MiB;
constexpr size_t WS_CHB = WS_WGDN + 212 * MiB;
constexpr size_t WS_UT = WS_CHB + 168 * MiB;
constexpr size_t WS_CD = WS_UT + 96 * MiB;
constexpr size_t WS_END = WS_CD + 1 * MiB;
constexpr int CW_BAR = 4096;

constexpr int RING_OFF = 0, RING_BYTES = 131072;
constexpr int XP_SCR = 64 * 65 * 4;
constexpr int LDSCTL_OFF = 139264, MISC_OFF = LDSCTL_OFF + 320;
static_assert(LDSCTL_OFF >= 8 * XP_SCR, "LDS map");
static_assert(LDSCTL_OFF >= RING_BYTES, "LDS map");
constexpr int LDS_BYTES = 147456;

#define GAS __attribute__((address_space(1)))
#define LAS __attribute__((address_space(3)))
typedef unsigned short bf16;
typedef unsigned v4u __attribute__((ext_vector_type(4)));
typedef unsigned v2u __attribute__((ext_vector_type(2)));
typedef float f32x4 __attribute__((ext_vector_type(4)));
typedef float f32x2 __attribute__((ext_vector_type(2)));
typedef short bf16x8 __attribute__((ext_vector_type(8)));
#define LDS_WAIT() asm volatile("s_waitcnt lgkmcnt(0)" ::: "memory")
#define VM_WAIT() asm volatile("s_waitcnt vmcnt(0)" ::: "memory")
__device__ __forceinline__ unsigned pk2(float lo, float hi) { return pg8::cvt_pk_bf16(lo, hi); }
__device__ __forceinline__ float bflo(unsigned u) { return __uint_as_float(u << 16); }
__device__ __forceinline__ float bfhi(unsigned u) { return __uint_as_float(u & 0xffff0000u); }
__device__ __forceinline__ float silu_f(float x) { return x * __builtin_amdgcn_rcpf(1.0f + __builtin_amdgcn_exp2f(x * -1.44269504089f)); }
__device__ __forceinline__ int opq_v(int x) { asm volatile("" : "+v"(x)); return x; }
__device__ __forceinline__ int opq_s(int x) { asm volatile("" : "+s"(x)); return x; }

#define XB_TMO      128
#define XB_XCNT(j)  (256  + 64 * (j))
#define XB_XSUB(j)  (1280 + 64 * (j))
#define XB_XGEN(j)  (2304 + 64 * (j))
#define XB_TOP      3328
#define XB_TOPGEN   3392
#define XCD_BAR_WORDS 3456
#define XB_SPIN_CAP (1u << 18)

__device__ __forceinline__ unsigned xb_ld(unsigned* p)              { return __hip_atomic_load(p, __ATOMIC_RELAXED, __HIP_MEMORY_SCOPE_AGENT); }
__device__ __forceinline__ unsigned xb_add(unsigned* p, unsigned v) { return __hip_atomic_fetch_add(p, v, __ATOMIC_RELAXED, __HIP_MEMORY_SCOPE_AGENT); }
__device__ __forceinline__ unsigned xb_xcc_id() { return (unsigned)__builtin_amdgcn_s_getreg((3 << 11) | 20) & 0xFu; }
#define XB_SPIN(cond, bar) do { unsigned _sp = 0; while (cond) { __builtin_amdgcn_s_sleep(1); \
    if ((++_sp & 255u) == 0u) { if (xb_ld(&(bar)[XB_TMO])) break; if (_sp > XB_SPIN_CAP) { atomicAdd(&(bar)[XB_TMO], 1u); break; } } } } while (0)

struct XcdBarrier {
    unsigned* bar; unsigned x;
    volatile LAS unsigned* st;
};
__device__ __forceinline__ XcdBarrier xcd_barrier_post(unsigned* bar, volatile LAS unsigned* st) {
    XcdBarrier b; b.bar = bar; b.x = xb_xcc_id(); b.st = st;
    if (threadIdx.x == 0) (void)xb_add(&bar[XB_XCNT(b.x)], 1u);
    return b;
}
__device__ __forceinline__ void xcd_barrier_complete(unsigned* bar, unsigned x, unsigned& nloc, unsigned& nx) {
    const unsigned G = gridDim.x * gridDim.y * gridDim.z;
    unsigned sum, cnt, mine, sp = 0u;
    for (;;) {
        sum = 0u; cnt = 0u; mine = 0u;
#pragma unroll
        for (unsigned j = 0; j < 16; ++j) { const unsigned c = xb_ld(&bar[XB_XCNT(j)]); sum += c; cnt += (c > 0u) ? 1u : 0u; mine = (j == x) ? c : mine; }
        if (sum == G) break;
        __builtin_amdgcn_s_sleep(1);
        if ((++sp & 255u) == 0u) { if (xb_ld(&bar[XB_TMO])) break; if (sp > XB_SPIN_CAP) { atomicAdd(&bar[XB_TMO], 1u); break; } }
    }
    nloc = mine > 0u ? mine : 1u; nx = cnt > 0u ? cnt : 1u;
}
__device__ __forceinline__ void xcd_barrier(const XcdBarrier& b) {
    asm volatile("s_waitcnt vmcnt(0)" ::: "memory");
    __syncthreads();
    if (threadIdx.x == 0) {
        unsigned* bar = b.bar;
        __builtin_amdgcn_s_waitcnt(0);
        unsigned nloc = b.st[0], nx = b.st[1];
        if (nloc == 0u) { xcd_barrier_complete(bar, b.x, nloc, nx); b.st[0] = nloc; b.st[1] = nx; }
        const unsigned old = xb_add(&bar[XB_XSUB(b.x)], 1u);
        const unsigned gen = old / nloc;
        if (old + 1u == (gen + 1u) * nloc) {
            __builtin_amdgcn_fence(__ATOMIC_RELEASE, "agent");
            asm volatile("s_waitcnt vmcnt(0)" ::: "memory");
            const unsigned og = xb_add(&bar[XB_TOP], 1u);
            const unsigned tg = og / nx;
            if (og + 1u == (tg + 1u) * nx) xb_add(&bar[XB_TOPGEN], 1u);
            else XB_SPIN(xb_ld(&bar[XB_TOPGEN]) == tg, bar);
            __builtin_amdgcn_fence(__ATOMIC_ACQUIRE, "agent");
            xb_add(&bar[XB_XGEN(b.x)], 1u);
            asm volatile("s_waitcnt vmcnt(0)" ::: "memory");
        } else {
            XB_SPIN(xb_ld(&bar[XB_XGEN(b.x)]) == gen, bar);
            __builtin_amdgcn_fence(__ATOMIC_ACQUIRE, "agent");
            asm volatile("s_waitcnt vmcnt(0)" ::: "memory");
        }
    }
    __syncthreads();
}

__device__ __forceinline__ float wave_sum(float v) {
#pragma unroll
    for (int o = 1; o < 64; o <<= 1) v += __shfl_xor(v, o);
    return v;
}
__device__ __forceinline__ float grp16_sum(float v) {
#pragma unroll
    for (int o = 1; o < 16; o <<= 1) v += __shfl_xor(v, o);
    return v;
}
template <int CTRL> __device__ __forceinline__ float dpp_mov(float v) {
    return __builtin_bit_cast(float, __builtin_amdgcn_update_dpp(0, __builtin_bit_cast(int, v), CTRL, 0xF, 0xF, true));
}
__device__ __forceinline__ float grp8_sum(float v) {
    v += dpp_mov<0xB1>(v); v += dpp_mov<0x4E>(v); v += dpp_mov<0x141>(v); return v;
}

__device__ __forceinline__ void xpose_load(f32x4 (&v)[16], const float* W, int N, int col0, int nvalid, int k0, int n0, int lane) {
    const int nn = n0 + 4 * (lane & 15); const bool ok = nn < nvalid;
    const float* p = W + (size_t)(k0 + (lane >> 4)) * N + col0 + nn;
#pragma unroll
    for (int i = 0; i < 16; ++i) v[i] = ok ? __builtin_nontemporal_load((const GAS f32x4*)(p + (size_t)(4 * i) * N)) : (f32x4){0.f, 0.f, 0.f, 0.f};
}
__device__ __forceinline__ void xpose_store(const f32x4 (&v)[16], bf16* WT, int Kd, int drow0, LAS float* scr, int k0, int lane) {
    LAS float* w = scr + (lane >> 4) * 65 + 4 * (lane & 15);
#pragma unroll
    for (int i = 0; i < 16; ++i) { w[(4 * i) * 65 + 0] = v[i][0]; w[(4 * i) * 65 + 1] = v[i][1]; w[(4 * i) * 65 + 2] = v[i][2]; w[(4 * i) * 65 + 3] = v[i][3]; }
    LDS_WAIT(); asm volatile("" ::: "memory");
    const int c = lane & 7;
#pragma unroll
    for (int j = 0; j < 8; ++j) { const int n = (lane >> 3) + 8 * j; const LAS float* s = scr + (8 * c) * 65 + n;
        v4u o; o.x = pk2(s[0 * 65], s[1 * 65]); o.y = pk2(s[2 * 65], s[3 * 65]); o.z = pk2(s[4 * 65], s[5 * 65]); o.w = pk2(s[6 * 65], s[7 * 65]);
        *(GAS v4u*)(WT + (size_t)(drow0 + n) * Kd + k0 + 8 * c) = o; }
    LDS_WAIT(); asm volatile("" ::: "memory");
}

struct Args { const float* in[19]; float* out; unsigned char* ws; };
enum { I_X = 0, I_MEM, I_FPRE, I_FPOST, I_MPRE, I_MPOST, I_MEMG, I_WG, I_WU, I_WD, I_WKV, I_WOUT, I_SCIN, I_SCCONV, I_GDNIN, I_GDNCONV, I_ALOG, I_DTB, I_NORMG };

__device__ __forceinline__ void norm_phase(int gw, int NGW, int lane, const bf16* outb, float w, const float* g_post, const float* hsrc, float* hdst, const float* g_pre, bf16* Adst) {
    for (int row = gw; row < MROWS; row += NGW) {
        const float* hr = hsrc + (size_t)row * DM;
        f32x4 hv[16];
#pragma unroll
        for (int j = 0; j < 8; ++j) { const int e = (j * 64 + lane) * 8; hv[2 * j] = *(const GAS f32x4*)(hr + e); hv[2 * j + 1] = *(const GAS f32x4*)(hr + e + 4); }
        if (outb) {
            v4u ov[8]; float ss = 0.f;
#pragma unroll
            for (int j = 0; j < 8; ++j) { ov[j] = *(const GAS v4u*)(outb + (size_t)row * DM + (j * 64 + lane) * 8);
#pragma unroll
                for (int q = 0; q < 4; ++q) { const float a = bflo(ov[j][q]), b = bfhi(ov[j][q]); ss += a * a + b * b; } }
            ss = wave_sum(ss);
            const float sc = w / sqrtf(ss * (1.0f / DM) + EPS);
#pragma unroll
            for (int j = 0; j < 8; ++j) { const int e = (j * 64 + lane) * 8;
                const f32x4 g0 = *(const GAS f32x4*)(g_post + e), g1 = *(const GAS f32x4*)(g_post + e + 4);
                f32x4 o0, o1; o0[0] = bflo(ov[j][0]); o0[1] = bfhi(ov[j][0]); o0[2] = bflo(ov[j][1]); o0[3] = bfhi(ov[j][1]);
                o1[0] = bflo(ov[j][2]); o1[1] = bfhi(ov[j][2]); o1[2] = bflo(ov[j][3]); o1[3] = bfhi(ov[j][3]);
                hv[2 * j] += o0 * g0 * sc; hv[2 * j + 1] += o1 * g1 * sc; }
        }
        if (hdst) { float* hw = hdst + (size_t)row * DM;
#pragma unroll
            for (int j = 0; j < 8; ++j) { const int e = (j * 64 + lane) * 8; *(GAS f32x4*)(hw + e) = hv[2 * j]; *(GAS f32x4*)(hw + e + 4) = hv[2 * j + 1]; } }
        if (Adst) {
            float ss = 0.f;
#pragma unroll
            for (int j = 0; j < 16; ++j) ss += (hv[j][0] * hv[j][0] + hv[j][1] * hv[j][1]) + (hv[j][2] * hv[j][2] + hv[j][3] * hv[j][3]);
            ss = wave_sum(ss);
            const float sc = 1.0f / sqrtf(ss * (1.0f / DM) + EPS);
#pragma unroll
            for (int j = 0; j < 8; ++j) { const int e = (j * 64 + lane) * 8;
                const f32x4 g0 = *(const GAS f32x4*)(g_pre + e), g1 = *(const GAS f32x4*)(g_pre + e + 4);
                const f32x4 a0 = hv[2 * j] * g0 * sc, a1 = hv[2 * j + 1] * g1 * sc;
                v4u o; o.x = pk2(a0[0], a0[1]); o.y = pk2(a0[2], a0[3]); o.z = pk2(a1[0], a1[1]); o.w = pk2(a1[2], a1[3]);
                *(GAS v4u*)(Adst + (size_t)row * DM + e) = o; }
        }
    }
}

constexpr int XA_PITCH = 544;
__device__ __forceinline__ void xa_stage(LAS unsigned char* ldsb, const bf16* src, int tid) {
#pragma unroll
    for (int hf = 0; hf < 2; ++hf) { v4u t[8];
#pragma unroll
        for (int e = 0; e < 8; ++e) { const int p = tid + 512 * (8 * hf + e); t[e] = *(const GAS v4u*)(src + (size_t)(p >> 5) * 1024 + (p & 31) * 8); }
#pragma unroll
        for (int e = 0; e < 8; ++e) { const int p = tid + 512 * (8 * hf + e); *(LAS v4u*)(ldsb + (p >> 5) * XA_PITCH + (p & 31) * 16) = t[e]; } }
}
__device__ __forceinline__ void xattn_unit(int unit, LAS unsigned char* ldsb, const bf16* proj, int ldp, int xq_col0, const bf16* Kb, const bf16* VTb, bf16* cat, int tid, int wave, int lane) {
    const int rb = unit & 15, h = (unit >> 4) & 3, b = unit >> 6;
    const int r0 = b * SEQ + rb * 128 + wave * 16, c15 = lane & 15, q4 = lane >> 4;
    xa_stage(ldsb, Kb + (size_t)(b * MEMT) * 1024 + h * XHD, tid);
    bf16x8 qf[8];
    const bf16* qp = proj + (size_t)(r0 + c15) * ldp + xq_col0 + h * XHD + 8 * q4;
#pragma unroll
    for (int s = 0; s < 8; ++s) qf[s] = *(const GAS bf16x8*)(qp + 32 * s);
    __syncthreads();
    f32x4 st[16];
    const LAS unsigned char* fp = ldsb + c15 * XA_PITCH + 16 * q4;
#pragma unroll
    for (int kb = 0; kb < 16; ++kb) { f32x4 acc = {0.f, 0.f, 0.f, 0.f};
#pragma unroll
        for (int s = 0; s < 8; ++s) acc = __builtin_amdgcn_mfma_f32_16x16x32_bf16(*(const LAS bf16x8*)(fp + (16 * kb) * XA_PITCH + 64 * s), qf[s], acc, 0, 0, 0);
        st[kb] = acc; }
    __syncthreads();
    xa_stage(ldsb, VTb + (size_t)(h * XHD) * 1024 + b * MEMT, tid);
    float mx = -3.0e38f;
#pragma unroll
    for (int kb = 0; kb < 16; ++kb)
#pragma unroll
        for (int j = 0; j < 4; ++j) mx = fmaxf(mx, st[kb][j]);
    mx = fmaxf(mx, __shfl_xor(mx, 16)); mx = fmaxf(mx, __shfl_xor(mx, 32));
    const float sc = 0.0625f * 1.44269504089f; float sum = 0.f;
#pragma unroll
    for (int kb = 0; kb < 16; ++kb)
#pragma unroll
        for (int j = 0; j < 4; ++j) { const float p = __builtin_amdgcn_exp2f((st[kb][j] - mx) * sc); st[kb][j] = p; sum += p; }
    sum += __shfl_xor(sum, 16); sum += __shfl_xor(sum, 32);
    const float inv = 1.0f / sum;
    bf16x8 pf[8];
#pragma unroll
    for (int s = 0; s < 8; ++s) { v4u w; w.x = pk2(st[2 * s][0], st[2 * s][1]); w.y = pk2(st[2 * s][2], st[2 * s][3]); w.z = pk2(st[2 * s + 1][0], st[2 * s + 1][1]); w.w = pk2(st[2 * s + 1][2], st[2 * s + 1][3]);
        pf[s] = __builtin_bit_cast(bf16x8, w); }
    __syncthreads();
    bf16* op = cat + (size_t)(r0 + c15) * DM + MIXW + h * XHD + 4 * q4;
#pragma unroll 4
    for (int db = 0; db < 16; ++db) { f32x4 acc = {0.f, 0.f, 0.f, 0.f};
#pragma unroll
        for (int s = 0; s < 8; ++s) acc = __builtin_amdgcn_mfma_f32_16x16x32_bf16(*(const LAS bf16x8*)(fp + (16 * db) * XA_PITCH + 64 * s), pf[s], acc, 0, 0, 0);
        v2u o; o.x = pk2(acc[0] * inv, acc[1] * inv); o.y = pk2(acc[2] * inv, acc[3] * inv);
        *(GAS v2u*)(op + 16 * db) = o; }
    __syncthreads();
}

__device__ __forceinline__ void sc_gate_phase(int gw, int NGW, int lane, const bf16* proj, const float* convw, bf16* cat) {
    for (int task = gw; task < (MROWS / 16) * 6; task += NGW) {
        const int row0 = (task / 6) * 16, c = (task % 6) * 512 + lane * 8;
        float cw[3][8];
#pragma unroll
        for (int j = 0; j < 3; ++j) { const f32x4 a = *(const GAS f32x4*)(convw + j * MIXW + c), b = *(const GAS f32x4*)(convw + j * MIXW + c + 4);
            cw[j][0] = a[0]; cw[j][1] = a[1]; cw[j][2] = a[2]; cw[j][3] = a[3]; cw[j][4] = b[0]; cw[j][5] = b[1]; cw[j][6] = b[2]; cw[j][7] = b[3]; }
        float u2[8], u1[8];
#pragma unroll
        for (int e = 0; e < 8; ++e) { u2[e] = 0.f; u1[e] = 0.f; }
        if ((row0 % SEQ) != 0) {
#pragma unroll
            for (int hrow = 0; hrow < 2; ++hrow) { const bf16* pr = proj + (size_t)(row0 - 2 + hrow) * SC_IN + c;
                const v4u cv = *(const GAS v4u*)(pr + MIXW), hv = *(const GAS v4u*)(pr + 2 * MIXW);
#pragma unroll
                for (int q = 0; q < 4; ++q) { const float a = bflo(cv[q]) * bflo(hv[q]), b = bfhi(cv[q]) * bfhi(hv[q]);
                    if (hrow == 0) { u2[2 * q] = a; u2[2 * q + 1] = b; } else { u1[2 * q] = a; u1[2 * q + 1] = b; } } }
        }
#pragma unroll 4
        for (int r = 0; r < 16; ++r) { const bf16* pr = proj + (size_t)(row0 + r) * SC_IN + c;
            const v4u bv = *(const GAS v4u*)(pr), cv = *(const GAS v4u*)(pr + MIXW), hv = *(const GAS v4u*)(pr + 2 * MIXW);
            float u0[8], y[8];
#pragma unroll
            for (int q = 0; q < 4; ++q) { u0[2 * q] = bflo(cv[q]) * bflo(hv[q]); u0[2 * q + 1] = bfhi(cv[q]) * bfhi(hv[q]); }
#pragma unroll
            for (int q = 0; q < 4; ++q) {
                y[2 * q] = bflo(bv[q]) * (cw[0][2 * q] * u2[2 * q] + cw[1][2 * q] * u1[2 * q] + cw[2][2 * q] * u0[2 * q]);
                y[2 * q + 1] = bfhi(bv[q]) * (cw[0][2 * q + 1] * u2[2 * q + 1] + cw[1][2 * q + 1] * u1[2 * q + 1] + cw[2][2 * q + 1] * u0[2 * q + 1]); }
            v4u o; o.x = pk2(y[0], y[1]); o.y = pk2(y[2], y[3]); o.z = pk2(y[4], y[5]); o.w = pk2(y[6], y[7]);
            *(GAS v4u*)(cat + (size_t)(row0 + r) * DM + c) = o;
#pragma unroll
            for (int e = 0; e < 8; ++e) { u2[e] = u1[e]; u1[e] = u0[e]; } }
    }
}

__device__ __forceinline__ void gdn_prep_phase(int gw, int NGW, int lane, const bf16* proj, const float* convw, bf16* qkvn, const float* aux, const float* alog, const float* dtb, float* ab) {
    for (int task = gw; task < (MROWS / 16) * 18; task += NGW) {
        const int row0 = (task / 18) * 16, slot = (task % 18) * 4 + (lane >> 4), type = slot / GH, ch = slot * GHD + (lane & 15) * 8;
        float cw[4][8];
#pragma unroll
        for (int j = 0; j < 4; ++j) { const f32x4 a = *(const GAS f32x4*)(convw + j * (3 * MIXW) + ch), b = *(const GAS f32x4*)(convw + j * (3 * MIXW) + ch + 4);
            cw[j][0] = a[0]; cw[j][1] = a[1]; cw[j][2] = a[2]; cw[j][3] = a[3]; cw[j][4] = b[0]; cw[j][5] = b[1]; cw[j][6] = b[2]; cw[j][7] = b[3]; }
        float w0[8], w1[8], w2[8];
#pragma unroll
        for (int e = 0; e < 8; ++e) { w0[e] = 0.f; w1[e] = 0.f; w2[e] = 0.f; }
        if ((row0 % SEQ) != 0) {
#pragma unroll
            for (int hrow = 0; hrow < 3; ++hrow) { const v4u xv = *(const GAS v4u*)(proj + (size_t)(row0 - 3 + hrow) * GDN_LD + ch);
#pragma unroll
                for (int q = 0; q < 4; ++q) { const float a = bflo(xv[q]), b = bfhi(xv[q]);
                    if (hrow == 0) { w0[2 * q] = a; w0[2 * q + 1] = b; } else if (hrow == 1) { w1[2 * q] = a; w1[2 * q + 1] = b; } else { w2[2 * q] = a; w2[2 * q + 1] = b; } } }
        }
        const float post = (type == 0) ? 0.08838834764831845f : 1.0f;
#pragma unroll 4
        for (int r = 0; r < 16; ++r) { const v4u xv = *(const GAS v4u*)(proj + (size_t)(row0 + r) * GDN_LD + ch);
            float x[8], y[8]; float ss = 0.f;
#pragma unroll
            for (int q = 0; q < 4; ++q) { x[2 * q] = bflo(xv[q]); x[2 * q + 1] = bfhi(xv[q]); }
#pragma unroll
            for (int e = 0; e < 8; ++e) { const float v = cw[0][e] * w0[e] + cw[1][e] * w1[e] + cw[2][e] * w2[e] + cw[3][e] * x[e]; y[e] = silu_f(v); ss += y[e] * y[e]; }
            if (type < 2) { ss = grp16_sum(ss); const float sc = post / sqrtf(ss + EPS);
#pragma unroll
                for (int e = 0; e < 8; ++e) y[e] *= sc; }
            v4u o; o.x = pk2(y[0], y[1]); o.y = pk2(y[2], y[3]); o.z = pk2(y[4], y[5]); o.w = pk2(y[6], y[7]);
            *(GAS v4u*)(qkvn + (size_t)(row0 + r) * (3 * MIXW) + ch) = o;
#pragma unroll
            for (int e = 0; e < 8; ++e) { w0[e] = w1[e]; w1[e] = w2[e]; w2[e] = x[e]; } }
    }
    for (int idx = gw * 64 + lane; idx < MROWS * GH; idx += NGW * 64) { const int row = idx / GH, h = idx % GH;
        const float bi = aux[(size_t)row * 64 + h], ai = aux[(size_t)row * 64 + GH + h] + dtb[h];
        const float sp = ai > 20.f ? ai : log1pf(expf(ai));
        ab[(size_t)row * 48 + h] = 1.0f / (1.0f + expf(-bi));
        ab[(size_t)row * 48 + GH + h] = -expf(alog[h]) * sp; }
}

constexpr int NCHUNK = SEQ / 64;
constexpr int CHB_WC = 0, CHB_QD = 16384, CHB_IN = 32768, CHB_KT = 40960, CHB_BYTES = 57344;
constexpr int P2_PITCH = 272;
constexpr int P2_GC = 0, P2_BETA = 256, P2_EG = 512, P2_Q = 768, P2_K = P2_Q + 64 * P2_PITCH, P2_V = P2_K + 64 * P2_PITCH, P2_A = P2_V + 64 * P2_PITCH, P2_HALF = P2_A + 16384;
__device__ __forceinline__ int kperm_pos(int col) { const int o = col & 31; return (col & ~31) + 8 * ((o & 15) >> 2) + (o & 3) + ((o >> 4) << 2); }
__device__ __forceinline__ unsigned short bf1(float x) { return (unsigned short)(pk2(x, 0.f) & 0xffffu); }
__device__ __forceinline__ float ldbf(const LAS unsigned char* p) { return __uint_as_float((unsigned)(*(const LAS unsigned short*)p) << 16); }

__device__ __forceinline__ void gdn_chunk_phase(int c, int G, int tid, LAS unsigned char* ldsb, const bf16* qkvn, const float* ab, unsigned char* chb, float* utb, float* cdb) {
    const int half = __builtin_amdgcn_readfirstlane(tid >> 8), w4 = __builtin_amdgcn_readfirstlane((tid >> 6) & 3);
    const int role = half ? (w4 - 2) : w4;
    const int ew = half ? w4 : (w4 - 2);
    const int npair = (NBATCH * GH * NCHUNK) / 2;
    for (int pr = c; pr < npair; pr += G) {
        const int ci = pr * 2 + half;
        const int n = ci % NCHUNK, bh = ci / NCHUNK, h = bh % GH, b = bh / GH;
        const size_t row0 = (size_t)b * SEQ + (size_t)n * 64;
        unsigned char* blob = chb + (size_t)ci * CHB_BYTES;
#define P2_FRESH() unsigned lbv = (unsigned)(size_t)(ldsb + half * P2_HALF), afv = lbv + P2_A; asm volatile("" : "+v"(lbv)); asm volatile("" : "+v"(afv)); \
        LAS unsigned char* lb = (LAS unsigned char*)(size_t)lbv; LAS float* Af = (LAS float*)(size_t)afv; LAS float* gcs = (LAS float*)(lb + P2_GC); LAS float* bts = (LAS float*)(lb + P2_BETA); LAS float* egs = (LAS float*)(lb + P2_EG); \
        const int t = opq_v(tid) & 255, lane = t & 63; (void)Af; (void)gcs; (void)bts; (void)egs; (void)lane
        { P2_FRESH();
#pragma unroll
        for (int e = 0; e < 12; ++e) { const int p = t + 256 * e; const int which = p >> 10, r = (p >> 4) & 63, c16 = p & 15;
            const v4u x = *(const GAS v4u*)(qkvn + (row0 + r) * (size_t)(3 * MIXW) + which * MIXW + h * GHD + c16 * 8);
            *(LAS v4u*)(lb + P2_Q + which * (64 * P2_PITCH) + r * P2_PITCH + c16 * 16) = x; }
        if (w4 == 0) { float g = ab[(row0 + lane) * 48 + GH + h]; const float be = ab[(row0 + lane) * 48 + h];
#pragma unroll
            for (int o = 1; o < 64; o <<= 1) { const float y = __shfl_up(g, o); if (lane >= o) g += y; }
            gcs[lane] = g; bts[lane] = be; egs[lane] = __expf(g); }
        }
        __syncthreads();
        { P2_FRESH();
            const int i15 = lane & 15, q4 = lane >> 4;
            bf16x8 kA[4], qA[4];
#pragma unroll
            for (int s = 0; s < 4; ++s) { kA[s] = *(const LAS bf16x8*)(lb + P2_K + (16 * w4 + i15) * P2_PITCH + (32 * s + 8 * q4) * 2);
                                          qA[s] = *(const LAS bf16x8*)(lb + P2_Q + (16 * w4 + i15) * P2_PITCH + (32 * s + 8 * q4) * 2); }
            bf16* In = (bf16*)(blob + CHB_IN);
#pragma unroll
            for (int nb = 0; nb < 4; ++nb) {
                const int jg = 16 * nb + i15;
                if (nb <= w4) {
                    f32x4 akk = {0.f, 0.f, 0.f, 0.f}, aqk = {0.f, 0.f, 0.f, 0.f};
#pragma unroll
                    for (int s = 0; s < 4; ++s) { const bf16x8 kB = *(const LAS bf16x8*)(lb + P2_K + (16 * nb + i15) * P2_PITCH + (32 * s + 8 * q4) * 2);
                        akk = __builtin_amdgcn_mfma_f32_16x16x32_bf16(kA[s], kB, akk, 0, 0, 0); aqk = __builtin_amdgcn_mfma_f32_16x16x32_bf16(qA[s], kB, aqk, 0, 0, 0); }
                    const float gj = gcs[jg];
#pragma unroll
                    for (int r = 0; r < 4; ++r) { const int ig = 16 * w4 + 4 * q4 + r;
                        const float dec = (ig >= jg) ? __expf(gcs[ig] - gj) : 0.f;
                        Af[ig * 64 + jg] = (ig > jg) ? bts[ig] * akk[r] * dec : 0.f;
                        *(GAS unsigned short*)(In + ig * 64 + kperm_pos(jg)) = bf1(aqk[r] * dec); }
                } else {
#pragma unroll
                    for (int r = 0; r < 4; ++r) { const int ig = 16 * w4 + 4 * q4 + r; *(GAS unsigned short*)(In + ig * 64 + kperm_pos(jg)) = 0; }
                }
            }
        }
        __syncthreads();
        if (role == 0 || role == 1) { P2_FRESH();
            f32x2 x[64];
            const LAS unsigned char* tp = lb + (role ? P2_K : P2_V) + lane * 2;
#pragma unroll
            for (int g8 = 0; g8 < 8; ++g8) {
#pragma unroll
                for (int ii = 0; ii < 8; ++ii) { const int i = 8 * g8 + ii; const float e = egs[i], sc = bts[i] * (role ? e : 1.0f);
                    x[i] = (f32x2){ldbf(tp + i * P2_PITCH) * sc, ldbf(tp + i * P2_PITCH + 128) * sc}; asm volatile("" : "+v"(x[i])); }
                __builtin_amdgcn_sched_barrier(0);
            }
            f32x4 cur[4], nxt[4];
            cur[0] = *(const LAS f32x4*)(Af + 64);
#define P2_ROWS(NSEG, ILO, IHI) \
            _Pragma("unroll") for (int i = (ILO); i <= (IHI); ++i) { \
                f32x2 a0 = x[i], a1 = {0.f, 0.f}; \
                _Pragma("unroll") for (int sg = 0; sg < (NSEG); ++sg) { \
                    const bool more = (sg + 1 < (NSEG)); const int ni = more ? i : i + 1, nsg = more ? sg + 1 : 0; \
                    if (ni < 64) { _Pragma("unroll") for (int q = 0; q < 4; ++q) if (16 * nsg + 4 * q < ni) nxt[q] = *(const LAS f32x4*)(Af + ni * 64 + 16 * nsg + 4 * q); } \
                    __builtin_amdgcn_sched_barrier(0); \
                    _Pragma("unroll") for (int jj = 0; jj < (more ? 16 : i - 16 * sg); ++jj) { const int j = 16 * sg + jj; const float aij = cur[jj >> 2][jj & 3]; if (j & 1) a1 -= x[j] * aij; else a0 -= x[j] * aij; } \
                    __builtin_amdgcn_sched_barrier(0); \
                    _Pragma("unroll") for (int q = 0; q < 4; ++q) cur[q] = nxt[q]; \
                } \
                x[i] = a0 + a1; \
            }
            P2_ROWS(1, 1, 16)
            P2_ROWS(2, 17, 32)
            P2_ROWS(3, 33, 48)
            P2_ROWS(4, 49, 63)
#undef P2_ROWS
            if (role == 0) { float* up = utb + (size_t)ci * 8192 + lane * 64;
#pragma unroll
                for (int i = 0; i < 16; ++i) { *(GAS f32x4*)(up + 4 * i) = (f32x4){x[4 * i][0], x[4 * i + 1][0], x[4 * i + 2][0], x[4 * i + 3][0]};
                                               *(GAS f32x4*)(up + 4096 + 4 * i) = (f32x4){x[4 * i][1], x[4 * i + 1][1], x[4 * i + 2][1], x[4 * i + 3][1]}; } }
            else { bf16* wp = (bf16*)(blob + CHB_WC) + kperm_pos(lane);
#pragma unroll
                for (int i = 0; i < 64; ++i) { *(GAS unsigned short*)(wp + i * 128) = bf1(x[i][0]); *(GAS unsigned short*)(wp + i * 128 + 64) = bf1(x[i][1]); } }
        } else { P2_FRESH();
            const int t2 = ew * 64 + lane;
#pragma unroll
            for (int ps = 0; ps < 2; ++ps) { const int tt = t2 + 128 * ps; const int i = tt >> 2, cseg = (tt & 3) * 32; const float e = egs[i];
                v4u sv[4];
#pragma unroll
                for (int q = 0; q < 4; ++q) { const v4u xv = *(const LAS v4u*)(lb + P2_Q + i * P2_PITCH + (cseg + 8 * q) * 2);
                    sv[q].x = pk2(bflo(xv.x) * e, bfhi(xv.x) * e); sv[q].y = pk2(bflo(xv.y) * e, bfhi(xv.y) * e); sv[q].z = pk2(bflo(xv.z) * e, bfhi(xv.z) * e); sv[q].w = pk2(bflo(xv.w) * e, bfhi(xv.w) * e); }
#pragma unroll
                for (int q = 0; q < 4; ++q) { const v4u lo = sv[q >> 1], hi = sv[2 + (q >> 1)];
                    v4u o; o.x = (q & 1) ? lo.z : lo.x; o.y = (q & 1) ? lo.w : lo.y; o.z = (q & 1) ? hi.z : hi.x; o.w = (q & 1) ? hi.w : hi.y;
                    *(GAS v4u*)(blob + CHB_QD + (i * 128 + cseg + 8 * q) * 2) = o; } }
            const float gl = gcs[63];
#pragma unroll
            for (int ps = 0; ps < 2; ++ps) { const int d = t2, hh = ps; float y[32];
#pragma unroll
                for (int jj = 0; jj < 32; ++jj) { const int i = 32 * hh + jj; y[jj] = ldbf(lb + P2_K + i * P2_PITCH + d * 2) * __expf(gl - gcs[i]); }
#pragma unroll
                for (int q = 0; q < 4; ++q) { v4u o; o.x = pk2(y[4 * q], y[4 * q + 1]); o.y = pk2(y[4 * q + 2], y[4 * q + 3]); o.z = pk2(y[16 + 4 * q], y[16 + 4 * q + 1]); o.w = pk2(y[16 + 4 * q + 2], y[16 + 4 * q + 3]);
                    *(GAS v4u*)(blob + CHB_KT + (d * 64 + 32 * hh + 8 * q) * 2) = o; } }
            if (t2 == 0) cdb[ci] = __expf(gl);
        }
        __syncthreads();
    }
#undef P2_FRESH
}

constexpr int S2_WC = 0, S2_QD = 18432, S2_IN = 36864, S2_KT = 47104, S2_BUF = 67584;
__device__ __forceinline__ bf16x8 s2_frag(const LAS unsigned char* p) { return *(const LAS bf16x8*)p; }
__device__ __forceinline__ bf16x8 s2_pack(const f32x4& a, const f32x4& b) { v4u w; w.x = pk2(a[0], a[1]); w.y = pk2(a[2], a[3]); w.z = pk2(b[0], b[1]); w.w = pk2(b[2], b[3]); return __builtin_bit_cast(bf16x8, w); }
__device__ __forceinline__ void gdn_scan2_unit(int bh, LAS unsigned char* ldsb, const unsigned char* chb, const float* utb, const float* cdb, float* O, int tid, int wave, int lane) {
    const int b = bh / GH, h = bh % GH, i15 = lane & 15, q4 = lane >> 4, n0 = wave * 16;
    const size_t ci0 = (size_t)bh * NCHUNK;
    f32x4 S[8];
#pragma unroll
    for (int kb = 0; kb < 8; ++kb) S[kb] = (f32x4){0.f, 0.f, 0.f, 0.f};
    v4u r[7]; f32x4 utn[4], ocp[4];
#define S2_STORE_O(cc_) do { float* op_ = O + ((size_t)b * SEQ + (size_t)(cc_) * 64 + 4 * q4) * MIXW + h * GHD + n0 + i15; \
        _Pragma("unroll") for (int mb = 0; mb < 4; ++mb) _Pragma("unroll") for (int j = 0; j < 4; ++j) op_[(size_t)(16 * mb + j) * MIXW] = ocp[mb][j]; } while (0)
#define S2_ISSUE(cc_) do { const unsigned char* bp_ = chb + (ci0 + (cc_)) * CHB_BYTES + tid * 16; \
        _Pragma("unroll") for (int e = 0; e < 7; ++e) r[e] = *(const GAS v4u*)(bp_ + e * 8192); \
        const float* up_ = utb + (ci0 + (cc_)) * 8192 + (n0 + i15) * 64 + 4 * q4; \
        _Pragma("unroll") for (int mb = 0; mb < 4; ++mb) utn[mb] = *(const GAS f32x4*)(up_ + 16 * mb); } while (0)
    S2_ISSUE(0);
#if defined(TPROBE) && TPROBE >= 11 && TPROBE <= 13
    volatile LAS unsigned* MISCp = (volatile LAS unsigned*)(ldsb - RING_OFF + MISC_OFF); const bool prb = (bh == 0 && tid == 0);
#define S2_T0() unsigned long long pt0_ = prb ? __builtin_amdgcn_s_memrealtime() : 0ull
#define S2_T1(k) do { if ((k) == TPROBE && prb) { const unsigned long long d_ = __builtin_amdgcn_s_memrealtime() - pt0_; const unsigned long long a_ = ((((unsigned long long)MISCp[19] << 32) | MISCp[18])) + d_; MISCp[18] = (unsigned)a_; MISCp[19] = (unsigned)(a_ >> 32); } } while (0)
#else
#define S2_T0() do {} while (0)
#define S2_T1(k) do {} while (0)
#endif
    for (int cc = 0; cc < NCHUNK; ++cc) {
        LAS unsigned char* buf = ldsb + (cc & 1) * S2_BUF;
        { S2_T0(); asm volatile("s_waitcnt vmcnt(0)" ::: "memory"); S2_T1(11); }
        *(LAS v4u*)(buf + S2_WC + (tid >> 4) * 288 + (tid & 15) * 16) = r[0];
        *(LAS v4u*)(buf + S2_WC + ((tid + 512) >> 4) * 288 + (tid & 15) * 16) = r[1];
        *(LAS v4u*)(buf + S2_QD + (tid >> 4) * 288 + (tid & 15) * 16) = r[2];
        *(LAS v4u*)(buf + S2_QD + ((tid + 512) >> 4) * 288 + (tid & 15) * 16) = r[3];
        *(LAS v4u*)(buf + S2_IN + (tid >> 3) * 160 + (tid & 7) * 16) = r[4];
        *(LAS v4u*)(buf + S2_KT + (tid >> 3) * 160 + (tid & 7) * 16) = r[5];
        *(LAS v4u*)(buf + S2_KT + ((tid + 512) >> 3) * 160 + (tid & 7) * 16) = r[6];
        f32x4 ut[4];
#pragma unroll
        for (int mb = 0; mb < 4; ++mb) ut[mb] = utn[mb];
        const float cd = cdb[ci0 + cc];
        { S2_T0(); __syncthreads(); S2_T1(12); }
        S2_T0();
        if (cc > 0) S2_STORE_O(cc - 1);
        if (cc + 1 < NCHUNK) S2_ISSUE(cc + 1);
        bf16x8 sb[4];
#pragma unroll
        for (int s = 0; s < 4; ++s) sb[s] = s2_pack(S[2 * s], S[2 * s + 1]);
#define S2_LD4x2(dst, base, pitch, s0) do { _Pragma("unroll") for (int e_ = 0; e_ < 8; ++e_) dst[e_] = s2_frag(buf + (base) + (16 * (e_ & 3) + i15) * (pitch) + (32 * ((s0) + (e_ >> 2)) + 8 * q4) * 2); } while (0)
#define S2_LD8x1(dst, base, pitch, s0) do { _Pragma("unroll") for (int e_ = 0; e_ < 8; ++e_) dst[e_] = s2_frag(buf + (base) + (16 * e_ + i15) * (pitch) + (32 * (s0) + 8 * q4) * 2); } while (0)
#define S2_SB() __builtin_amdgcn_sched_barrier(0)
        bf16x8 fa[8], fb[8];
        f32x4 vn[4], oc[4];
#pragma unroll
        for (int mb = 0; mb < 4; ++mb) { vn[mb] = (f32x4){0.f, 0.f, 0.f, 0.f}; oc[mb] = (f32x4){0.f, 0.f, 0.f, 0.f}; }
        S2_LD4x2(fa, S2_WC, 288, 0); S2_LD4x2(fb, S2_WC, 288, 2); S2_SB();
#pragma unroll
        for (int e = 0; e < 8; ++e) vn[e & 3] = __builtin_amdgcn_mfma_f32_16x16x32_bf16(fa[e], sb[e >> 2], vn[e & 3], 0, 0, 0);
        S2_SB(); S2_LD4x2(fa, S2_QD, 288, 0); S2_SB();
#pragma unroll
        for (int e = 0; e < 8; ++e) vn[e & 3] = __builtin_amdgcn_mfma_f32_16x16x32_bf16(fb[e], sb[2 + (e >> 2)], vn[e & 3], 0, 0, 0);
        S2_SB(); S2_LD4x2(fb, S2_QD, 288, 2); S2_SB();
#pragma unroll
        for (int e = 0; e < 8; ++e) oc[e & 3] = __builtin_amdgcn_mfma_f32_16x16x32_bf16(fa[e], sb[e >> 2], oc[e & 3], 0, 0, 0);
        S2_SB(); S2_LD4x2(fa, S2_IN, 160, 0); S2_SB();
#pragma unroll
        for (int mb = 0; mb < 4; ++mb) vn[mb] = ut[mb] - vn[mb];
        bf16x8 vb[2];
        vb[0] = s2_pack(vn[0], vn[1]); vb[1] = s2_pack(vn[2], vn[3]);
#pragma unroll
        for (int e = 0; e < 8; ++e) oc[e & 3] = __builtin_amdgcn_mfma_f32_16x16x32_bf16(fb[e], sb[2 + (e >> 2)], oc[e & 3], 0, 0, 0);
        S2_SB(); S2_LD8x1(fb, S2_KT, 160, 0); S2_SB();
#pragma unroll
        for (int e = 0; e < 8; ++e) oc[e & 3] = __builtin_amdgcn_mfma_f32_16x16x32_bf16(fa[e], vb[e >> 2], oc[e & 3], 0, 0, 0);
        S2_SB(); S2_LD8x1(fa, S2_KT, 160, 1); S2_SB();
#pragma unroll
        for (int kb = 0; kb < 8; ++kb) S[kb] = __builtin_amdgcn_mfma_f32_16x16x32_bf16(fb[kb], vb[0], S[kb] * cd, 0, 0, 0);
        S2_SB();
#pragma unroll
        for (int mb = 0; mb < 4; ++mb) ocp[mb] = oc[mb];
        asm volatile("" :: "v"(S[0]), "v"(S[7]), "v"(ocp[3])); S2_T1(13);
#pragma unroll
        for (int kb = 0; kb < 8; ++kb) S[kb] = __builtin_amdgcn_mfma_f32_16x16x32_bf16(fa[kb], vb[1], S[kb], 0, 0, 0);
#undef S2_LD4x2
#undef S2_LD8x1
#undef S2_SB
    }
    S2_STORE_O(NCHUNK - 1);
    __syncthreads();
#undef S2_STORE_O
#undef S2_ISSUE
}

__device__ __forceinline__ void gdn_out_phase(int gw, int NGW, int lane, const float* O, const bf16* proj, const float* normg, bf16* cat) {
    const int dl = (lane & 15) * 8;
    const f32x4 g0 = *(const GAS f32x4*)(normg + dl), g1 = *(const GAS f32x4*)(normg + dl + 4);
    for (int row = gw; row < MROWS; row += NGW) {
#pragma unroll 2
        for (int it = 0; it < 6; ++it) { const int ch = (it * 4 + (lane >> 4)) * GHD + dl;
            const f32x4 o0 = *(const GAS f32x4*)(O + (size_t)row * MIXW + ch), o1 = *(const GAS f32x4*)(O + (size_t)row * MIXW + ch + 4);
            const v4u zv = *(const GAS v4u*)(proj + (size_t)row * GDN_LD + 3 * MIXW + ch);
            float ss = (o0[0] * o0[0] + o0[1] * o0[1]) + (o0[2] * o0[2] + o0[3] * o0[3]) + (o1[0] * o1[0] + o1[1] * o1[1]) + (o1[2] * o1[2] + o1[3] * o1[3]);
            ss = grp16_sum(ss);
            const float r = 1.0f / sqrtf(ss * (1.0f / GHD) + EPS);
            float y[8];
            y[0] = o0[0] * r * g0[0] * silu_f(bflo(zv[0])); y[1] = o0[1] * r * g0[1] * silu_f(bfhi(zv[0])); y[2] = o0[2] * r * g0[2] * silu_f(bflo(zv[1])); y[3] = o0[3] * r * g0[3] * silu_f(bfhi(zv[1]));
            y[4] = o1[0] * r * g1[0] * silu_f(bflo(zv[2])); y[5] = o1[1] * r * g1[1] * silu_f(bfhi(zv[2])); y[6] = o1[2] * r * g1[2] * silu_f(bflo(zv[3])); y[7] = o1[3] * r * g1[3] * silu_f(bfhi(zv[3]));
            v4u w; w.x = pk2(y[0], y[1]); w.y = pk2(y[2], y[3]); w.z = pk2(y[4], y[5]); w.w = pk2(y[6], y[7]);
            *(GAS v4u*)(cat + (size_t)row * DM + ch) = w; }
    }
}

typedef unsigned char* const __attribute__((address_space(4)))* karg_tab_t;
__device__ __forceinline__ unsigned char* karg_ptr(int i) { asm volatile("" : "+s"(i)); return ((karg_tab_t)__builtin_amdgcn_kernarg_segment_ptr())[i]; }
#define INP(i) ((const float*)karg_ptr(i))
#define WSP(off) (karg_ptr(20) + (off))

__global__ void __launch_bounds__(NWAVES * 64, 2) fwd_kernel(Args args) {
    extern __shared__ __attribute__((aligned(16))) unsigned char lds[];
    LAS unsigned char* L = (LAS unsigned char*)lds;
    volatile LAS unsigned* MISC = (volatile LAS unsigned*)(L + MISC_OFF);
    const int tid0 = threadIdx.x;
    const int G = gridDim.x, c = blockIdx.x;
#define tid (opq_v(tid0))
#define lane (opq_v(tid0) & 63)
#define wave (__builtin_amdgcn_readfirstlane(opq_v(tid0) >> 6))
#define gw (opq_s(c) * NWAVES + __builtin_amdgcn_readfirstlane(opq_v(tid0) >> 6))
#define NGW (opq_s(G) * NWAVES)
    for (int u = tid0; u < (LDS_BYTES - LDSCTL_OFF) / 4; u += NWAVES * 64) ((LAS unsigned*)(L + LDSCTL_OFF))[u] = 0u;
    __syncthreads();
    (void)xcd_barrier_post((unsigned*)(WSP(WS_CTL)) + CW_BAR, MISC + 8);
#define GRID_BAR() do { XcdBarrier bar_; bar_.bar = (unsigned*)(WSP(WS_CTL)) + CW_BAR; bar_.x = xb_xcc_id(); bar_.st = MISC + 8; xcd_barrier(bar_); } while (0)
#if defined(TPROBE) && TPROBE == 8
#define TP_BEGIN(k) do { if ((k) == 3 && c == 0 && tid0 == 0) { const unsigned long long t_ = __builtin_amdgcn_s_memrealtime(), y_ = __builtin_amdgcn_s_memtime(); MISC[16] = (unsigned)t_; MISC[17] = (unsigned)(t_ >> 32); MISC[20] = (unsigned)y_; MISC[21] = (unsigned)(y_ >> 32); } } while (0)
#define TP_END(k) do { if ((k) == 3 && c == 0 && tid0 == 0) { const unsigned long long t_ = __builtin_amdgcn_s_memrealtime() - (((unsigned long long)MISC[17] << 32) | MISC[16]), y_ = __builtin_amdgcn_s_memtime() - (((unsigned long long)MISC[21] << 32) | MISC[20]); \
        const unsigned long long a_ = ((((unsigned long long)MISC[19] << 32) | MISC[18])) + t_, b_ = ((((unsigned long long)MISC[23] << 32) | MISC[22])) + y_; MISC[18] = (unsigned)a_; MISC[19] = (unsigned)(a_ >> 32); MISC[22] = (unsigned)b_; MISC[23] = (unsigned)(b_ >> 32); } } while (0)
#elif defined(TPROBE)
#define TP_BEGIN(k) do { if ((k) == TPROBE && c == 0 && tid0 == 0) { const unsigned long long t_ = __builtin_amdgcn_s_memrealtime(); MISC[16] = (unsigned)t_; MISC[17] = (unsigned)(t_ >> 32); } } while (0)
#define TP_END(k) do { if ((k) == TPROBE && c == 0 && tid0 == 0) { const unsigned long long t_ = __builtin_amdgcn_s_memrealtime() - (((unsigned long long)MISC[17] << 32) | MISC[16]); \
        const unsigned long long a_ = ((((unsigned long long)MISC[19] << 32) | MISC[18])) + t_; MISC[18] = (unsigned)a_; MISC[19] = (unsigned)(a_ >> 32); } } while (0)
#else
#define TP_BEGIN(k) do {} while (0)
#define TP_END(k) do {} while (0)
#endif
#ifdef NO_P0
#define PH_P0(x)
#else
#define PH_P0(x) x
#endif
#ifdef NO_KV
#define PH_KV(x)
#else
#define PH_KV(x) x
#endif
#ifdef NO_GU
#define PH_GU(x)
#else
#define PH_GU(x) x
#endif
#ifdef NO_DN
#define PH_DN(x)
#else
#define PH_DN(x) x
#endif
#ifdef NO_NORM
#define PH_NORM(x)
#else
#define PH_NORM(x) x
#endif
#ifdef NO_SCIN
#define PH_SCIN(x)
#else
#define PH_SCIN(x) x
#endif
#ifdef NO_SCG
#define PH_SCG(x)
#else
#define PH_SCG(x) x
#endif
#ifdef NO_XA
#define PH_XA(x)
#else
#define PH_XA(x) x
#endif
#ifdef NO_GDNIN
#define PH_GDNIN(x)
#else
#define PH_GDNIN(x) x
#endif
#ifdef NO_PREP
#define PH_PREP(x)
#else
#define PH_PREP(x) x
#endif
#ifdef NO_GOUT
#define PH_GOUT(x)
#else
#define PH_GOUT(x) x
#endif
#ifdef NO_WOUT
#define PH_WOUT(x)
#else
#define PH_WOUT(x) x
#endif
#ifdef NO_SCAN
#define DO_SCAN(x)
#else
#define DO_SCAN(x) x
#endif

#define Hbuf ((float*)WSP(WS_H))
#define Abuf ((bf16*)WSP(WS_A))
#define OUTb ((bf16*)WSP(WS_OUT))
#define CAT ((bf16*)WSP(WS_CAT))
#define ACT ((bf16*)WSP(WS_ACT))
#define PROJ ((bf16*)WSP(WS_PROJ))
#define AUX ((float*)WSP(WS_AUX))
#define AB ((float*)WSP(WS_AB))
#define QKVN ((bf16*)WSP(WS_QKV))
#define OBUF ((float*)WSP(WS_O))
#define KVOPS ((bf16*)WSP(WS_KVOPS))
#define KB ((bf16*)WSP(WS_KB))
#define VTB ((bf16*)WSP(WS_VTB))
#define WGU ((bf16*)WSP(WS_WGU))
#define WDN ((bf16*)WSP(WS_WDN))
#define WOUT ((bf16*)WSP(WS_WOUT))
#define WSC ((bf16*)WSP(WS_WSC))
#define WGDN ((bf16*)WSP(WS_WGDN))
#define CHB ((unsigned char*)WSP(WS_CHB))
#define UTB ((float*)WSP(WS_UT))
#define CDB ((float*)WSP(WS_CD))

    TP_BEGIN(1);
#ifndef NO_P0
    {
        LAS float* scr = (LAS float*)(L + RING_OFF + wave * XP_SCR);
        long base = 0;
        for (int job = 0; job < 40; ++job) {
            const float* W; bf16* WT; int K, N, col0 = 0, ncols, nvalid, mode = 0, roff = 0;
            if (job < 8)       { W = INP(I_WG) + (size_t)job * DM * DFF; K = DM; N = DFF; ncols = DFF; WT = WGU + (size_t)job * 2 * DFF * DM; mode = 1; roff = 0; }
            else if (job < 16) { W = INP(I_WU) + (size_t)(job - 8) * DM * DFF; K = DM; N = DFF; ncols = DFF; WT = WGU + (size_t)(job - 8) * 2 * DFF * DM; mode = 1; roff = 128; }
            else if (job < 24) { W = INP(I_WD) + (size_t)(job - 16) * DFF * DM; K = DFF; N = DM; ncols = DM; WT = WDN + (size_t)(job - 16) * DM * DFF; }
            else if (job < 28) { W = INP(I_WOUT) + (size_t)(job - 24) * DM * DM; K = DM; N = DM; ncols = DM; WT = WOUT + (size_t)(job - 24) * DM * DM; }
            else if (job < 32) { W = INP(I_WKV) + (size_t)(job - 28) * DM * 2 * XW; K = DM; N = 2 * XW; ncols = 2 * XW; WT = KVOPS + ((size_t)(job - 28) * 3072 + 1024) * DM; }
            else if (job < 34) { W = INP(I_SCIN) + (size_t)(job - 32) * DM * SC_IN; K = DM; N = SC_IN; ncols = SC_IN; WT = WSC + (size_t)(job - 32) * SC_IN * DM; }
            else if (job < 36) { W = INP(I_GDNIN) + (size_t)(job - 34) * DM * GDN_SRC; K = DM; N = GDN_SRC; ncols = 4 * MIXW; WT = WGDN + (size_t)(job - 34) * GDN_N * DM; }
            else if (job < 38) { W = INP(I_GDNIN) + (size_t)(job - 36) * DM * GDN_SRC; K = DM; N = GDN_SRC; col0 = 4 * MIXW + 2 * GH; ncols = XW; WT = WGDN + (size_t)(job - 36) * GDN_N * DM; roff = 4 * MIXW; }
            else               { W = INP(I_GDNIN) + (size_t)(job - 38) * DM * GDN_SRC; K = DM; N = GDN_SRC; col0 = 4 * MIXW; ncols = 64; WT = WGDN + (size_t)(job - 38) * GDN_N * DM; roff = GDN_LD; }
            nvalid = (job >= 38) ? 2 * GH : ncols;
            const int nblk = ncols / 64, items = (K / 64) * nblk;
            int first = (int)(((long)gw - base) % NGW); if (first < 0) first += NGW;
            const int step = NGW;
#define XP_DROW(nb_) (mode ? (256 * ((nb_) >> 1) + 64 * ((nb_) & 1) + roff) : (64 * (nb_) + roff))
            if (first < items) {
                f32x4 va[16], vb[16];
                int it = first;
                xpose_load(va, W, N, col0, nvalid, 64 * (it / nblk), 64 * (it % nblk), lane);
                for (;;) {
                    const int it1 = it + step;
                    if (it1 < items) xpose_load(vb, W, N, col0, nvalid, 64 * (it1 / nblk), 64 * (it1 % nblk), lane);
                    xpose_store(va, WT, K, XP_DROW(it % nblk), scr, 64 * (it / nblk), lane);
                    if (it1 >= items) break;
                    const int it2 = it1 + step;
                    if (it2 < items) xpose_load(va, W, N, col0, nvalid, 64 * (it2 / nblk), 64 * (it2 % nblk), lane);
                    xpose_store(vb, WT, K, XP_DROW(it1 % nblk), scr, 64 * (it1 / nblk), lane);
                    if (it2 >= items) break;
                    it = it2;
                }
            }
#undef XP_DROW
            base += items;
        }
        for (int r = gw; r < 2 * 192; r += NGW) { bf16* p = WGDN + ((size_t)(r / 192) * GDN_N + GDN_LD + 64 + (r % 192)) * DM;
#pragma unroll
            for (int j = 0; j < 8; ++j) *(GAS v4u*)(p + (j * 64 + lane) * 8) = (v4u){0u, 0u, 0u, 0u}; }
        for (int r = gw; r < NBATCH * MEMT; r += NGW) { const float* mr = INP(I_MEM) + (size_t)r * DM;
            f32x4 v[16]; float ss = 0.f;
#pragma unroll
            for (int j = 0; j < 16; ++j) { v[j] = *(const GAS f32x4*)(mr + (j * 64 + lane) * 4); ss += (v[j][0] * v[j][0] + v[j][1] * v[j][1]) + (v[j][2] * v[j][2] + v[j][3] * v[j][3]); }
            ss = wave_sum(ss); const float sc = 1.0f / sqrtf(ss * (1.0f / DM) + EPS);
            for (int l = 0; l < DEPTH; ++l) { const float* g = INP(I_MEMG) + (size_t)l * DM; bf16* dst = KVOPS + ((size_t)l * 3072 + r) * DM;
#pragma unroll
                for (int j = 0; j < 16; ++j) { const f32x4 gg = *(const GAS f32x4*)(g + (j * 64 + lane) * 4); const f32x4 a = v[j] * gg * sc;
                    v2u o; o.x = pk2(a[0], a[1]); o.y = pk2(a[2], a[3]); *(GAS v2u*)(dst + (j * 64 + lane) * 4) = o; } } }
        norm_phase(gw, NGW, lane, nullptr, 0.f, nullptr, INP(I_X), Hbuf, INP(I_FPRE), Abuf);
    }
#endif
    GRID_BAR();
    TP_END(1);

    TP_BEGIN(3);
    {
        pg8::Gemm g{KVOPS, KVOPS, 4 * 3072, 4 * 3072, DM}; pg8::KvOrder S{opq_s(G), opq_s(c)}; pg8::EpiKV E{KB, VTB};
        PH_KV((pg8::gemm_phase<pg8::EpiKV, pg8::KvOrder, PG8_ALIGN, PG8_SP2>(L + RING_OFF, g, S, E)));
    }
    TP_END(3);

#define FFN_GEMMS(f_) do { \
        TP_BEGIN(3); \
        { pg8::Gemm g{Abuf, WGU + (size_t)(l * 2 + (f_)) * 2 * DFF * DM, MROWS, 2 * DFF, DM}; pg8::StaticOrder S; S.init(MROWS, 2 * DFF, opq_s(G), opq_s(c)); pg8::EpiSwiGLU E{ACT, DFF}; \
          PH_GU((pg8::gemm_phase<pg8::EpiSwiGLU, pg8::StaticOrder, PG8_ALIGN, PG8_SP2>(L + RING_OFF, g, S, E))); } \
        GRID_BAR(); \
        { pg8::Gemm g{ACT, WDN + (size_t)(l * 2 + (f_)) * DM * DFF, MROWS, DM, DFF}; pg8::StaticOrder S; S.init(MROWS, DM, opq_s(G), opq_s(c)); pg8::EpiProj E{OUTb, DM, nullptr, -1}; \
          PH_DN((pg8::gemm_phase<pg8::EpiProj, pg8::StaticOrder, PG8_ALIGN, PG8_SP2>(L + RING_OFF, g, S, E))); } \
        GRID_BAR(); \
        TP_END(3); \
    } while (0)

    for (int l = 0; l < DEPTH; ++l) {
        const int j2 = l >> 1; const bool gdn = (l & 1) != 0;
        FFN_GEMMS(0);
        TP_BEGIN(6);
        PH_NORM(norm_phase(gw, NGW, lane, OUTb, 0.5f, INP(I_FPOST) + (size_t)(l * 2) * DM, Hbuf, Hbuf, INP(I_MPRE) + (size_t)l * DM, Abuf);)
        GRID_BAR();
        TP_END(6);
        if (!gdn) {
            TP_BEGIN(3);
            { pg8::Gemm g{Abuf, WSC + (size_t)j2 * SC_IN * DM, MROWS, SC_IN, DM}; pg8::StaticOrder S; S.init(MROWS, SC_IN, opq_s(G), opq_s(c)); pg8::EpiProj E{PROJ, SC_IN, nullptr, -1};
              PH_SCIN((pg8::gemm_phase<pg8::EpiProj, pg8::StaticOrder, PG8_ALIGN, PG8_SP2>(L + RING_OFF, g, S, E))); }
            GRID_BAR();
            TP_END(3);
            TP_BEGIN(4);
            PH_SCG(sc_gate_phase(gw, NGW, lane, PROJ, INP(I_SCCONV) + (size_t)j2 * 3 * MIXW, CAT);)
            for (int u = opq_s(c); u < 256; u += opq_s(G)) { PH_XA(xattn_unit(u, L + RING_OFF, PROJ, SC_IN, 3 * MIXW, KB + (size_t)l * 1048576, VTB + (size_t)l * 1048576, CAT, tid, wave, lane);) }
            GRID_BAR();
            TP_END(4);
        } else {
            TP_BEGIN(3);
            { pg8::Gemm g{Abuf, WGDN + (size_t)j2 * GDN_N * DM, MROWS, GDN_N, DM}; pg8::StaticOrder S; S.init(MROWS, GDN_N, opq_s(G), opq_s(c)); pg8::EpiProj E{PROJ, GDN_LD, AUX, GDN_LD / 256};
              PH_GDNIN((pg8::gemm_phase<pg8::EpiProj, pg8::StaticOrder, PG8_ALIGN, PG8_SP2>(L + RING_OFF, g, S, E))); }
            GRID_BAR();
            TP_END(3);
            TP_BEGIN(5);
            PH_PREP(gdn_prep_phase(gw, NGW, lane, PROJ, INP(I_GDNCONV) + (size_t)j2 * 4 * 3 * MIXW, QKVN, AUX, INP(I_ALOG) + j2 * GH, INP(I_DTB) + j2 * GH, AB);)
            GRID_BAR();
            TP_END(5);
            TP_BEGIN(2);
            DO_SCAN(gdn_chunk_phase(opq_s(c), opq_s(G), tid, L + RING_OFF, QKVN, AB, CHB, UTB, CDB));
            GRID_BAR();
            TP_END(2);
            TP_BEGIN(7);
            {
                const int nscan = NBATCH * GH;
                const int cq = opq_s(c);
                if (opq_s(G) == 256) {
                    if (cq < nscan) { TP_BEGIN(9); DO_SCAN(gdn_scan2_unit(cq, L + RING_OFF, CHB, UTB, CDB, OBUF, tid, wave, lane)); TP_END(9); }
                    else for (int u = cq - nscan; u < 256; u += 256 - nscan) { PH_XA(xattn_unit(u, L + RING_OFF, PROJ, GDN_LD, 4 * MIXW, KB + (size_t)l * 1048576, VTB + (size_t)l * 1048576, CAT, tid, wave, lane);) }
                } else {
                    for (int u = opq_s(c); u < nscan; u += opq_s(G)) { DO_SCAN(gdn_scan2_unit(u, L + RING_OFF, CHB, UTB, CDB, OBUF, tid, wave, lane)); }
                    for (int u = opq_s(c); u < 256; u += opq_s(G)) { PH_XA(xattn_unit(u, L + RING_OFF, PROJ, GDN_LD, 4 * MIXW, KB + (size_t)l * 1048576, VTB + (size_t)l * 1048576, CAT, tid, wave, lane);) }
                }
            }
            GRID_BAR();
            TP_END(7);
            TP_BEGIN(5);
            PH_GOUT(gdn_out_phase(gw, NGW, lane, OBUF, PROJ, INP(I_NORMG) + j2 * GHD, CAT);)
            GRID_BAR();
            TP_END(5);
        }
        TP_BEGIN(3);
        { pg8::Gemm g{CAT, WOUT + (size_t)l * DM * DM, MROWS, DM, DM}; pg8::StaticOrder S; S.init(MROWS, DM, opq_s(G), opq_s(c)); pg8::EpiProj E{OUTb, DM, nullptr, -1};
          PH_WOUT((pg8::gemm_phase<pg8::EpiProj, pg8::StaticOrder, PG8_ALIGN, PG8_SP2>(L + RING_OFF, g, S, E))); }
        GRID_BAR();
        TP_END(3);
        TP_BEGIN(6);
        PH_NORM(norm_phase(gw, NGW, lane, OUTb, 1.0f, INP(I_MPOST) + (size_t)l * DM, Hbuf, Hbuf, INP(I_FPRE) + (size_t)(l * 2 + 1) * DM, Abuf);)
        GRID_BAR();
        TP_END(6);
        FFN_GEMMS(1);
        TP_BEGIN(6);
        if (l < DEPTH - 1) {
            PH_NORM(norm_phase(gw, NGW, lane, OUTb, 0.5f, INP(I_FPOST) + (size_t)(l * 2 + 1) * DM, Hbuf, Hbuf, INP(I_FPRE) + (size_t)((l + 1) * 2) * DM, Abuf);)
            GRID_BAR();
        } else {
            PH_NORM(norm_phase(gw, NGW, lane, OUTb, 0.5f, INP(I_FPOST) + (size_t)(l * 2 + 1) * DM, Hbuf, ((float*)karg_ptr(19)), nullptr, nullptr);)
        }
        TP_END(6);
    }
#ifdef TPROBE
    if (c == 0 && tid0 == 0) { unsigned long long a_ = (((unsigned long long)MISC[19] << 32) | MISC[18]); const unsigned long long t0_ = __builtin_amdgcn_s_memrealtime();
#if TPROBE == 8
        { const unsigned long long b_ = (((unsigned long long)MISC[23] << 32) | MISC[22]); a_ = b_ * 10000ull / (a_ ? a_ : 1ull); }
#endif
        while (__builtin_amdgcn_s_memrealtime() - t0_ < a_) __builtin_amdgcn_s_sleep(8); }
#endif
#undef FFN_GEMMS
#undef GRID_BAR
#undef tid
#undef lane
#undef wave
#undef gw
#undef NGW
}

extern "C" void kernel_launch(void* const* d_in, const int* in_sizes, int n_in, void* d_out, int out_size, void* d_ws, size_t ws_size, hipStream_t stream) {
    static int grid = 0;
    if (grid == 0) {
        if (n_in != 19 || in_sizes[0] != MROWS * DM || out_size != MROWS * DM || ws_size < WS_END) {
            fprintf(stderr, "kernel_launch: unexpected problem (n_in %d, in0 %d, out %d, ws %zu, need %zu); nothing launched\n", n_in, n_in > 0 ? in_sizes[0] : -1, out_size, ws_size, (size_t)WS_END); grid = -1; return; }
        int dev = 0, cus = 0, per_cu = 0;
        if (hipGetDevice(&dev) != hipSuccess || hipDeviceGetAttribute(&cus, hipDeviceAttributeMultiprocessorCount, dev) != hipSuccess) { fprintf(stderr, "kernel_launch: device query failed\n"); grid = -1; return; }
        if (hipFuncSetAttribute((const void*)fwd_kernel, hipFuncAttributeMaxDynamicSharedMemorySize, LDS_BYTES) != hipSuccess) { fprintf(stderr, "kernel_launch: hipFuncSetAttribute failed\n"); grid = -1; return; }
        if (hipOccupancyMaxActiveBlocksPerMultiprocessor(&per_cu, (const void*)fwd_kernel, NWAVES * 64, LDS_BYTES) != hipSuccess || per_cu < 1)
            fprintf(stderr, "kernel_launch: note: occupancy query reports %d workgroups per CU\n", per_cu);
        (void)hipGetLastError();
        grid = cus;
    }
    if (grid < 0) return;
    if (hipMemsetAsync((char*)d_ws + WS_CTL, 0, CTL_ZERO_BYTES, stream) != hipSuccess) { fprintf(stderr, "kernel_launch: memset failed\n"); return; }
    Args a{};
    for (int i = 0; i < 19; ++i) a.in[i] = (const float*)d_in[i];
    a.out = (float*)d_out; a.ws = (unsigned char*)d_ws;
    hipLaunchKernelGGL(fwd_kernel, dim3(grid), dim3(NWAVES * 64), LDS_BYTES, stream, a);
    const hipError_t le = hipPeekAtLastError();
    if (le != hipSuccess) fprintf(stderr, "kernel_launch: launch failed: %s\n", hipGetErrorName(le));
}
```

```cpp
#include <hip/hip_runtime.h>
#include <cstdio>
#include <cstdint>
namespace pg8 {
#define PG8_LAS __attribute__((address_space(3)))
typedef unsigned short bf16_t;
typedef short bf16x8 __attribute__((ext_vector_type(8)));
typedef float f32x4 __attribute__((ext_vector_type(4)));
typedef unsigned u32x4 __attribute__((ext_vector_type(4)));
constexpr int BM = 256, BK = 64, HALF = 128, HTB = HALF * BK * 2  , STAGE_BYTES = 8 * HTB, NXCD = 8, WGM = 8;

__host__ __device__ __forceinline__ int lds_byte(int r, int c) { const int st = (r >> 4) * 2 + (c >> 5), rr = r & 15, cc = c & 31, ob = rr * 64 + cc * 2; return st * 1024 + (ob ^ (((ob >> 9) & 1) << 5)); }
__host__ __device__ __forceinline__ void stage_rc(int b, int& R, int& C) { const int st = b / 1024, sb = b % 1024, swz = sb ^ (((sb >> 9) & 1) << 5); R = (st >> 1) * 16 + swz / 64; C = (st & 1) * 32 + (swz % 64) / 2; }
__host__ __device__ __forceinline__ int perm32(int rho) { const int n = rho >> 4, i = rho & 15; return 8 * (i >> 2) + 4 * n + (i & 3); }

struct Unit { int pm, pn; };
struct Gemm { const bf16_t* A; const bf16_t* Bt; int M, N, K; };

struct StaticOrder {
    int nM, nN, nwg, G, c;
    __host__ __device__ void init(int M, int N, int G_, int c_) { nM = M / BM; nN = N / BM; nwg = nM * nN; G = G_; c = c_; }
    __host__ __device__ bool next(int i, Unit& u) const {
        const long L = (long)i * G + c; if (L >= nwg) return false;
        int wgid = (int)L; { const int q = nwg / NXCD, r = nwg % NXCD, xcd = wgid % NXCD, off = wgid / NXCD; wgid = (xcd < r ? xcd * (q + 1) : r * (q + 1) + (xcd - r) * q) + off; }
        const int nig = WGM * nN, gid = wgid / nig, fm = gid * WGM, gsz = (nM - fm) < WGM ? (nM - fm) : WGM;
        u.pm = fm + ((wgid % nig) % gsz); u.pn = (wgid % nig) / gsz; return true;
    }
    __device__ __forceinline__ void a_ready(const Unit&) const {}
    __device__ __forceinline__ void done(const Unit&) const {}
};

__device__ __forceinline__ unsigned cvt_pk_bf16(float lo, float hi) { unsigned r; asm volatile("v_cvt_pk_bf16_f32 %0, %1, %2" : "=v"(r) : "v"(lo), "v"(hi)); return r; }

struct EpiProj {
    static constexpr bool PERM = true, AFTER_DRAIN = false;
    bf16_t* O; int ldc; float* aux; int aux_pn;
    __device__ __forceinline__ void operator()(const f32x4 (&acc)[2][2][4][2], const Unit& u, int wr, int wc, int fr, int fq) const {
        const int row0 = u.pm * BM + wr * 64 + fr;
        if (u.pn == aux_pn) {
            if (wc < 2) {
#pragma unroll
                for (int ai = 0; ai < 2; ++ai)
#pragma unroll
                    for (int m = 0; m < 4; ++m) { float* rowp = aux + (size_t)(row0 + ai * HALF + m * 16) * 64 + wc * 32 + 8 * fq;
                        *(f32x4*)(rowp) = acc[ai][0][m][0]; *(f32x4*)(rowp + 4) = acc[ai][0][m][1]; }
            }
            return;
        }
        const int col0 = u.pn * BM + wc * 32 + 8 * fq;
#pragma unroll
        for (int ai = 0; ai < 2; ++ai)
#pragma unroll
            for (int m = 0; m < 4; ++m) { bf16_t* rowp = O + (size_t)(row0 + ai * HALF + m * 16) * ldc + col0;
#pragma unroll
                for (int bj = 0; bj < 2; ++bj) { const f32x4 v0 = acc[ai][bj][m][0], v1 = acc[ai][bj][m][1];
                    u32x4 w; w.x = cvt_pk_bf16(v0[0], v0[1]); w.y = cvt_pk_bf16(v0[2], v0[3]); w.z = cvt_pk_bf16(v1[0], v1[1]); w.w = cvt_pk_bf16(v1[2], v1[3]);
                    *(u32x4*)(rowp + bj * HALF) = w; } }
    }
};
struct EpiSwiGLU {
    static constexpr bool PERM = true, AFTER_DRAIN = false;
    bf16_t* O; int ldc;
    __device__ __forceinline__ void operator()(const f32x4 (&acc)[2][2][4][2], const Unit& u, int wr, int wc, int fr, int fq) const {
        const int row0 = u.pm * BM + wr * 64 + fr, col0 = u.pn * HALF + wc * 32 + 8 * fq;
#pragma unroll
        for (int ai = 0; ai < 2; ++ai)
#pragma unroll
            for (int m = 0; m < 4; ++m) { bf16_t* rowp = O + (size_t)(row0 + ai * HALF + m * 16) * ldc + col0;
                f32x4 r[2];
#pragma unroll
                for (int n = 0; n < 2; ++n)
#pragma unroll
                    for (int j = 0; j < 4; ++j) { const float g = acc[ai][0][m][n][j], up = acc[ai][1][m][n][j];
                        r[n][j] = g * up * __builtin_amdgcn_rcpf(1.0f + __builtin_amdgcn_exp2f(g * -1.44269504089f)); }
                u32x4 w; w.x = cvt_pk_bf16(r[0][0], r[0][1]); w.y = cvt_pk_bf16(r[0][2], r[0][3]); w.z = cvt_pk_bf16(r[1][0], r[1][1]); w.w = cvt_pk_bf16(r[1][2], r[1][3]);
                *(u32x4*)(rowp) = w; }
    }
};
struct EpiKV {
    static constexpr bool PERM = true, AFTER_DRAIN = false;
    bf16_t* Kb; bf16_t* VTb;
    __device__ __forceinline__ void operator()(const f32x4 (&acc)[2][2][4][2], const Unit& u, int wr, int wc, int fr, int fq) const {
        const int l = u.pm / 12, ri = u.pm % 12, rj = u.pn % 12;
        bf16_t* base = (ri < 4) ? Kb + (size_t)l * 1048576 + (size_t)(ri * 256) * 1024 + (rj - 4) * 256
                                : VTb + (size_t)l * 1048576 + (size_t)((ri - 8) * 256) * 1024 + rj * 256;
        const int row0 = wr * 64 + fr, col0 = wc * 32 + 8 * fq;
        const int p0 = 8 * ((2 * fq) & 3) + 4 * (fq >> 1), p1 = 8 * ((2 * fq + 1) & 3) + 4 * (fq >> 1);
        typedef unsigned u32x2e __attribute__((ext_vector_type(2)));
#pragma unroll
        for (int ai = 0; ai < 2; ++ai)
#pragma unroll
            for (int m = 0; m < 4; ++m) { bf16_t* rowp = base + (size_t)(row0 + ai * HALF + m * 16) * 1024;
#pragma unroll
                for (int bj = 0; bj < 2; ++bj) { const f32x4 v0 = acc[ai][bj][m][0], v1 = acc[ai][bj][m][1];
                    u32x4 w; w.x = cvt_pk_bf16(v0[0], v0[1]); w.y = cvt_pk_bf16(v0[2], v0[3]); w.z = cvt_pk_bf16(v1[0], v1[1]); w.w = cvt_pk_bf16(v1[2], v1[3]);
                    if (ri < 4) *(u32x4*)(rowp + col0 + bj * HALF) = w;
                    else { *(u32x2e*)(rowp + wc * 32 + bj * HALF + p0) = (u32x2e){w.x, w.y}; *(u32x2e*)(rowp + wc * 32 + bj * HALF + p1) = (u32x2e){w.z, w.w}; } } }
    }
};
struct KvOrder {
    int nwg, c, lbase, nunits;
    __device__ __forceinline__ bool next(int i, Unit& u) const {
        if (c < 0) return false;
        const int L = i * nwg + c; if (L >= nunits) return false;
        const int l = lbase + (L >> 5), r = L & 31;
        if (r < 16) { u.pm = 12 * l + (r >> 2); u.pn = 12 * l + 4 + (r & 3); }
        else { u.pm = 12 * l + 8 + ((r - 16) >> 2); u.pn = 12 * l + (r & 3); }
        return true;
    }
    __device__ __forceinline__ void a_ready(const Unit&) const {}
    __device__ __forceinline__ void done(const Unit&) const {}
};

template <class Epi, class Sched, bool ALIGN_EPI = false, bool SP2 = false>
__device__ __forceinline__ void gemm_phase(PG8_LAS unsigned char* lds, const Gemm g, const Sched& S, const Epi& E) {
    int tid_o = threadIdx.x; asm volatile("" : "+v"(tid_o));
    const int tid = tid_o, wid = __builtin_amdgcn_readfirstlane(tid >> 6), lane = tid & 63, wr = wid >> 2, wc = wid & 3, fr = lane & 15, fq = lane >> 4;
    const int K = g.K, nt = K / BK;
    unsigned voffA[2], voffB[2];
#pragma unroll
    for (int i = 0; i < 2; ++i) { int R, C; stage_rc(tid * 16 + i * 8192, R, C); const int Rb = Epi::PERM ? ((R & ~31) + perm32(R & 31)) : R;
        voffA[i] = (unsigned)(R * K + C) * 2u; voffB[i] = (unsigned)(Rb * K + C) * 2u; }
    const size_t kstep = (size_t)(BK * 2);
    const size_t hstep = (size_t)HALF * K * 2;
    const size_t tstep = 2 * hstep;
    const unsigned ldsw = (unsigned)wid * 1024u;
    const int aoff = lds_byte(wr * 64 + fr, fq * 8), boff = lds_byte(wc * 32 + fr, fq * 8);
#define PG8_SA(b, h) (((b) * 2 + (h)) * HTB)
#define PG8_SB(b, h) ((4 + (b) * 2 + (h)) * HTB)
#define PG8_STAGE(bufoff, gbase, voff) do { _Pragma("unroll") for (int _i = 0; _i < 2; ++_i) \
        __builtin_amdgcn_global_load_lds((const unsigned*)((const char*)(gbase) + (voff)[_i]), (PG8_LAS unsigned*)(lds + (bufoff) + ldsw + _i * 8192), 16, 0, 0); } while (0)
#define PG8_LDA(dst, b, h) do { _Pragma("unroll") for (int m = 0; m < 4; ++m) _Pragma("unroll") for (int k = 0; k < 2; ++k) dst[m][k] = *(const PG8_LAS bf16x8*)(lds + PG8_SA(b, h) + aoff + m * 2048 + k * 1024); } while (0)
#define PG8_LDB(dst, b, h) do { _Pragma("unroll") for (int n = 0; n < 2; ++n) _Pragma("unroll") for (int k = 0; k < 2; ++k) dst[n][k] = *(const PG8_LAS bf16x8*)(lds + PG8_SB(b, h) + boff + n * 2048 + k * 1024); } while (0)
#define PG8_MMA(ai, bj, At, Bt) do { __builtin_amdgcn_s_setprio(1); _Pragma("unroll") for (int m = 0; m < 4; ++m) _Pragma("unroll") for (int n = 0; n < 2; ++n) _Pragma("unroll") for (int k = 0; k < 2; ++k) \
        acc[ai][bj][m][n] = __builtin_amdgcn_mfma_f32_16x16x32_bf16(Bt[n][k], At[m][k], acc[ai][bj][m][n], 0, 0, 0); __builtin_amdgcn_s_setprio(0); } while (0)
#define PG8_WAIT_V(n) asm volatile("s_waitcnt vmcnt(" #n ")" ::: "memory")
#define PG8_WAIT_L(n) asm volatile("s_waitcnt lgkmcnt(" #n ")" ::: "memory")
#define PG8_BAR __builtin_amdgcn_s_barrier()
#define PG8_SCHED __builtin_amdgcn_sched_barrier(0)
    Unit cur, nxt; int ui = 0;
    if (!S.next(0, cur)) return;
    f32x4 acc[2][2][4][2];
#pragma unroll
    for (int a = 0; a < 2; ++a)
#pragma unroll
        for (int b = 0; b < 2; ++b)
#pragma unroll
            for (int m = 0; m < 4; ++m)
#pragma unroll
                for (int n = 0; n < 2; ++n) acc[a][b][m][n] = (f32x4){0.f, 0.f, 0.f, 0.f};
    bf16x8 At[4][2], B0[2][2], B1[2][2];
    const char* cA = (const char*)g.A + (size_t)cur.pm * tstep; const char* cB = (const char*)g.Bt + (size_t)cur.pn * tstep;
    S.a_ready(cur);
    if constexpr (SP2) {
        PG8_STAGE(PG8_SB(0, 0), cB, voffB); PG8_STAGE(PG8_SB(0, 1), cB + hstep, voffB); PG8_STAGE(PG8_SA(0, 0), cA, voffA); PG8_STAGE(PG8_SA(0, 1), cA + hstep, voffA);
        if (wr == 1) PG8_BAR;
        PG8_WAIT_V(2); PG8_BAR;
        PG8_STAGE(PG8_SB(1, 0), cB + kstep, voffB); PG8_STAGE(PG8_SA(1, 0), cA + kstep, voffA); PG8_STAGE(PG8_SB(1, 1), cB + hstep + kstep, voffB);
        PG8_WAIT_V(6); PG8_BAR;
    } else {
        PG8_STAGE(PG8_SB(0, 0), cB, voffB); PG8_STAGE(PG8_SA(0, 0), cA, voffA); PG8_STAGE(PG8_SB(0, 1), cB + hstep, voffB); PG8_STAGE(PG8_SA(0, 1), cA + hstep, voffA);
        if (wr == 1) PG8_BAR;
        PG8_WAIT_V(4); PG8_BAR;
        PG8_STAGE(PG8_SB(1, 0), cB + kstep, voffB); PG8_STAGE(PG8_SA(1, 0), cA + kstep, voffA); PG8_STAGE(PG8_SB(1, 1), cB + hstep + kstep, voffB);
        PG8_WAIT_V(6); PG8_BAR;
    }
    for (;;) {
        const bool has_next = S.next(ui + 1, nxt);
        const char* nA = has_next ? (const char*)g.A + (size_t)nxt.pm * tstep : cA; const char* nB = has_next ? (const char*)g.Bt + (size_t)nxt.pn * tstep : cB;
        for (int t = 0; t < nt; t += 2) {
            const bool last = (t == nt - 2);
            const char* a1 = cA + (size_t)(t + 1) * kstep;
            const char* a2 = last ? nA : cA + (size_t)(t + 2) * kstep; const char* b2 = last ? nB : cB + (size_t)(t + 2) * kstep;
            const char* a3 = a2 + kstep; const char* b3 = b2 + kstep;
            if (last && has_next) S.a_ready(nxt);
            if constexpr (SP2) {
            PG8_LDB(B0, 0, 0); PG8_LDB(B1, 0, 1); PG8_SCHED; PG8_LDA(At, 0, 0); PG8_STAGE(PG8_SA(1, 1), a1 + hstep, voffA);
            PG8_WAIT_V(8); PG8_WAIT_L(0); PG8_BAR; PG8_MMA(0, 0, At, B0); PG8_MMA(0, 1, At, B1); PG8_BAR; PG8_SCHED;
            PG8_LDA(At, 0, 1); PG8_STAGE(PG8_SB(0, 0), b2, voffB); PG8_STAGE(PG8_SB(0, 1), b2 + hstep, voffB); PG8_STAGE(PG8_SA(0, 0), a2, voffA);
            PG8_WAIT_V(8); PG8_WAIT_L(0); PG8_BAR; PG8_MMA(1, 0, At, B0); PG8_MMA(1, 1, At, B1); PG8_BAR; PG8_SCHED;
            PG8_LDB(B0, 1, 0); PG8_LDB(B1, 1, 1); PG8_SCHED; PG8_LDA(At, 1, 0); PG8_STAGE(PG8_SA(0, 1), a2 + hstep, voffA);
            PG8_WAIT_V(8); PG8_WAIT_L(0); PG8_BAR; PG8_MMA(0, 0, At, B0); PG8_MMA(0, 1, At, B1); PG8_BAR; PG8_SCHED;
            PG8_LDA(At, 1, 1); PG8_STAGE(PG8_SB(1, 0), b3, voffB); PG8_STAGE(PG8_SB(1, 1), b3 + hstep, voffB); PG8_STAGE(PG8_SA(1, 0), a3, voffA);
            PG8_WAIT_V(8); PG8_WAIT_L(0); PG8_BAR; PG8_MMA(1, 0, At, B0); PG8_MMA(1, 1, At, B1); PG8_BAR; PG8_SCHED;
            } else {
            PG8_LDB(B0, 0, 0); PG8_SCHED; PG8_LDA(At, 0, 0); PG8_STAGE(PG8_SA(1, 1), a1 + hstep, voffA);
            PG8_WAIT_L(8); PG8_BAR; PG8_WAIT_L(0); PG8_MMA(0, 0, At, B0); PG8_BAR; PG8_SCHED;
            PG8_LDB(B1, 0, 1); PG8_STAGE(PG8_SB(0, 0), b2, voffB);
            PG8_BAR; PG8_WAIT_L(0); PG8_MMA(0, 1, At, B1); PG8_BAR;
            PG8_LDA(At, 0, 1); PG8_STAGE(PG8_SA(0, 0), a2, voffA);
            PG8_BAR; PG8_WAIT_L(0); PG8_MMA(1, 0, At, B0); PG8_BAR; PG8_SCHED;
            PG8_STAGE(PG8_SB(0, 1), b2 + hstep, voffB);
            PG8_WAIT_V(6); PG8_BAR; PG8_MMA(1, 1, At, B1); PG8_BAR;
            PG8_LDB(B0, 1, 0); PG8_SCHED; PG8_LDA(At, 1, 0); PG8_STAGE(PG8_SA(0, 1), a2 + hstep, voffA);
            PG8_WAIT_L(8); PG8_BAR; PG8_WAIT_L(0); PG8_MMA(0, 0, At, B0); PG8_BAR; PG8_SCHED;
            PG8_LDB(B1, 1, 1); PG8_STAGE(PG8_SB(1, 0), b3, voffB);
            PG8_BAR; PG8_WAIT_L(0); PG8_MMA(0, 1, At, B1); PG8_BAR;
            PG8_LDA(At, 1, 1); PG8_STAGE(PG8_SA(1, 0), a3, voffA);
            PG8_BAR; PG8_WAIT_L(0); PG8_MMA(1, 0, At, B0); PG8_BAR; PG8_SCHED;
            PG8_STAGE(PG8_SB(1, 1), b3 + hstep, voffB);
            PG8_WAIT_V(6); PG8_BAR; PG8_MMA(1, 1, At, B1); PG8_BAR;
            }
        }
        if constexpr (ALIGN_EPI) { if (wr == 0) PG8_BAR; }
        if constexpr (!Epi::AFTER_DRAIN) { E(acc, cur, wr, wc, fr, fq); S.done(cur); }
        if (!has_next) break;
#pragma unroll
        for (int a = 0; a < 2; ++a)
#pragma unroll
            for (int b = 0; b < 2; ++b)
#pragma unroll
                for (int m = 0; m < 4; ++m)
#pragma unroll
                    for (int n = 0; n < 2; ++n) acc[a][b][m][n] = (f32x4){0.f, 0.f, 0.f, 0.f};
        cur = nxt; cA = nA; cB = nB; ++ui;
        if constexpr (ALIGN_EPI) { if (wr == 1) PG8_BAR; }
    }
    PG8_WAIT_V(0);
    if constexpr (!ALIGN_EPI) { if (wr == 0) PG8_BAR; }
    PG8_BAR;
    if constexpr (Epi::AFTER_DRAIN) { E.fused(acc, cur, wr, wc, fr, fq, lds, wid, lane); S.done(cur); }
#undef PG8_SA
#undef PG8_SB
#undef PG8_STAGE
#undef PG8_LDA
#undef PG8_LDB
#undef PG8_MMA
#undef PG8_WAIT_V
#undef PG8_WAIT_L
#undef PG8_BAR
#undef PG8_SCHED
}
}

#ifndef PG8_SP2
#define PG8_SP2 true
#endif
#ifndef PG8_ALIGN
#define PG8_ALIGN true
#endif

constexpr int NWAVES = 8;
constexpr int DM = 4096, NBATCH = 4, SEQ = 2048, MROWS = NBATCH * SEQ, DEPTH = 4;
constexpr int MEMT = 256, XH = 4, XW = 1024, XHD = 256, MIXW = 3072, DFF = 6144;
constexpr int GH = 24, GHD = 128;
constexpr int SC_IN = 3 * MIXW + XW;
constexpr int GDN_SRC = 4 * MIXW + 2 * GH + XW;
constexpr int GDN_LD = 4 * MIXW + XW;
constexpr int GDN_N = GDN_LD + 256;
constexpr float EPS = 1e-6f;

constexpr size_t MiB = 1u << 20;
constexpr size_t WS_CTL = 0, CTL_ZERO_BYTES = 1 * MiB;
constexpr size_t WS_H = 1 * MiB;
constexpr size_t WS_A = WS_H + 128 * MiB;
constexpr size_t WS_OUT = WS_A + 64 * MiB;
constexpr size_t WS_CAT = WS_OUT + 64 * MiB;
constexpr size_t WS_ACT = WS_CAT + 64 * MiB;
constexpr size_t WS_PROJ = WS_ACT + 96 * MiB;
constexpr size_t WS_AUX = WS_PROJ + 208 * MiB;
constexpr size_t WS_AB = WS_AUX + 2 * MiB;
constexpr size_t WS_QKV = WS_AB + 2 * MiB;
constexpr size_t WS_O = WS_QKV + 144 * MiB;
constexpr size_t WS_KVOPS = WS_O + 96 * MiB;
constexpr size_t WS_KB = WS_KVOPS + 96 * MiB;
constexpr size_t WS_VTB = WS_KB + 8 * MiB;
constexpr size_t WS_WGU = WS_VTB + 8 * MiB;
constexpr size_t WS_WDN = WS_WGU + 768 * MiB;
constexpr size_t WS_WOUT = WS_WDN + 384 * MiB;
constexpr size_t WS_WSC = WS_WOUT + 128 * MiB;
constexpr size_t WS_WGDN = WS_WSC + 160 * MiB;
constexpr size_t WS_CHB = WS_WGDN + 212 * MiB;
constexpr size_t WS_UT = WS_CHB + 168 * MiB;
constexpr size_t WS_CD = WS_UT + 96 * MiB;
constexpr size_t WS_END = WS_CD + 1 * MiB;
constexpr int CW_BAR = 4096;

constexpr int RING_OFF = 0, RING_BYTES = 131072;
constexpr int XP_SCR = 64 * 65 * 4;
constexpr int LDSCTL_OFF = 139264, MISC_OFF = LDSCTL_OFF + 320;
static_assert(LDSCTL_OFF >= 8 * XP_SCR, "LDS map");
static_assert(LDSCTL_OFF >= RING_BYTES, "LDS map");
constexpr int LDS_BYTES = 147456;

#define GAS __attribute__((address_space(1)))
#define LAS __attribute__((address_space(3)))
typedef unsigned short bf16;
typedef unsigned v4u __attribute__((ext_vector_type(4)));
typedef unsigned v2u __attribute__((ext_vector_type(2)));
typedef float f32x4 __attribute__((ext_vector_type(4)));
typedef float f32x2 __attribute__((ext_vector_type(2)));
typedef short bf16x8 __attribute__((ext_vector_type(8)));
#define LDS_WAIT() asm volatile("s_waitcnt lgkmcnt(0)" ::: "memory")
#define VM_WAIT() asm volatile("s_waitcnt vmcnt(0)" ::: "memory")
__device__ __forceinline__ unsigned pk2(float lo, float hi) { return pg8::cvt_pk_bf16(lo, hi); }
__device__ __forceinline__ float bflo(unsigned u) { return __uint_as_float(u << 16); }
__device__ __forceinline__ float bfhi(unsigned u) { return __uint_as_float(u & 0xffff0000u); }
__device__ __forceinline__ float silu_f(float x) { return x * __builtin_amdgcn_rcpf(1.0f + __builtin_amdgcn_exp2f(x * -1.44269504089f)); }
__device__ __forceinline__ int opq_v(int x) { asm volatile("" : "+v"(x)); return x; }
__device__ __forceinline__ int opq_s(int x) { asm volatile("" : "+s"(x)); return x; }

#define XB_TMO      128
#define XB_XCNT(j)  (256  + 64 * (j))
#define XB_XSUB(j)  (1280 + 64 * (j))
#define XB_XGEN(j)  (2304 + 64 * (j))
#define XB_TOP      3328
#define XB_TOPGEN   3392
#define XCD_BAR_WORDS 3456
#define XB_SPIN_CAP (1u << 18)

__device__ __forceinline__ unsigned xb_ld(unsigned* p)              { return __hip_atomic_load(p, __ATOMIC_RELAXED, __HIP_MEMORY_SCOPE_AGENT); }
__device__ __forceinline__ unsigned xb_add(unsigned* p, unsigned v) { return __hip_atomic_fetch_add(p, v, __ATOMIC_RELAXED, __HIP_MEMORY_SCOPE_AGENT); }
__device__ __forceinline__ unsigned xb_xcc_id() { return (unsigned)__builtin_amdgcn_s_getreg((3 << 11) | 20) & 0xFu; }
#define XB_SPIN(cond, bar) do { unsigned _sp = 0; while (cond) { __builtin_amdgcn_s_sleep(1); \
    if ((++_sp & 255u) == 0u) { if (xb_ld(&(bar)[XB_TMO])) break; if (_sp > XB_SPIN_CAP) { atomicAdd(&(bar)[XB_TMO], 1u); break; } } } } while (0)

struct XcdBarrier {
    unsigned* bar; unsigned x;
    volatile LAS unsigned* st;
};
__device__ __forceinline__ XcdBarrier xcd_barrier_post(unsigned* bar, volatile LAS unsigned* st) {
    XcdBarrier b; b.bar = bar; b.x = xb_xcc_id(); b.st = st;
    if (threadIdx.x == 0) (void)xb_add(&bar[XB_XCNT(b.x)], 1u);
    return b;
}
__device__ __forceinline__ void xcd_barrier_complete(unsigned* bar, unsigned x, unsigned& nloc, unsigned& nx) {
    const unsigned G = gridDim.x * gridDim.y * gridDim.z;
    unsigned sum, cnt, mine, sp = 0u;
    for (;;) {
        sum = 0u; cnt = 0u; mine = 0u;
#pragma unroll
        for (unsigned j = 0; j < 16; ++j) { const unsigned c = xb_ld(&bar[XB_XCNT(j)]); sum += c; cnt += (c > 0u) ? 1u : 0u; mine = (j == x) ? c : mine; }
        if (sum == G) break;
        __builtin_amdgcn_s_sleep(1);
        if ((++sp & 255u) == 0u) { if (xb_ld(&bar[XB_TMO])) break; if (sp > XB_SPIN_CAP) { atomicAdd(&bar[XB_TMO], 1u); break; } }
    }
    nloc = mine > 0u ? mine : 1u; nx = cnt > 0u ? cnt : 1u;
}
__device__ __forceinline__ void xcd_barrier(const XcdBarrier& b) {
    asm volatile("s_waitcnt vmcnt(0)" ::: "memory");
    __syncthreads();
    if (threadIdx.x == 0) {
        unsigned* bar = b.bar;
        __builtin_amdgcn_s_waitcnt(0);
        unsigned nloc = b.st[0], nx = b.st[1];
        if (nloc == 0u) { xcd_barrier_complete(bar, b.x, nloc, nx); b.st[0] = nloc; b.st[1] = nx; }
        const unsigned old = xb_add(&bar[XB_XSUB(b.x)], 1u);
        const unsigned gen = old / nloc;
        if (old + 1u == (gen + 1u) * nloc) {
            __builtin_amdgcn_fence(__ATOMIC_RELEASE, "agent");
            asm volatile("s_waitcnt vmcnt(0)" ::: "memory");
            const unsigned og = xb_add(&bar[XB_TOP], 1u);
            const unsigned tg = og / nx;
            if (og + 1u == (tg + 1u) * nx) xb_add(&bar[XB_TOPGEN], 1u);
            else XB_SPIN(xb_ld(&bar[XB_TOPGEN]) == tg, bar);
            __builtin_amdgcn_fence(__ATOMIC_ACQUIRE, "agent");
            xb_add(&bar[XB_XGEN(b.x)], 1u);
            asm volatile("s_waitcnt vmcnt(0)" ::: "memory");
        } else {
            XB_SPIN(xb_ld(&bar[XB_XGEN(b.x)]) == gen, bar);
            __builtin_amdgcn_fence(__ATOMIC_ACQUIRE, "agent");
            asm volatile("s_waitcnt vmcnt(0)" ::: "memory");
        }
    }
    __syncthreads();
}

__device__ __forceinline__ float wave_sum(float v) {
#pragma unroll
    for (int o = 1; o < 64; o <<= 1) v += __shfl_xor(v, o);
    return v;
}
__device__ __forceinline__ float grp16_sum(float v) {
#pragma unroll
    for (int o = 1; o < 16; o <<= 1) v += __shfl_xor(v, o);
    return v;
}
template <int CTRL> __device__ __forceinline__ float dpp_mov(float v) {
    return __builtin_bit_cast(float, __builtin_amdgcn_update_dpp(0, __builtin_bit_cast(int, v), CTRL, 0xF, 0xF, true));
}
__device__ __forceinline__ float grp8_sum(float v) {
    v += dpp_mov<0xB1>(v); v += dpp_mov<0x4E>(v); v += dpp_mov<0x141>(v); return v;
}

__device__ __forceinline__ void xpose_load(f32x4 (&v)[16], const float* W, int N, int col0, int nvalid, int k0, int n0, int lane) {
    const int nn = n0 + 4 * (lane & 15); const bool ok = nn < nvalid;
    const float* p = W + (size_t)(k0 + (lane >> 4)) * N + col0 + nn;
#pragma unroll
    for (int i = 0; i < 16; ++i) v[i] = ok ? __builtin_nontemporal_load((const GAS f32x4*)(p + (size_t)(4 * i) * N)) : (f32x4){0.f, 0.f, 0.f, 0.f};
}
__device__ __forceinline__ void xpose_store(const f32x4 (&v)[16], bf16* WT, int Kd, int drow0, LAS float* scr, int k0, int lane) {
    LAS float* w = scr + (lane >> 4) * 65 + 4 * (lane & 15);
#pragma unroll
    for (int i = 0; i < 16; ++i) { w[(4 * i) * 65 + 0] = v[i][0]; w[(4 * i) * 65 + 1] = v[i][1]; w[(4 * i) * 65 + 2] = v[i][2]; w[(4 * i) * 65 + 3] = v[i][3]; }
    LDS_WAIT(); asm volatile("" ::: "memory");
    const int c = lane & 7;
#pragma unroll
    for (int j = 0; j < 8; ++j) { const int n = (lane >> 3) + 8 * j; const LAS float* s = scr + (8 * c) * 65 + n;
        v4u o; o.x = pk2(s[0 * 65], s[1 * 65]); o.y = pk2(s[2 * 65], s[3 * 65]); o.z = pk2(s[4 * 65], s[5 * 65]); o.w = pk2(s[6 * 65], s[7 * 65]);
        __builtin_nontemporal_store(o, (GAS v4u*)(WT + (size_t)(drow0 + n) * Kd + k0 + 8 * c)); }
    LDS_WAIT(); asm volatile("" ::: "memory");
}

struct Args { const float* in[19]; float* out; unsigned char* ws; };
enum { I_X = 0, I_MEM, I_FPRE, I_FPOST, I_MPRE, I_MPOST, I_MEMG, I_WG, I_WU, I_WD, I_WKV, I_WOUT, I_SCIN, I_SCCONV, I_GDNIN, I_GDNCONV, I_ALOG, I_DTB, I_NORMG };

__device__ __forceinline__ void norm_load(f32x4 (&hv)[16], v4u (&ov)[8], const void* hsrc, bool h16, const bf16* outb, int row, int lane) {
    if (h16) { const bf16* hr = (const bf16*)hsrc + (size_t)row * DM;
#pragma unroll
        for (int j = 0; j < 8; ++j) { const v4u x = __builtin_nontemporal_load((const GAS v4u*)(hr + (j * 64 + lane) * 8));
            hv[2 * j] = (f32x4){bflo(x.x), bfhi(x.x), bflo(x.y), bfhi(x.y)}; hv[2 * j + 1] = (f32x4){bflo(x.z), bfhi(x.z), bflo(x.w), bfhi(x.w)}; } }
    else { const float* hr = (const float*)hsrc + (size_t)row * DM;
#pragma unroll
        for (int j = 0; j < 8; ++j) { const int e = (j * 64 + lane) * 8; hv[2 * j] = __builtin_nontemporal_load((const GAS f32x4*)(hr + e)); hv[2 * j + 1] = __builtin_nontemporal_load((const GAS f32x4*)(hr + e + 4)); } }
    if (outb) {
#pragma unroll
        for (int j = 0; j < 8; ++j) ov[j] = __builtin_nontemporal_load((const GAS v4u*)(outb + (size_t)row * DM + (j * 64 + lane) * 8)); }
}
__device__ __forceinline__ void norm_row(f32x4 (&hv)[16], const v4u (&ov)[8], int row, int lane, bool has_out, float w, const float* g_post, void* hdst, bool d16, const float* g_pre, bf16* Adst) {
    if (has_out) {
        float ss = 0.f;
#pragma unroll
        for (int j = 0; j < 8; ++j)
#pragma unroll
            for (int q = 0; q < 4; ++q) { const float a = bflo(ov[j][q]), b = bfhi(ov[j][q]); ss += a * a + b * b; }
        ss = wave_sum(ss);
        const float sc = w / sqrtf(ss * (1.0f / DM) + EPS);
#pragma unroll
        for (int j = 0; j < 8; ++j) { const int e = (j * 64 + lane) * 8;
            const f32x4 g0 = *(const GAS f32x4*)(g_post + e), g1 = *(const GAS f32x4*)(g_post + e + 4);
            f32x4 o0, o1; o0[0] = bflo(ov[j][0]); o0[1] = bfhi(ov[j][0]); o0[2] = bflo(ov[j][1]); o0[3] = bfhi(ov[j][1]);
            o1[0] = bflo(ov[j][2]); o1[1] = bfhi(ov[j][2]); o1[2] = bflo(ov[j][3]); o1[3] = bfhi(ov[j][3]);
            hv[2 * j] += o0 * g0 * sc; hv[2 * j + 1] += o1 * g1 * sc; __builtin_amdgcn_sched_barrier(0); }
    }
    if (hdst) {
        if (d16) { bf16* hw = (bf16*)hdst + (size_t)row * DM;
#pragma unroll
            for (int j = 0; j < 8; ++j) { v4u o; o.x = pk2(hv[2 * j][0], hv[2 * j][1]); o.y = pk2(hv[2 * j][2], hv[2 * j][3]); o.z = pk2(hv[2 * j + 1][0], hv[2 * j + 1][1]); o.w = pk2(hv[2 * j + 1][2], hv[2 * j + 1][3]);
                __builtin_nontemporal_store(o, (GAS v4u*)(hw + (j * 64 + lane) * 8)); } }
        else { float* hw = (float*)hdst + (size_t)row * DM;
#pragma unroll
            for (int j = 0; j < 8; ++j) { const int e = (j * 64 + lane) * 8; __builtin_nontemporal_store(hv[2 * j], (GAS f32x4*)(hw + e)); __builtin_nontemporal_store(hv[2 * j + 1], (GAS f32x4*)(hw + e + 4)); } } }
    if (Adst) {
        float ss = 0.f;
#pragma unroll
        for (int j = 0; j < 16; ++j) ss += (hv[j][0] * hv[j][0] + hv[j][1] * hv[j][1]) + (hv[j][2] * hv[j][2] + hv[j][3] * hv[j][3]);
        ss = wave_sum(ss);
        const float sc = 1.0f / sqrtf(ss * (1.0f / DM) + EPS);
#pragma unroll
        for (int j = 0; j < 8; ++j) { const int e = (j * 64 + lane) * 8;
            const f32x4 g0 = *(const GAS f32x4*)(g_pre + e), g1 = *(const GAS f32x4*)(g_pre + e + 4);
            const f32x4 a0 = hv[2 * j] * g0 * sc, a1 = hv[2 * j + 1] * g1 * sc;
            v4u o; o.x = pk2(a0[0], a0[1]); o.y = pk2(a0[2], a0[3]); o.z = pk2(a1[0], a1[1]); o.w = pk2(a1[2], a1[3]);
            *(GAS v4u*)(Adst + (size_t)row * DM + e) = o; __builtin_amdgcn_sched_barrier(0); }
    }
}
__device__ __forceinline__ void norm_phase(int gw, int NGW, int lane, const bf16* outb, float w, const float* g_post, const void* hsrc, bool h16, void* hdst, bool d16, const float* g_pre, bf16* Adst) {
    for (int row = gw; row < MROWS; row += NGW) {
        f32x4 ha[16]; v4u oa[8];
#pragma unroll
        for (int j = 0; j < 8; ++j) oa[j] = (v4u){0u, 0u, 0u, 0u};
        norm_load(ha, oa, hsrc, h16, outb, row, lane);
        norm_row(ha, oa, row, lane, outb != nullptr, w, g_post, hdst, d16, g_pre, Adst);
    }
}

constexpr int XA_PITCH = 544;
__device__ __forceinline__ void xa_stage(LAS unsigned char* ldsb, const bf16* src, int tid) {
#pragma unroll
    for (int hf = 0; hf < 2; ++hf) { v4u t[8];
#pragma unroll
        for (int e = 0; e < 8; ++e) { const int p = tid + 512 * (8 * hf + e); t[e] = *(const GAS v4u*)(src + (size_t)(p >> 5) * 1024 + (p & 31) * 8); }
#pragma unroll
        for (int e = 0; e < 8; ++e) { const int p = tid + 512 * (8 * hf + e); *(LAS v4u*)(ldsb + (p >> 5) * XA_PITCH + (p & 31) * 16) = t[e]; } }
}
__device__ __forceinline__ void xattn_unit(int unit, LAS unsigned char* ldsb, const bf16* proj, int ldp, int xq_col0, const bf16* Kb, const bf16* VTb, bf16* cat, int tid, int wave, int lane) {
    const int rb = unit & 15, h = (unit >> 4) & 3, b = unit >> 6;
    const int r0 = b * SEQ + rb * 128 + wave * 16, c15 = lane & 15, q4 = lane >> 4;
    xa_stage(ldsb, Kb + (size_t)(b * MEMT) * 1024 + h * XHD, tid);
    bf16x8 qf[8];
    const bf16* qp = proj + (size_t)(r0 + c15) * ldp + xq_col0 + h * XHD + 8 * q4;
#pragma unroll
    for (int s = 0; s < 8; ++s) qf[s] = *(const GAS bf16x8*)(qp + 32 * s);
    __syncthreads();
    f32x4 st[16];
    const LAS unsigned char* fp = ldsb + c15 * XA_PITCH + 16 * q4;
#pragma unroll
    for (int kb = 0; kb < 16; ++kb) { f32x4 acc = {0.f, 0.f, 0.f, 0.f};
#pragma unroll
        for (int s = 0; s < 8; ++s) acc = __builtin_amdgcn_mfma_f32_16x16x32_bf16(*(const LAS bf16x8*)(fp + (16 * kb) * XA_PITCH + 64 * s), qf[s], acc, 0, 0, 0);
        st[kb] = acc; }
    __syncthreads();
    xa_stage(ldsb, VTb + (size_t)(h * XHD) * 1024 + b * MEMT, tid);
    float mx = -3.0e38f;
#pragma unroll
    for (int kb = 0; kb < 16; ++kb)
#pragma unroll
        for (int j = 0; j < 4; ++j) mx = fmaxf(mx, st[kb][j]);
    mx = fmaxf(mx, __shfl_xor(mx, 16)); mx = fmaxf(mx, __shfl_xor(mx, 32));
    const float sc = 0.0625f * 1.44269504089f; float sum = 0.f;
#pragma unroll
    for (int kb = 0; kb < 16; ++kb)
#pragma unroll
        for (int j = 0; j < 4; ++j) { const float p = __builtin_amdgcn_exp2f((st[kb][j] - mx) * sc); st[kb][j] = p; sum += p; }
    sum += __shfl_xor(sum, 16); sum += __shfl_xor(sum, 32);
    const float inv = 1.0f / sum;
    bf16x8 pf[8];
#pragma unroll
    for (int s = 0; s < 8; ++s) { v4u w; w.x = pk2(st[2 * s][0], st[2 * s][1]); w.y = pk2(st[2 * s][2], st[2 * s][3]); w.z = pk2(st[2 * s + 1][0], st[2 * s + 1][1]); w.w = pk2(st[2 * s + 1][2], st[2 * s + 1][3]);
        pf[s] = __builtin_bit_cast(bf16x8, w); }
    __syncthreads();
    bf16* op = cat + (size_t)(r0 + c15) * DM + MIXW + h * XHD + 4 * q4;
#pragma unroll 4
    for (int db = 0; db < 16; ++db) { f32x4 acc = {0.f, 0.f, 0.f, 0.f};
#pragma unroll
        for (int s = 0; s < 8; ++s) acc = __builtin_amdgcn_mfma_f32_16x16x32_bf16(*(const LAS bf16x8*)(fp + (16 * db) * XA_PITCH + 64 * s), pf[s], acc, 0, 0, 0);
        v2u o; o.x = pk2(acc[0] * inv, acc[1] * inv); o.y = pk2(acc[2] * inv, acc[3] * inv);
        *(GAS v2u*)(op + 16 * db) = o; }
    __syncthreads();
}

__device__ __forceinline__ void sc_gate_phase(int gw, int NGW, int lane, const bf16* proj, const float* convw, bf16* cat) {
    for (int task = gw; task < (MROWS / 16) * 6; task += NGW) {
        const int row0 = (task / 6) * 16, c = (task % 6) * 512 + lane * 8;
        float cw[3][8];
#pragma unroll
        for (int j = 0; j < 3; ++j) { const f32x4 a = *(const GAS f32x4*)(convw + j * MIXW + c), b = *(const GAS f32x4*)(convw + j * MIXW + c + 4);
            cw[j][0] = a[0]; cw[j][1] = a[1]; cw[j][2] = a[2]; cw[j][3] = a[3]; cw[j][4] = b[0]; cw[j][5] = b[1]; cw[j][6] = b[2]; cw[j][7] = b[3]; }
        float u2[8], u1[8];
#pragma unroll
        for (int e = 0; e < 8; ++e) { u2[e] = 0.f; u1[e] = 0.f; }
        if ((row0 % SEQ) != 0) {
#pragma unroll
            for (int hrow = 0; hrow < 2; ++hrow) { const bf16* pr = proj + (size_t)(row0 - 2 + hrow) * SC_IN + c;
                const v4u cv = __builtin_nontemporal_load((const GAS v4u*)(pr + MIXW)), hv = __builtin_nontemporal_load((const GAS v4u*)(pr + 2 * MIXW));
#pragma unroll
                for (int q = 0; q < 4; ++q) { const float a = bflo(cv[q]) * bflo(hv[q]), b = bfhi(cv[q]) * bfhi(hv[q]);
                    if (hrow == 0) { u2[2 * q] = a; u2[2 * q + 1] = b; } else { u1[2 * q] = a; u1[2 * q + 1] = b; } } }
        }
#pragma unroll 4
        for (int r = 0; r < 16; ++r) { const bf16* pr = proj + (size_t)(row0 + r) * SC_IN + c;
            const v4u bv = __builtin_nontemporal_load((const GAS v4u*)(pr)), cv = __builtin_nontemporal_load((const GAS v4u*)(pr + MIXW)), hv = __builtin_nontemporal_load((const GAS v4u*)(pr + 2 * MIXW));
            float u0[8], y[8];
#pragma unroll
            for (int q = 0; q < 4; ++q) { u0[2 * q] = bflo(cv[q]) * bflo(hv[q]); u0[2 * q + 1] = bfhi(cv[q]) * bfhi(hv[q]); }
#pragma unroll
            for (int q = 0; q < 4; ++q) {
                y[2 * q] = bflo(bv[q]) * (cw[0][2 * q] * u2[2 * q] + cw[1][2 * q] * u1[2 * q] + cw[2][2 * q] * u0[2 * q]);
                y[2 * q + 1] = bfhi(bv[q]) * (cw[0][2 * q + 1] * u2[2 * q + 1] + cw[1][2 * q + 1] * u1[2 * q + 1] + cw[2][2 * q + 1] * u0[2 * q + 1]); }
            v4u o; o.x = pk2(y[0], y[1]); o.y = pk2(y[2], y[3]); o.z = pk2(y[4], y[5]); o.w = pk2(y[6], y[7]);
            *(GAS v4u*)(cat + (size_t)(row0 + r) * DM + c) = o;
#pragma unroll
            for (int e = 0; e < 8; ++e) { u2[e] = u1[e]; u1[e] = u0[e]; } }
    }
}

__device__ __forceinline__ void gdn_prep_phase(int gw, int NGW, int lane, const bf16* proj, const float* convw, bf16* qkvn, const float* aux, const float* alog, const float* dtb, float* ab) {
    for (int task = gw; task < (MROWS / 16) * 18; task += NGW) {
        const int row0 = (task / 18) * 16, slot = (task % 18) * 4 + (lane >> 4), type = slot / GH, ch = slot * GHD + (lane & 15) * 8;
        float cw[4][8];
#pragma unroll
        for (int j = 0; j < 4; ++j) { const f32x4 a = *(const GAS f32x4*)(convw + j * (3 * MIXW) + ch), b = *(const GAS f32x4*)(convw + j * (3 * MIXW) + ch + 4);
            cw[j][0] = a[0]; cw[j][1] = a[1]; cw[j][2] = a[2]; cw[j][3] = a[3]; cw[j][4] = b[0]; cw[j][5] = b[1]; cw[j][6] = b[2]; cw[j][7] = b[3]; }
        float w0[8], w1[8], w2[8];
#pragma unroll
        for (int e = 0; e < 8; ++e) { w0[e] = 0.f; w1[e] = 0.f; w2[e] = 0.f; }
        if ((row0 % SEQ) != 0) {
#pragma unroll
            for (int hrow = 0; hrow < 3; ++hrow) { const v4u xv = __builtin_nontemporal_load((const GAS v4u*)(proj + (size_t)(row0 - 3 + hrow) * GDN_LD + ch));
#pragma unroll
                for (int q = 0; q < 4; ++q) { const float a = bflo(xv[q]), b = bfhi(xv[q]);
                    if (hrow == 0) { w0[2 * q] = a; w0[2 * q + 1] = b; } else if (hrow == 1) { w1[2 * q] = a; w1[2 * q + 1] = b; } else { w2[2 * q] = a; w2[2 * q + 1] = b; } } }
        }
        const float post = (type == 0) ? 0.08838834764831845f : 1.0f;
#pragma unroll 4
        for (int r = 0; r < 16; ++r) { const v4u xv = __builtin_nontemporal_load((const GAS v4u*)(proj + (size_t)(row0 + r) * GDN_LD + ch));
            float x[8], y[8]; float ss = 0.f;
#pragma unroll
            for (int q = 0; q < 4; ++q) { x[2 * q] = bflo(xv[q]); x[2 * q + 1] = bfhi(xv[q]); }
#pragma unroll
            for (int e = 0; e < 8; ++e) { const float v = cw[0][e] * w0[e] + cw[1][e] * w1[e] + cw[2][e] * w2[e] + cw[3][e] * x[e]; y[e] = silu_f(v); ss += y[e] * y[e]; }
            if (type < 2) { ss = grp16_sum(ss); const float sc = post / sqrtf(ss + EPS);
#pragma unroll
                for (int e = 0; e < 8; ++e) y[e] *= sc; }
            v4u o; o.x = pk2(y[0], y[1]); o.y = pk2(y[2], y[3]); o.z = pk2(y[4], y[5]); o.w = pk2(y[6], y[7]);
            *(GAS v4u*)(qkvn + (size_t)(row0 + r) * (3 * MIXW) + ch) = o;
#pragma unroll
            for (int e = 0; e < 8; ++e) { w0[e] = w1[e]; w1[e] = w2[e]; w2[e] = x[e]; } }
    }
    for (int idx = gw * 64 + lane; idx < MROWS * GH; idx += NGW * 64) { const int row = idx / GH, h = idx % GH;
        const float bi = aux[(size_t)row * 64 + h], ai = aux[(size_t)row * 64 + GH + h] + dtb[h];
        const float sp = ai > 20.f ? ai : log1pf(expf(ai));
        ab[(size_t)row * 48 + h] = 1.0f / (1.0f + expf(-bi));
        ab[(size_t)row * 48 + GH + h] = -expf(alog[h]) * sp; }
}

constexpr int NCHUNK = SEQ / 64;
constexpr int CHB_WC = 0, CHB_QD = 16384, CHB_IN = 32768, CHB_KT = 40960, CHB_BYTES = 57344;
constexpr int P2_PITCH = 272;
constexpr int P2_GC = 0, P2_BETA = 256, P2_EG = 512, P2_Q = 768, P2_K = P2_Q + 64 * P2_PITCH, P2_V = P2_K + 64 * P2_PITCH, P2_A = P2_V + 64 * P2_PITCH, P2_HALF = P2_A + 16384;
__device__ __forceinline__ int kperm_pos(int col) { const int o = col & 31; return (col & ~31) + 8 * ((o & 15) >> 2) + (o & 3) + ((o >> 4) << 2); }
__device__ __forceinline__ unsigned short bf1(float x) { return (unsigned short)(pk2(x, 0.f) & 0xffffu); }
__device__ __forceinline__ float ldbf(const LAS unsigned char* p) { return __uint_as_float((unsigned)(*(const LAS unsigned short*)p) << 16); }

__device__ __forceinline__ void gdn_chunk_phase(int c, int G, int tid, LAS unsigned char* ldsb, const bf16* qkvn, const float* ab, unsigned char* chb, float* utb, float* cdb) {
    const int half = __builtin_amdgcn_readfirstlane(tid >> 8), w4 = __builtin_amdgcn_readfirstlane((tid >> 6) & 3);
    const int role = half ? (w4 - 2) : w4;
    const int ew = half ? w4 : (w4 - 2);
    const int npair = (NBATCH * GH * NCHUNK) / 2;
    for (int pr = c; pr < npair; pr += G) {
        const int ci = pr * 2 + half;
        const int n = ci % NCHUNK, bh = ci / NCHUNK, h = bh % GH, b = bh / GH;
        const size_t row0 = (size_t)b * SEQ + (size_t)n * 64;
        unsigned char* blob = chb + (size_t)ci * CHB_BYTES;
#define P2_FRESH() unsigned lbv = (unsigned)(size_t)(ldsb + half * P2_HALF), afv = lbv + P2_A; asm volatile("" : "+v"(lbv)); asm volatile("" : "+v"(afv)); \
        LAS unsigned char* lb = (LAS unsigned char*)(size_t)lbv; LAS float* Af = (LAS float*)(size_t)afv; LAS float* gcs = (LAS float*)(lb + P2_GC); LAS float* bts = (LAS float*)(lb + P2_BETA); LAS float* egs = (LAS float*)(lb + P2_EG); \
        const int t = opq_v(tid) & 255, lane = t & 63; (void)Af; (void)gcs; (void)bts; (void)egs; (void)lane
        { P2_FRESH();
#pragma unroll
        for (int e = 0; e < 12; ++e) { const int p = t + 256 * e; const int which = p >> 10, r = (p >> 4) & 63, c16 = p & 15;
            const v4u x = *(const GAS v4u*)(qkvn + (row0 + r) * (size_t)(3 * MIXW) + which * MIXW + h * GHD + c16 * 8);
            *(LAS v4u*)(lb + P2_Q + which * (64 * P2_PITCH) + r * P2_PITCH + c16 * 16) = x; }
        if (w4 == 0) { float g = ab[(row0 + lane) * 48 + GH + h]; const float be = ab[(row0 + lane) * 48 + h];
#pragma unroll
            for (int o = 1; o < 64; o <<= 1) { const float y = __shfl_up(g, o); if (lane >= o) g += y; }
            gcs[lane] = g; bts[lane] = be; egs[lane] = __expf(g); }
        }
        __syncthreads();
        { P2_FRESH();
            const int i15 = lane & 15, q4 = lane >> 4;
            bf16x8 kA[4], qA[4];
#pragma unroll
            for (int s = 0; s < 4; ++s) { kA[s] = *(const LAS bf16x8*)(lb + P2_K + (16 * w4 + i15) * P2_PITCH + (32 * s + 8 * q4) * 2);
                                          qA[s] = *(const LAS bf16x8*)(lb + P2_Q + (16 * w4 + i15) * P2_PITCH + (32 * s + 8 * q4) * 2); }
            bf16* In = (bf16*)(blob + CHB_IN);
#pragma unroll
            for (int nb = 0; nb < 4; ++nb) {
                const int jg = 16 * nb + i15;
                if (nb <= w4) {
                    f32x4 akk = {0.f, 0.f, 0.f, 0.f}, aqk = {0.f, 0.f, 0.f, 0.f};
#pragma unroll
                    for (int s = 0; s < 4; ++s) { const bf16x8 kB = *(const LAS bf16x8*)(lb + P2_K + (16 * nb + i15) * P2_PITCH + (32 * s + 8 * q4) * 2);
                        akk = __builtin_amdgcn_mfma_f32_16x16x32_bf16(kA[s], kB, akk, 0, 0, 0); aqk = __builtin_amdgcn_mfma_f32_16x16x32_bf16(qA[s], kB, aqk, 0, 0, 0); }
                    const float gj = gcs[jg];
#pragma unroll
                    for (int r = 0; r < 4; ++r) { const int ig = 16 * w4 + 4 * q4 + r;
                        const float dec = (ig >= jg) ? __expf(gcs[ig] - gj) : 0.f;
                        Af[ig * 64 + jg] = (ig > jg) ? bts[ig] * akk[r] * dec : 0.f;
                        *(GAS unsigned short*)(In + ig * 64 + kperm_pos(jg)) = bf1(aqk[r] * dec); }
                } else {
#pragma unroll
                    for (int r = 0; r < 4; ++r) { const int ig = 16 * w4 + 4 * q4 + r; *(GAS unsigned short*)(In + ig * 64 + kperm_pos(jg)) = 0; }
                }
            }
        }
        __syncthreads();
        if (role == 0 || role == 1) { P2_FRESH();
            f32x2 x[64];
            const LAS unsigned char* tp = lb + (role ? P2_K : P2_V) + lane * 2;
#pragma unroll
            for (int g8 = 0; g8 < 8; ++g8) {
#pragma unroll
                for (int ii = 0; ii < 8; ++ii) { const int i = 8 * g8 + ii; const float e = egs[i], sc = bts[i] * (role ? e : 1.0f);
                    x[i] = (f32x2){ldbf(tp + i * P2_PITCH) * sc, ldbf(tp + i * P2_PITCH + 128) * sc}; asm volatile("" : "+v"(x[i])); }
                __builtin_amdgcn_sched_barrier(0);
            }
            f32x4 cur[4], nxt[4];
            cur[0] = *(const LAS f32x4*)(Af + 64);
#define P2_ROWS(NSEG, ILO, IHI) \
            _Pragma("unroll") for (int i = (ILO); i <= (IHI); ++i) { \
                f32x2 a0 = x[i], a1 = {0.f, 0.f}; \
                _Pragma("unroll") for (int sg = 0; sg < (NSEG); ++sg) { \
                    const bool more = (sg + 1 < (NSEG)); const int ni = more ? i : i + 1, nsg = more ? sg + 1 : 0; \
                    if (ni < 64) { _Pragma("unroll") for (int q = 0; q < 4; ++q) if (16 * nsg + 4 * q < ni) nxt[q] = *(const LAS f32x4*)(Af + ni * 64 + 16 * nsg + 4 * q); } \
                    __builtin_amdgcn_sched_barrier(0); \
                    _Pragma("unroll") for (int jj = 0; jj < (more ? 16 : i - 16 * sg); ++jj) { const int j = 16 * sg + jj; const float aij = cur[jj >> 2][jj & 3]; if (j & 1) a1 -= x[j] * aij; else a0 -= x[j] * aij; } \
                    __builtin_amdgcn_sched_barrier(0); \
                    _Pragma("unroll") for (int q = 0; q < 4; ++q) cur[q] = nxt[q]; \
                } \
                x[i] = a0 + a1; \
            }
            P2_ROWS(1, 1, 16)
            P2_ROWS(2, 17, 32)
            P2_ROWS(3, 33, 48)
            P2_ROWS(4, 49, 63)
#undef P2_ROWS
            if (role == 0) { float* up = utb + (size_t)ci * 8192 + lane * 64;
#pragma unroll
                for (int i = 0; i < 16; ++i) { *(GAS f32x4*)(up + 4 * i) = (f32x4){x[4 * i][0], x[4 * i + 1][0], x[4 * i + 2][0], x[4 * i + 3][0]};
                                               *(GAS f32x4*)(up + 4096 + 4 * i) = (f32x4){x[4 * i][1], x[4 * i + 1][1], x[4 * i + 2][1], x[4 * i + 3][1]}; } }
            else { bf16* wp = (bf16*)(blob + CHB_WC) + kperm_pos(lane);
#pragma unroll
                for (int i = 0; i < 64; ++i) { *(GAS unsigned short*)(wp + i * 128) = bf1(x[i][0]); *(GAS unsigned short*)(wp + i * 128 + 64) = bf1(x[i][1]); } }
        } else { P2_FRESH();
            const int t2 = ew * 64 + lane;
#pragma unroll
            for (int ps = 0; ps < 2; ++ps) { const int tt = t2 + 128 * ps; const int i = tt >> 2, cseg = (tt & 3) * 32; const float e = egs[i];
                v4u sv[4];
#pragma unroll
                for (int q = 0; q < 4; ++q) { const v4u xv = *(const LAS v4u*)(lb + P2_Q + i * P2_PITCH + (cseg + 8 * q) * 2);
                    sv[q].x = pk2(bflo(xv.x) * e, bfhi(xv.x) * e); sv[q].y = pk2(bflo(xv.y) * e, bfhi(xv.y) * e); sv[q].z = pk2(bflo(xv.z) * e, bfhi(xv.z) * e); sv[q].w = pk2(bflo(xv.w) * e, bfhi(xv.w) * e); }
#pragma unroll
                for (int q = 0; q < 4; ++q) { const v4u lo = sv[q >> 1], hi = sv[2 + (q >> 1)];
                    v4u o; o.x = (q & 1) ? lo.z : lo.x; o.y = (q & 1) ? lo.w : lo.y; o.z = (q & 1) ? hi.z : hi.x; o.w = (q & 1) ? hi.w : hi.y;
                    *(GAS v4u*)(blob + CHB_QD + (i * 128 + cseg + 8 * q) * 2) = o; } }
            const float gl = gcs[63];
#pragma unroll
            for (int ps = 0; ps < 2; ++ps) { const int d = t2, hh = ps; float y[32];
#pragma unroll
                for (int jj = 0; jj < 32; ++jj) { const int i = 32 * hh + jj; y[jj] = ldbf(lb + P2_K + i * P2_PITCH + d * 2) * __expf(gl - gcs[i]); }
#pragma unroll
                for (int q = 0; q < 4; ++q) { v4u o; o.x = pk2(y[4 * q], y[4 * q + 1]); o.y = pk2(y[4 * q + 2], y[4 * q + 3]); o.z = pk2(y[16 + 4 * q], y[16 + 4 * q + 1]); o.w = pk2(y[16 + 4 * q + 2], y[16 + 4 * q + 3]);
                    *(GAS v4u*)(blob + CHB_KT + (d * 64 + 32 * hh + 8 * q) * 2) = o; } }
            if (t2 == 0) cdb[ci] = __expf(gl);
        }
        __syncthreads();
    }
#undef P2_FRESH
}

constexpr int S2_WC = 0, S2_QD = 18432, S2_IN = 36864, S2_KT = 47104, S2_BUF = 67584;
__device__ __forceinline__ bf16x8 s2_frag(const LAS unsigned char* p) { return *(const LAS bf16x8*)p; }
__device__ __forceinline__ bf16x8 s2_pack(const f32x4& a, const f32x4& b) { v4u w; w.x = pk2(a[0], a[1]); w.y = pk2(a[2], a[3]); w.z = pk2(b[0], b[1]); w.w = pk2(b[2], b[3]); return __builtin_bit_cast(bf16x8, w); }
__device__ __forceinline__ void gdn_scan2_unit(int bh, LAS unsigned char* ldsb, const unsigned char* chb, const float* utb, const float* cdb, float* O, int tid, int wave, int lane) {
    const int b = bh / GH, h = bh % GH, i15 = lane & 15, q4 = lane >> 4, n0 = wave * 16;
    const size_t ci0 = (size_t)bh * NCHUNK;
    f32x4 S[8];
#pragma unroll
    for (int kb = 0; kb < 8; ++kb) S[kb] = (f32x4){0.f, 0.f, 0.f, 0.f};
    v4u r[7]; f32x4 utn[4], ocp[4];
#define S2_STORE_O(cc_) do { float* op_ = O + ((size_t)b * SEQ + (size_t)(cc_) * 64 + 4 * q4) * MIXW + h * GHD + n0 + i15; \
        _Pragma("unroll") for (int mb = 0; mb < 4; ++mb) _Pragma("unroll") for (int j = 0; j < 4; ++j) op_[(size_t)(16 * mb + j) * MIXW] = ocp[mb][j]; } while (0)
#define S2_ISSUE(cc_) do { const unsigned char* bp_ = chb + (ci0 + (cc_)) * CHB_BYTES + tid * 16; \
        _Pragma("unroll") for (int e = 0; e < 7; ++e) r[e] = __builtin_nontemporal_load((const GAS v4u*)(bp_ + e * 8192)); \
        const float* up_ = utb + (ci0 + (cc_)) * 8192 + (n0 + i15) * 64 + 4 * q4; \
        _Pragma("unroll") for (int mb = 0; mb < 4; ++mb) utn[mb] = __builtin_nontemporal_load((const GAS f32x4*)(up_ + 16 * mb)); } while (0)
    S2_ISSUE(0);
#if defined(TPROBE) && TPROBE >= 11 && TPROBE <= 13
    volatile LAS unsigned* MISCp = (volatile LAS unsigned*)(ldsb - RING_OFF + MISC_OFF); const bool prb = (bh == 0 && tid == 0);
#define S2_T0() unsigned long long pt0_ = prb ? __builtin_amdgcn_s_memrealtime() : 0ull
#define S2_T1(k) do { if ((k) == TPROBE && prb) { const unsigned long long d_ = __builtin_amdgcn_s_memrealtime() - pt0_; const unsigned long long a_ = ((((unsigned long long)MISCp[19] << 32) | MISCp[18])) + d_; MISCp[18] = (unsigned)a_; MISCp[19] = (unsigned)(a_ >> 32); } } while (0)
#else
#define S2_T0() do {} while (0)
#define S2_T1(k) do {} while (0)
#endif
    for (int cc = 0; cc < NCHUNK; ++cc) {
        LAS unsigned char* buf = ldsb + (cc & 1) * S2_BUF;
        { S2_T0(); asm volatile("s_waitcnt vmcnt(0)" ::: "memory"); S2_T1(11); }
        *(LAS v4u*)(buf + S2_WC + (tid >> 4) * 288 + (tid & 15) * 16) = r[0];
        *(LAS v4u*)(buf + S2_WC + ((tid + 512) >> 4) * 288 + (tid & 15) * 16) = r[1];
        *(LAS v4u*)(buf + S2_QD + (tid >> 4) * 288 + (tid & 15) * 16) = r[2];
        *(LAS v4u*)(buf + S2_QD + ((tid + 512) >> 4) * 288 + (tid & 15) * 16) = r[3];
        *(LAS v4u*)(buf + S2_IN + (tid >> 3) * 160 + (tid & 7) * 16) = r[4];
        *(LAS v4u*)(buf + S2_KT + (tid >> 3) * 160 + (tid & 7) * 16) = r[5];
        *(LAS v4u*)(buf + S2_KT + ((tid + 512) >> 3) * 160 + (tid & 7) * 16) = r[6];
        f32x4 ut[4];
#pragma unroll
        for (int mb = 0; mb < 4; ++mb) ut[mb] = utn[mb];
        const float cd = cdb[ci0 + cc];
        { S2_T0(); __syncthreads(); S2_T1(12); }
        S2_T0();
        if (cc > 0) S2_STORE_O(cc - 1);
        if (cc + 1 < NCHUNK) S2_ISSUE(cc + 1);
        bf16x8 sb[4];
#pragma unroll
        for (int s = 0; s < 4; ++s) sb[s] = s2_pack(S[2 * s], S[2 * s + 1]);
#define S2_LD4x2(dst, base, pitch, s0) do { _Pragma("unroll") for (int e_ = 0; e_ < 8; ++e_) dst[e_] = s2_frag(buf + (base) + (16 * (e_ & 3) + i15) * (pitch) + (32 * ((s0) + (e_ >> 2)) + 8 * q4) * 2); } while (0)
#define S2_LD8x1(dst, base, pitch, s0) do { _Pragma("unroll") for (int e_ = 0; e_ < 8; ++e_) dst[e_] = s2_frag(buf + (base) + (16 * e_ + i15) * (pitch) + (32 * (s0) + 8 * q4) * 2); } while (0)
#define S2_SB() __builtin_amdgcn_sched_barrier(0)
        bf16x8 fa[8], fb[8];
        f32x4 vn[4], oc[4];
#pragma unroll
        for (int mb = 0; mb < 4; ++mb) { vn[mb] = (f32x4){0.f, 0.f, 0.f, 0.f}; oc[mb] = (f32x4){0.f, 0.f, 0.f, 0.f}; }
        S2_LD4x2(fa, S2_WC, 288, 0); S2_LD4x2(fb, S2_WC, 288, 2); S2_SB();
#pragma unroll
        for (int e = 0; e < 8; ++e) vn[e & 3] = __builtin_amdgcn_mfma_f32_16x16x32_bf16(fa[e], sb[e >> 2], vn[e & 3], 0, 0, 0);
        S2_SB(); S2_LD4x2(fa, S2_QD, 288, 0); S2_SB();
#pragma unroll
        for (int e = 0; e < 8; ++e) vn[e & 3] = __builtin_amdgcn_mfma_f32_16x16x32_bf16(fb[e], sb[2 + (e >> 2)], vn[e & 3], 0, 0, 0);
        S2_SB(); S2_LD4x2(fb, S2_QD, 288, 2); S2_SB();
#pragma unroll
        for (int e = 0; e < 8; ++e) oc[e & 3] = __builtin_amdgcn_mfma_f32_16x16x32_bf16(fa[e], sb[e >> 2], oc[e & 3], 0, 0, 0);
        S2_SB(); S2_LD4x2(fa, S2_IN, 160, 0); S2_SB();
#pragma unroll
        for (int mb = 0; mb < 4; ++mb) vn[mb] = ut[mb] - vn[mb];
        bf16x8 vb[2];
        vb[0] = s2_pack(vn[0], vn[1]); vb[1] = s2_pack(vn[2], vn[3]);
#pragma unroll
        for (int e = 0; e < 8; ++e) oc[e & 3] = __builtin_amdgcn_mfma_f32_16x16x32_bf16(fb[e], sb[2 + (e >> 2)], oc[e & 3], 0, 0, 0);
        S2_SB(); S2_LD8x1(fb, S2_KT, 160, 0); S2_SB();
#pragma unroll
        for (int e = 0; e < 8; ++e) oc[e & 3] = __builtin_amdgcn_mfma_f32_16x16x32_bf16(fa[e], vb[e >> 2], oc[e & 3], 0, 0, 0);
        S2_SB(); S2_LD8x1(fa, S2_KT, 160, 1); S2_SB();
#pragma unroll
        for (int kb = 0; kb < 8; ++kb) S[kb] = __builtin_amdgcn_mfma_f32_16x16x32_bf16(fb[kb], vb[0], S[kb] * cd, 0, 0, 0);
        S2_SB();
#pragma unroll
        for (int mb = 0; mb < 4; ++mb) ocp[mb] = oc[mb];
        asm volatile("" :: "v"(S[0]), "v"(S[7]), "v"(ocp[3])); S2_T1(13);
#pragma unroll
        for (int kb = 0; kb < 8; ++kb) S[kb] = __builtin_amdgcn_mfma_f32_16x16x32_bf16(fa[kb], vb[1], S[kb], 0, 0, 0);
#undef S2_LD4x2
#undef S2_LD8x1
#undef S2_SB
    }
    S2_STORE_O(NCHUNK - 1);
    __syncthreads();
#undef S2_STORE_O
#undef S2_ISSUE
}

__device__ __forceinline__ void gdn_out_phase(int gw, int NGW, int lane, const float* O, const bf16* proj, const float* normg, bf16* cat) {
    const int dl = (lane & 15) * 8;
    const f32x4 g0 = *(const GAS f32x4*)(normg + dl), g1 = *(const GAS f32x4*)(normg + dl + 4);
    for (int row = gw; row < MROWS; row += NGW) {
#pragma unroll 2
        for (int it = 0; it < 6; ++it) { const int ch = (it * 4 + (lane >> 4)) * GHD + dl;
            const f32x4 o0 = __builtin_nontemporal_load((const GAS f32x4*)(O + (size_t)row * MIXW + ch)), o1 = __builtin_nontemporal_load((const GAS f32x4*)(O + (size_t)row * MIXW + ch + 4));
            const v4u zv = __builtin_nontemporal_load((const GAS v4u*)(proj + (size_t)row * GDN_LD + 3 * MIXW + ch));
            float ss = (o0[0] * o0[0] + o0[1] * o0[1]) + (o0[2] * o0[2] + o0[3] * o0[3]) + (o1[0] * o1[0] + o1[1] * o1[1]) + (o1[2] * o1[2] + o1[3] * o1[3]);
            ss = grp16_sum(ss);
            const float r = 1.0f / sqrtf(ss * (1.0f / GHD) + EPS);
            float y[8];
            y[0] = o0[0] * r * g0[0] * silu_f(bflo(zv[0])); y[1] = o0[1] * r * g0[1] * silu_f(bfhi(zv[0])); y[2] = o0[2] * r * g0[2] * silu_f(bflo(zv[1])); y[3] = o0[3] * r * g0[3] * silu_f(bfhi(zv[1]));
            y[4] = o1[0] * r * g1[0] * silu_f(bflo(zv[2])); y[5] = o1[1] * r * g1[1] * silu_f(bfhi(zv[2])); y[6] = o1[2] * r * g1[2] * silu_f(bflo(zv[3])); y[7] = o1[3] * r * g1[3] * silu_f(bfhi(zv[3]));
            v4u w; w.x = pk2(y[0], y[1]); w.y = pk2(y[2], y[3]); w.z = pk2(y[4], y[5]); w.w = pk2(y[6], y[7]);
            *(GAS v4u*)(cat + (size_t)row * DM + ch) = w; }
    }
}

typedef unsigned char* const __attribute__((address_space(4)))* karg_tab_t;
__device__ __forceinline__ unsigned char* karg_ptr(int i) { asm volatile("" : "+s"(i)); return ((karg_tab_t)__builtin_amdgcn_kernarg_segment_ptr())[i]; }
#define INP(i) ((const float*)karg_ptr(i))
#define WSP(off) (karg_ptr(20) + (off))

__global__ void __launch_bounds__(NWAVES * 64, 2) fwd_kernel(Args args) {
    extern __shared__ __attribute__((aligned(16))) unsigned char lds[];
    LAS unsigned char* L = (LAS unsigned char*)lds;
    volatile LAS unsigned* MISC = (volatile LAS unsigned*)(L + MISC_OFF);
    const int tid0 = threadIdx.x;
    const int G = gridDim.x, c = blockIdx.x;
#define tid (opq_v(tid0))
#define lane (opq_v(tid0) & 63)
#define wave (__builtin_amdgcn_readfirstlane(opq_v(tid0) >> 6))
#define gw (opq_s(c) * NWAVES + __builtin_amdgcn_readfirstlane(opq_v(tid0) >> 6))
#define NGW (opq_s(G) * NWAVES)
    for (int u = tid0; u < (LDS_BYTES - LDSCTL_OFF) / 4; u += NWAVES * 64) ((LAS unsigned*)(L + LDSCTL_OFF))[u] = 0u;
    __syncthreads();
    (void)xcd_barrier_post((unsigned*)(WSP(WS_CTL)) + CW_BAR, MISC + 8);
#define GRID_BAR() do { XcdBarrier bar_; bar_.bar = (unsigned*)(WSP(WS_CTL)) + CW_BAR; bar_.x = xb_xcc_id(); bar_.st = MISC + 8; xcd_barrier(bar_); } while (0)
#if defined(TPROBE) && TPROBE == 8
#define TP_BEGIN(k) do { if ((k) == 3 && c == 0 && tid0 == 0) { const unsigned long long t_ = __builtin_amdgcn_s_memrealtime(), y_ = __builtin_amdgcn_s_memtime(); MISC[16] = (unsigned)t_; MISC[17] = (unsigned)(t_ >> 32); MISC[20] = (unsigned)y_; MISC[21] = (unsigned)(y_ >> 32); } } while (0)
#define TP_END(k) do { if ((k) == 3 && c == 0 && tid0 == 0) { const unsigned long long t_ = __builtin_amdgcn_s_memrealtime() - (((unsigned long long)MISC[17] << 32) | MISC[16]), y_ = __builtin_amdgcn_s_memtime() - (((unsigned long long)MISC[21] << 32) | MISC[20]); \
        const unsigned long long a_ = ((((unsigned long long)MISC[19] << 32) | MISC[18])) + t_, b_ = ((((unsigned long long)MISC[23] << 32) | MISC[22])) + y_; MISC[18] = (unsigned)a_; MISC[19] = (unsigned)(a_ >> 32); MISC[22] = (unsigned)b_; MISC[23] = (unsigned)(b_ >> 32); } } while (0)
#elif defined(TPROBE)
#define TP_BEGIN(k) do { if ((k) == TPROBE && c == 0 && tid0 == 0) { const unsigned long long t_ = __builtin_amdgcn_s_memrealtime(); MISC[16] = (unsigned)t_; MISC[17] = (unsigned)(t_ >> 32); } } while (0)
#define TP_END(k) do { if ((k) == TPROBE && c == 0 && tid0 == 0) { const unsigned long long t_ = __builtin_amdgcn_s_memrealtime() - (((unsigned long long)MISC[17] << 32) | MISC[16]); \
        const unsigned long long a_ = ((((unsigned long long)MISC[19] << 32) | MISC[18])) + t_; MISC[18] = (unsigned)a_; MISC[19] = (unsigned)(a_ >> 32); } } while (0)
#else
#define TP_BEGIN(k) do {} while (0)
#define TP_END(k) do {} while (0)
#endif
#ifdef NO_P0
#define PH_P0(x)
#else
#define PH_P0(x) x
#endif
#ifdef NO_KV
#define PH_KV(x)
#else
#define PH_KV(x) x
#endif
#ifdef NO_GU
#define PH_GU(x)
#else
#define PH_GU(x) x
#endif
#ifdef NO_DN
#define PH_DN(x)
#else
#define PH_DN(x) x
#endif
#ifdef NO_NORM
#define PH_NORM(x)
#else
#define PH_NORM(x) x
#endif
#ifdef NO_SCIN
#define PH_SCIN(x)
#else
#define PH_SCIN(x) x
#endif
#ifdef NO_SCG
#define PH_SCG(x)
#else
#define PH_SCG(x) x
#endif
#ifdef NO_XA
#define PH_XA(x)
#else
#define PH_XA(x) x
#endif
#ifdef NO_GDNIN
#define PH_GDNIN(x)
#else
#define PH_GDNIN(x) x
#endif
#ifdef NO_PREP
#define PH_PREP(x)
#else
#define PH_PREP(x) x
#endif
#ifdef NO_GOUT
#define PH_GOUT(x)
#else
#define PH_GOUT(x) x
#endif
#ifdef NO_WOUT
#define PH_WOUT(x)
#else
#define PH_WOUT(x) x
#endif
#ifdef NO_SCAN
#define DO_SCAN(x)
#else
#define DO_SCAN(x) x
#endif

#define Hbuf ((bf16*)WSP(WS_H))
#define Abuf ((bf16*)WSP(WS_A))
#define OUTb ((bf16*)WSP(WS_OUT))
#define CAT ((bf16*)WSP(WS_CAT))
#define ACT ((bf16*)WSP(WS_ACT))
#define PROJ ((bf16*)WSP(WS_PROJ))
#define AUX ((float*)WSP(WS_AUX))
#define AB ((float*)WSP(WS_AB))
#define QKVN ((bf16*)WSP(WS_QKV))
#define OBUF ((float*)WSP(WS_O))
#define KVOPS ((bf16*)WSP(WS_KVOPS))
#define KB ((bf16*)WSP(WS_KB))
#define VTB ((bf16*)WSP(WS_VTB))
#define WGU ((bf16*)WSP(WS_WGU))
#define WDN ((bf16*)WSP(WS_WDN))
#define WOUT ((bf16*)WSP(WS_WOUT))
#define WSC ((bf16*)WSP(WS_WSC))
#define WGDN ((bf16*)WSP(WS_WGDN))
#define CHB ((unsigned char*)WSP(WS_CHB))
#define UTB ((float*)WSP(WS_UT))
#define CDB ((float*)WSP(WS_CD))

    TP_BEGIN(1);
#ifndef NO_P0
    {
        LAS float* scr = (LAS float*)(L + RING_OFF + wave * XP_SCR);
        long base = 0;
        for (int job = 0; job < 40; ++job) {
            const float* W; bf16* WT; int K, N, col0 = 0, ncols, nvalid, mode = 0, roff = 0;
            if (job < 8)       { W = INP(I_WG) + (size_t)job * DM * DFF; K = DM; N = DFF; ncols = DFF; WT = WGU + (size_t)job * 2 * DFF * DM; mode = 1; roff = 0; }
            else if (job < 16) { W = INP(I_WU) + (size_t)(job - 8) * DM * DFF; K = DM; N = DFF; ncols = DFF; WT = WGU + (size_t)(job - 8) * 2 * DFF * DM; mode = 1; roff = 128; }
            else if (job < 24) { W = INP(I_WD) + (size_t)(job - 16) * DFF * DM; K = DFF; N = DM; ncols = DM; WT = WDN + (size_t)(job - 16) * DM * DFF; }
            else if (job < 28) { W = INP(I_WOUT) + (size_t)(job - 24) * DM * DM; K = DM; N = DM; ncols = DM; WT = WOUT + (size_t)(job - 24) * DM * DM; }
            else if (job < 32) { W = INP(I_WKV) + (size_t)(job - 28) * DM * 2 * XW; K = DM; N = 2 * XW; ncols = 2 * XW; WT = KVOPS + ((size_t)(job - 28) * 3072 + 1024) * DM; }
            else if (job < 34) { W = INP(I_SCIN) + (size_t)(job - 32) * DM * SC_IN; K = DM; N = SC_IN; ncols = SC_IN; WT = WSC + (size_t)(job - 32) * SC_IN * DM; }
            else if (job < 36) { W = INP(I_GDNIN) + (size_t)(job - 34) * DM * GDN_SRC; K = DM; N = GDN_SRC; ncols = 4 * MIXW; WT = WGDN + (size_t)(job - 34) * GDN_N * DM; }
            else if (job < 38) { W = INP(I_GDNIN) + (size_t)(job - 36) * DM * GDN_SRC; K = DM; N = GDN_SRC; col0 = 4 * MIXW + 2 * GH; ncols = XW; WT = WGDN + (size_t)(job - 36) * GDN_N * DM; roff = 4 * MIXW; }
            else               { W = INP(I_GDNIN) + (size_t)(job - 38) * DM * GDN_SRC; K = DM; N = GDN_SRC; col0 = 4 * MIXW; ncols = 64; WT = WGDN + (size_t)(job - 38) * GDN_N * DM; roff = GDN_LD; }
            nvalid = (job >= 38) ? 2 * GH : ncols;
            const int nblk = ncols / 64, items = (K / 64) * nblk;
            int first = (int)(((long)gw - base) % NGW); if (first < 0) first += NGW;
            const int step = NGW;
#define XP_DROW(nb_) (mode ? (256 * ((nb_) >> 1) + 64 * ((nb_) & 1) + roff) : (64 * (nb_) + roff))
            if (first < items) {
                f32x4 va[16], vb[16];
                int it = first;
                xpose_load(va, W, N, col0, nvalid, 64 * (it / nblk), 64 * (it % nblk), lane);
                for (;;) {
                    const int it1 = it + step;
                    if (it1 < items) xpose_load(vb, W, N, col0, nvalid, 64 * (it1 / nblk), 64 * (it1 % nblk), lane);
                    xpose_store(va, WT, K, XP_DROW(it % nblk), scr, 64 * (it / nblk), lane);
                    if (it1 >= items) break;
                    const int it2 = it1 + step;
                    if (it2 < items) xpose_load(va, W, N, col0, nvalid, 64 * (it2 / nblk), 64 * (it2 % nblk), lane);
                    xpose_store(vb, WT, K, XP_DROW(it1 % nblk), scr, 64 * (it1 / nblk), lane);
                    if (it2 >= items) break;
                    it = it2;
                }
            }
#undef XP_DROW
            base += items;
        }
        for (int r = gw; r < 2 * 192; r += NGW) { bf16* p = WGDN + ((size_t)(r / 192) * GDN_N + GDN_LD + 64 + (r % 192)) * DM;
#pragma unroll
            for (int j = 0; j < 8; ++j) *(GAS v4u*)(p + (j * 64 + lane) * 8) = (v4u){0u, 0u, 0u, 0u}; }
        for (int r = gw; r < NBATCH * MEMT; r += NGW) { const float* mr = INP(I_MEM) + (size_t)r * DM;
            f32x4 v[16]; float ss = 0.f;
#pragma unroll
            for (int j = 0; j < 16; ++j) { v[j] = *(const GAS f32x4*)(mr + (j * 64 + lane) * 4); ss += (v[j][0] * v[j][0] + v[j][1] * v[j][1]) + (v[j][2] * v[j][2] + v[j][3] * v[j][3]); }
            ss = wave_sum(ss); const float sc = 1.0f / sqrtf(ss * (1.0f / DM) + EPS);
            for (int l = 0; l < DEPTH; ++l) { const float* g = INP(I_MEMG) + (size_t)l * DM; bf16* dst = KVOPS + ((size_t)l * 3072 + r) * DM;
#pragma unroll
                for (int j = 0; j < 16; ++j) { const f32x4 gg = *(const GAS f32x4*)(g + (j * 64 + lane) * 4); const f32x4 a = v[j] * gg * sc;
                    v2u o; o.x = pk2(a[0], a[1]); o.y = pk2(a[2], a[3]); *(GAS v2u*)(dst + (j * 64 + lane) * 4) = o; } } }
        norm_phase(gw, NGW, lane, nullptr, 0.f, nullptr, INP(I_X), false, Hbuf, true, INP(I_FPRE), Abuf);
    }
#endif
    GRID_BAR();
    TP_END(1);

#define FFN_GEMMS(f_) do { \
        TP_BEGIN(3); \
        { pg8::Gemm g{Abuf, WGU + (size_t)(l * 2 + (f_)) * 2 * DFF * DM, MROWS, 2 * DFF, DM}; pg8::StaticOrder S; S.init(MROWS, 2 * DFF, opq_s(G), opq_s(c)); pg8::EpiSwiGLU E{ACT, DFF}; \
          PH_GU((pg8::gemm_phase<pg8::EpiSwiGLU, pg8::StaticOrder, PG8_ALIGN, PG8_SP2>(L + RING_OFF, g, S, E))); } \
        GRID_BAR(); \
        { pg8::Gemm g{ACT, WDN + (size_t)(l * 2 + (f_)) * DM * DFF, MROWS, DM, DFF}; pg8::StaticOrder S; S.init(MROWS, DM, opq_s(G), opq_s(c)); pg8::EpiProj E{OUTb, DM, nullptr, -1}; \
          PH_DN((pg8::gemm_phase<pg8::EpiProj, pg8::StaticOrder, PG8_ALIGN, PG8_SP2>(L + RING_OFF, g, S, E))); } \
        GRID_BAR(); \
        TP_END(3); \
    } while (0)

    for (int l = 0; l < DEPTH; ++l) {
        const int j2 = l >> 1; const bool gdn = (l & 1) != 0;
        FFN_GEMMS(0);
        TP_BEGIN(6);
        { const int Gq = opq_s(G), cq = opq_s(c); const int nkv = (l == 0 && Gq > 64) ? 32 : 0;
          if (cq < nkv) { pg8::Gemm g{KVOPS, KVOPS, 4 * 3072, 4 * 3072, DM}; pg8::KvOrder S{nkv, cq, 0, 32}; pg8::EpiKV E{KB, VTB};
              PH_KV((pg8::gemm_phase<pg8::EpiKV, pg8::KvOrder, PG8_ALIGN, PG8_SP2>(L + RING_OFF, g, S, E))); }
          else { PH_NORM(norm_phase((cq - nkv) * NWAVES + wave, (Gq - nkv) * NWAVES, lane, OUTb, 0.5f, INP(I_FPOST) + (size_t)(l * 2) * DM, Hbuf, true, Hbuf, true, INP(I_MPRE) + (size_t)l * DM, Abuf);) }
          if (l == 0 && nkv == 0) { pg8::Gemm g{KVOPS, KVOPS, 4 * 3072, 4 * 3072, DM}; pg8::KvOrder S{Gq, cq, 0, 32}; pg8::EpiKV E{KB, VTB};
              PH_KV((pg8::gemm_phase<pg8::EpiKV, pg8::KvOrder, PG8_ALIGN, PG8_SP2>(L + RING_OFF, g, S, E))); } }
        GRID_BAR();
        TP_END(6);
        if (!gdn) {
            TP_BEGIN(3);
            { pg8::Gemm g{Abuf, WSC + (size_t)j2 * SC_IN * DM, MROWS, SC_IN, DM}; pg8::StaticOrder S; S.init(MROWS, SC_IN, opq_s(G), opq_s(c)); pg8::EpiProj E{PROJ, SC_IN, nullptr, -1};
              PH_SCIN((pg8::gemm_phase<pg8::EpiProj, pg8::StaticOrder, PG8_ALIGN, PG8_SP2>(L + RING_OFF, g, S, E))); }
            GRID_BAR();
            TP_END(3);
            TP_BEGIN(4);
            PH_SCG(sc_gate_phase(gw, NGW, lane, PROJ, INP(I_SCCONV) + (size_t)j2 * 3 * MIXW, CAT);)
            for (int u = opq_s(c); u < 256; u += opq_s(G)) { PH_XA(xattn_unit(u, L + RING_OFF, PROJ, SC_IN, 3 * MIXW, KB + (size_t)l * 1048576, VTB + (size_t)l * 1048576, CAT, tid, wave, lane);) }
            GRID_BAR();
            TP_END(4);
        } else {
            TP_BEGIN(3);
            { pg8::Gemm g{Abuf, WGDN + (size_t)j2 * GDN_N * DM, MROWS, GDN_N, DM}; pg8::StaticOrder S; S.init(MROWS, GDN_N, opq_s(G), opq_s(c)); pg8::EpiProj E{PROJ, GDN_LD, AUX, GDN_LD / 256};
              PH_GDNIN((pg8::gemm_phase<pg8::EpiProj, pg8::StaticOrder, PG8_ALIGN, PG8_SP2>(L + RING_OFF, g, S, E))); }
            if (l == 1) { const int Gq = opq_s(G), cq = opq_s(c); const int first = (Gq == 256) ? 160 : 0;
              pg8::Gemm g{KVOPS, KVOPS, 4 * 3072, 4 * 3072, DM}; pg8::KvOrder S{Gq - first, cq - first, 1, 96}; pg8::EpiKV E{KB, VTB};
              PH_KV((pg8::gemm_phase<pg8::EpiKV, pg8::KvOrder, PG8_ALIGN, PG8_SP2>(L + RING_OFF, g, S, E))); }
            GRID_BAR();
            TP_END(3);
            TP_BEGIN(5);
            PH_PREP(gdn_prep_phase(gw, NGW, lane, PROJ, INP(I_GDNCONV) + (size_t)j2 * 4 * 3 * MIXW, QKVN, AUX, INP(I_ALOG) + j2 * GH, INP(I_DTB) + j2 * GH, AB);)
            GRID_BAR();
            TP_END(5);
            TP_BEGIN(2);
            DO_SCAN(gdn_chunk_phase(opq_s(c), opq_s(G), tid, L + RING_OFF, QKVN, AB, CHB, UTB, CDB));
            GRID_BAR();
            TP_END(2);
            TP_BEGIN(7);
            {
                const int nscan = NBATCH * GH;
                const int cq = opq_s(c);
                if (opq_s(G) == 256) {
                    if (cq < nscan) { TP_BEGIN(9); DO_SCAN(gdn_scan2_unit(cq, L + RING_OFF, CHB, UTB, CDB, OBUF, tid, wave, lane)); TP_END(9); }
                    else for (int u = cq - nscan; u < 256; u += 256 - nscan) { PH_XA(xattn_unit(u, L + RING_OFF, PROJ, GDN_LD, 4 * MIXW, KB + (size_t)l * 1048576, VTB + (size_t)l * 1048576, CAT, tid, wave, lane);) }
                } else {
                    for (int u = opq_s(c); u < nscan; u += opq_s(G)) { DO_SCAN(gdn_scan2_unit(u, L + RING_OFF, CHB, UTB, CDB, OBUF, tid, wave, lane)); }
                    for (int u = opq_s(c); u < 256; u += opq_s(G)) { PH_XA(xattn_unit(u, L + RING_OFF, PROJ, GDN_LD, 4 * MIXW, KB + (size_t)l * 1048576, VTB + (size_t)l * 1048576, CAT, tid, wave, lane);) }
                }
            }
            GRID_BAR();
            TP_END(7);
            TP_BEGIN(5);
            PH_GOUT(gdn_out_phase(gw, NGW, lane, OBUF, PROJ, INP(I_NORMG) + j2 * GHD, CAT);)
            GRID_BAR();
            TP_END(5);
        }
        TP_BEGIN(3);
        { pg8::Gemm g{CAT, WOUT + (size_t)l * DM * DM, MROWS, DM, DM}; pg8::StaticOrder S; S.init(MROWS, DM, opq_s(G), opq_s(c)); pg8::EpiProj E{OUTb, DM, nullptr, -1};
          PH_WOUT((pg8::gemm_phase<pg8::EpiProj, pg8::StaticOrder, PG8_ALIGN, PG8_SP2>(L + RING_OFF, g, S, E))); }
        GRID_BAR();
        TP_END(3);
        TP_BEGIN(6);
        PH_NORM(norm_phase(gw, NGW, lane, OUTb, 1.0f, INP(I_MPOST) + (size_t)l * DM, Hbuf, true, Hbuf, true, INP(I_FPRE) + (size_t)(l * 2 + 1) * DM, Abuf);)
        GRID_BAR();
        TP_END(6);
        FFN_GEMMS(1);
        TP_BEGIN(6);
        if (l < DEPTH - 1) {
            PH_NORM(norm_phase(gw, NGW, lane, OUTb, 0.5f, INP(I_FPOST) + (size_t)(l * 2 + 1) * DM, Hbuf, true, Hbuf, true, INP(I_FPRE) + (size_t)((l + 1) * 2) * DM, Abuf);)
            GRID_BAR();
        } else {
            PH_NORM(norm_phase(gw, NGW, lane, OUTb, 0.5f, INP(I_FPOST) + (size_t)(l * 2 + 1) * DM, Hbuf, true, ((float*)karg_ptr(19)), false, nullptr, nullptr);)
        }
        TP_END(6);
    }
#ifdef TPROBE
    if (c == 0 && tid0 == 0) { unsigned long long a_ = (((unsigned long long)MISC[19] << 32) | MISC[18]); const unsigned long long t0_ = __builtin_amdgcn_s_memrealtime();
#if TPROBE == 8
        { const unsigned long long b_ = (((unsigned long long)MISC[23] << 32) | MISC[22]); a_ = b_ * 10000ull / (a_ ? a_ : 1ull); }
#endif
        while (__builtin_amdgcn_s_memrealtime() - t0_ < a_) __builtin_amdgcn_s_sleep(8); }
#endif
#undef FFN_GEMMS
#undef GRID_BAR
#undef tid
#undef lane
#undef wave
#undef gw
#undef NGW
}

extern "C" void kernel_launch(void* const* d_in, const int* in_sizes, int n_in, void* d_out, int out_size, void* d_ws, size_t ws_size, hipStream_t stream) {
    static int grid = 0;
    if (grid == 0) {
        if (n_in != 19 || in_sizes[0] != MROWS * DM || out_size != MROWS * DM || ws_size < WS_END) {
            fprintf(stderr, "kernel_launch: unexpected problem (n_in %d, in0 %d, out %d, ws %zu, need %zu); nothing launched\n", n_in, n_in > 0 ? in_sizes[0] : -1, out_size, ws_size, (size_t)WS_END); grid = -1; return; }
        int dev = 0, cus = 0, per_cu = 0;
        if (hipGetDevice(&dev) != hipSuccess || hipDeviceGetAttribute(&cus, hipDeviceAttributeMultiprocessorCount, dev) != hipSuccess) { fprintf(stderr, "kernel_launch: device query failed\n"); grid = -1; return; }
        if (hipFuncSetAttribute((const void*)fwd_kernel, hipFuncAttributeMaxDynamicSharedMemorySize, LDS_BYTES) != hipSuccess) { fprintf(stderr, "kernel_launch: hipFuncSetAttribute failed\n"); grid = -1; return; }
        if (hipOccupancyMaxActiveBlocksPerMultiprocessor(&per_cu, (const void*)fwd_kernel, NWAVES * 64, LDS_BYTES) != hipSuccess || per_cu < 1)
            fprintf(stderr, "kernel_launch: note: occupancy query reports %d workgroups per CU\n", per_cu);
        (void)hipGetLastError();
        grid = cus;
    }
    if (grid < 0) return;
    if (hipMemsetAsync((char*)d_ws + WS_CTL, 0, CTL_ZERO_BYTES, stream) != hipSuccess) { fprintf(stderr, "kernel_launch: memset failed\n"); return; }
    Args a{};
    for (int i = 0; i < 19; ++i) a.in[i] = (const float*)d_in[i];
    a.out = (float*)d_out; a.ws = (unsigned char*)d_ws;
    hipLaunchKernelGGL(fwd_kernel, dim3(grid), dim3(NWAVES * 64), LDS_BYTES, stream, a);
    const hipError_t le = hipPeekAtLastError();
    if (le != hipSuccess) fprintf(stderr, "kernel_launch: launch failed: %s\n", hipGetErrorName(le));
}
```

```cpp
#include <hip/hip_runtime.h>
#include <cstdio>
#include <cstdint>
namespace pg8 {
#define PG8_LAS __attribute__((address_space(3)))
typedef unsigned short bf16_t;
typedef short bf16x8 __attribute__((ext_vector_type(8)));
typedef float f32x4 __attribute__((ext_vector_type(4)));
typedef unsigned u32x4 __attribute__((ext_vector_type(4)));
constexpr int BM = 256, BK = 64, HALF = 128, HTB = HALF * BK * 2  , STAGE_BYTES = 8 * HTB, NXCD = 8, WGM = 8;

__host__ __device__ __forceinline__ int lds_byte(int r, int c) { const int st = (r >> 4) * 2 + (c >> 5), rr = r & 15, cc = c & 31, ob = rr * 64 + cc * 2; return st * 1024 + (ob ^ (((ob >> 9) & 1) << 5)); }
__host__ __device__ __forceinline__ void stage_rc(int b, int& R, int& C) { const int st = b / 1024, sb = b % 1024, swz = sb ^ (((sb >> 9) & 1) << 5); R = (st >> 1) * 16 + swz / 64; C = (st & 1) * 32 + (swz % 64) / 2; }
__host__ __device__ __forceinline__ int perm32(int rho) { const int n = rho >> 4, i = rho & 15; return 8 * (i >> 2) + 4 * n + (i & 3); }

struct Unit { int pm, pn; };
struct Gemm { const bf16_t* A; const bf16_t* Bt; int M, N, K; };

struct StaticOrder {
    int nM, nN, nwg, G, c;
    __host__ __device__ void init(int M, int N, int G_, int c_) { nM = M / BM; nN = N / BM; nwg = nM * nN; G = G_; c = c_; }
    __host__ __device__ bool next(int i, Unit& u) const {
        const long L = (long)i * G + c; if (L >= nwg) return false;
        int wgid = (int)L; { const int q = nwg / NXCD, r = nwg % NXCD, xcd = wgid % NXCD, off = wgid / NXCD; wgid = (xcd < r ? xcd * (q + 1) : r * (q + 1) + (xcd - r) * q) + off; }
        const int nig = WGM * nN, gid = wgid / nig, fm = gid * WGM, gsz = (nM - fm) < WGM ? (nM - fm) : WGM;
        u.pm = fm + ((wgid % nig) % gsz); u.pn = (wgid % nig) / gsz; return true;
    }
    __device__ __forceinline__ void a_ready(const Unit&) const {}
    __device__ __forceinline__ void done(const Unit&) const {}
};

__device__ __forceinline__ unsigned cvt_pk_bf16(float lo, float hi) { unsigned r; asm volatile("v_cvt_pk_bf16_f32 %0, %1, %2" : "=v"(r) : "v"(lo), "v"(hi)); return r; }

struct EpiProj {
    static constexpr bool PERM = true, AFTER_DRAIN = false;
    bf16_t* O; int ldc; float* aux; int aux_pn;
    __device__ __forceinline__ void operator()(const f32x4 (&acc)[2][2][4][2], const Unit& u, int wr, int wc, int fr, int fq) const {
        const int row0 = u.pm * BM + wr * 64 + fr;
        if (u.pn == aux_pn) {
            if (wc < 2) {
#pragma unroll
                for (int ai = 0; ai < 2; ++ai)
#pragma unroll
                    for (int m = 0; m < 4; ++m) { float* rowp = aux + (size_t)(row0 + ai * HALF + m * 16) * 64 + wc * 32 + 8 * fq;
                        *(f32x4*)(rowp) = acc[ai][0][m][0]; *(f32x4*)(rowp + 4) = acc[ai][0][m][1]; }
            }
            return;
        }
        const int col0 = u.pn * BM + wc * 32 + 8 * fq;
#pragma unroll
        for (int ai = 0; ai < 2; ++ai)
#pragma unroll
            for (int m = 0; m < 4; ++m) { bf16_t* rowp = O + (size_t)(row0 + ai * HALF + m * 16) * ldc + col0;
#pragma unroll
                for (int bj = 0; bj < 2; ++bj) { const f32x4 v0 = acc[ai][bj][m][0], v1 = acc[ai][bj][m][1];
                    u32x4 w; w.x = cvt_pk_bf16(v0[0], v0[1]); w.y = cvt_pk_bf16(v0[2], v0[3]); w.z = cvt_pk_bf16(v1[0], v1[1]); w.w = cvt_pk_bf16(v1[2], v1[3]);
                    *(u32x4*)(rowp + bj * HALF) = w; } }
    }
};
struct EpiSwiGLU {
    static constexpr bool PERM = true, AFTER_DRAIN = false;
    bf16_t* O; int ldc;
    __device__ __forceinline__ void operator()(const f32x4 (&acc)[2][2][4][2], const Unit& u, int wr, int wc, int fr, int fq) const {
        const int row0 = u.pm * BM + wr * 64 + fr, col0 = u.pn * HALF + wc * 32 + 8 * fq;
#pragma unroll
        for (int ai = 0; ai < 2; ++ai)
#pragma unroll
            for (int m = 0; m < 4; ++m) { bf16_t* rowp = O + (size_t)(row0 + ai * HALF + m * 16) * ldc + col0;
                f32x4 r[2];
#pragma unroll
                for (int n = 0; n < 2; ++n)
#pragma unroll
                    for (int j = 0; j < 4; ++j) { const float g = acc[ai][0][m][n][j], up = acc[ai][1][m][n][j];
                        r[n][j] = g * up * __builtin_amdgcn_rcpf(1.0f + __builtin_amdgcn_exp2f(g * -1.44269504089f)); }
                u32x4 w; w.x = cvt_pk_bf16(r[0][0], r[0][1]); w.y = cvt_pk_bf16(r[0][2], r[0][3]); w.z = cvt_pk_bf16(r[1][0], r[1][1]); w.w = cvt_pk_bf16(r[1][2], r[1][3]);
                *(u32x4*)(rowp) = w; }
    }
};
struct EpiKV {
    static constexpr bool PERM = true, AFTER_DRAIN = false;
    bf16_t* Kb; bf16_t* VTb;
    __device__ __forceinline__ void operator()(const f32x4 (&acc)[2][2][4][2], const Unit& u, int wr, int wc, int fr, int fq) const {
        const int l = u.pm / 12, ri = u.pm % 12, rj = u.pn % 12;
        bf16_t* base = (ri < 4) ? Kb + (size_t)l * 1048576 + (size_t)(ri * 256) * 1024 + (rj - 4) * 256
                                : VTb + (size_t)l * 1048576 + (size_t)((ri - 8) * 256) * 1024 + rj * 256;
        const int row0 = wr * 64 + fr, col0 = wc * 32 + 8 * fq;
        const int p0 = 8 * ((2 * fq) & 3) + 4 * (fq >> 1), p1 = 8 * ((2 * fq + 1) & 3) + 4 * (fq >> 1);
        typedef unsigned u32x2e __attribute__((ext_vector_type(2)));
#pragma unroll
        for (int ai = 0; ai < 2; ++ai)
#pragma unroll
            for (int m = 0; m < 4; ++m) { bf16_t* rowp = base + (size_t)(row0 + ai * HALF + m * 16) * 1024;
#pragma unroll
                for (int bj = 0; bj < 2; ++bj) { const f32x4 v0 = acc[ai][bj][m][0], v1 = acc[ai][bj][m][1];
                    u32x4 w; w.x = cvt_pk_bf16(v0[0], v0[1]); w.y = cvt_pk_bf16(v0[2], v0[3]); w.z = cvt_pk_bf16(v1[0], v1[1]); w.w = cvt_pk_bf16(v1[2], v1[3]);
                    if (ri < 4) *(u32x4*)(rowp + col0 + bj * HALF) = w;
                    else { *(u32x2e*)(rowp + wc * 32 + bj * HALF + p0) = (u32x2e){w.x, w.y}; *(u32x2e*)(rowp + wc * 32 + bj * HALF + p1) = (u32x2e){w.z, w.w}; } } }
    }
};
struct KvOrder {
    int nwg, c, lbase, nunits;
    __device__ __forceinline__ bool next(int i, Unit& u) const {
        if (c < 0) return false;
        const int L = i * nwg + c; if (L >= nunits) return false;
        const int l = lbase + (L >> 5), r = L & 31;
        if (r < 16) { u.pm = 12 * l + (r >> 2); u.pn = 12 * l + 4 + (r & 3); }
        else { u.pm = 12 * l + 8 + ((r - 16) >> 2); u.pn = 12 * l + (r & 3); }
        return true;
    }
    __device__ __forceinline__ void a_ready(const Unit&) const {}
    __device__ __forceinline__ void done(const Unit&) const {}
};

template <class Epi, class Sched, bool ALIGN_EPI = false, bool SP2 = false>
__device__ __forceinline__ void gemm_phase(PG8_LAS unsigned char* lds, const Gemm g, const Sched& S, const Epi& E) {
    int tid_o = threadIdx.x; asm volatile("" : "+v"(tid_o));
    const int tid = tid_o, wid = __builtin_amdgcn_readfirstlane(tid >> 6), lane = tid & 63, wr = wid >> 2, wc = wid & 3, fr = lane & 15, fq = lane >> 4;
    const int K = g.K, nt = K / BK;
    unsigned voffA[2], voffB[2];
#pragma unroll
    for (int i = 0; i < 2; ++i) { int R, C; stage_rc(tid * 16 + i * 8192, R, C); const int Rb = Epi::PERM ? ((R & ~31) + perm32(R & 31)) : R;
        voffA[i] = (unsigned)(R * K + C) * 2u; voffB[i] = (unsigned)(Rb * K + C) * 2u; }
    const size_t kstep = (size_t)(BK * 2);
    const size_t hstep = (size_t)HALF * K * 2;
    const size_t tstep = 2 * hstep;
    const unsigned ldsw = (unsigned)wid * 1024u;
    const int aoff = lds_byte(wr * 64 + fr, fq * 8), boff = lds_byte(wc * 32 + fr, fq * 8);
#define PG8_SA(b, h) (((b) * 2 + (h)) * HTB)
#define PG8_SB(b, h) ((4 + (b) * 2 + (h)) * HTB)
#define PG8_STAGE(bufoff, gbase, voff) do { _Pragma("unroll") for (int _i = 0; _i < 2; ++_i) \
        __builtin_amdgcn_global_load_lds((const unsigned*)((const char*)(gbase) + (voff)[_i]), (PG8_LAS unsigned*)(lds + (bufoff) + ldsw + _i * 8192), 16, 0, 0); } while (0)
#define PG8_LDA(dst, b, h) do { _Pragma("unroll") for (int m = 0; m < 4; ++m) _Pragma("unroll") for (int k = 0; k < 2; ++k) dst[m][k] = *(const PG8_LAS bf16x8*)(lds + PG8_SA(b, h) + aoff + m * 2048 + k * 1024); } while (0)
#define PG8_LDB(dst, b, h) do { _Pragma("unroll") for (int n = 0; n < 2; ++n) _Pragma("unroll") for (int k = 0; k < 2; ++k) dst[n][k] = *(const PG8_LAS bf16x8*)(lds + PG8_SB(b, h) + boff + n * 2048 + k * 1024); } while (0)
#define PG8_MMA(ai, bj, At, Bt) do { __builtin_amdgcn_s_setprio(1); _Pragma("unroll") for (int m = 0; m < 4; ++m) _Pragma("unroll") for (int n = 0; n < 2; ++n) _Pragma("unroll") for (int k = 0; k < 2; ++k) \
        acc[ai][bj][m][n] = __builtin_amdgcn_mfma_f32_16x16x32_bf16(Bt[n][k], At[m][k], acc[ai][bj][m][n], 0, 0, 0); __builtin_amdgcn_s_setprio(0); } while (0)
#define PG8_WAIT_V(n) asm volatile("s_waitcnt vmcnt(" #n ")" ::: "memory")
#define PG8_WAIT_L(n) asm volatile("s_waitcnt lgkmcnt(" #n ")" ::: "memory")
#define PG8_BAR __builtin_amdgcn_s_barrier()
#define PG8_SCHED __builtin_amdgcn_sched_barrier(0)
    Unit cur, nxt; int ui = 0;
    if (!S.next(0, cur)) return;
    f32x4 acc[2][2][4][2];
#pragma unroll
    for (int a = 0; a < 2; ++a)
#pragma unroll
        for (int b = 0; b < 2; ++b)
#pragma unroll
            for (int m = 0; m < 4; ++m)
#pragma unroll
                for (int n = 0; n < 2; ++n) acc[a][b][m][n] = (f32x4){0.f, 0.f, 0.f, 0.f};
    bf16x8 At[4][2], B0[2][2], B1[2][2];
    const char* cA = (const char*)g.A + (size_t)cur.pm * tstep; const char* cB = (const char*)g.Bt + (size_t)cur.pn * tstep;
    S.a_ready(cur);
    if constexpr (SP2) {
        PG8_STAGE(PG8_SB(0, 0), cB, voffB); PG8_STAGE(PG8_SB(0, 1), cB + hstep, voffB); PG8_STAGE(PG8_SA(0, 0), cA, voffA); PG8_STAGE(PG8_SA(0, 1), cA + hstep, voffA);
        if (wr == 1) PG8_BAR;
        PG8_WAIT_V(2); PG8_BAR;
        PG8_STAGE(PG8_SB(1, 0), cB + kstep, voffB); PG8_STAGE(PG8_SA(1, 0), cA + kstep, voffA); PG8_STAGE(PG8_SB(1, 1), cB + hstep + kstep, voffB);
        PG8_WAIT_V(6); PG8_BAR;
    } else {
        PG8_STAGE(PG8_SB(0, 0), cB, voffB); PG8_STAGE(PG8_SA(0, 0), cA, voffA); PG8_STAGE(PG8_SB(0, 1), cB + hstep, voffB); PG8_STAGE(PG8_SA(0, 1), cA + hstep, voffA);
        if (wr == 1) PG8_BAR;
        PG8_WAIT_V(4); PG8_BAR;
        PG8_STAGE(PG8_SB(1, 0), cB + kstep, voffB); PG8_STAGE(PG8_SA(1, 0), cA + kstep, voffA); PG8_STAGE(PG8_SB(1, 1), cB + hstep + kstep, voffB);
        PG8_WAIT_V(6); PG8_BAR;
    }
    for (;;) {
        const bool has_next = S.next(ui + 1, nxt);
        const char* nA = has_next ? (const char*)g.A + (size_t)nxt.pm * tstep : cA; const char* nB = has_next ? (const char*)g.Bt + (size_t)nxt.pn * tstep : cB;
        for (int t = 0; t < nt; t += 2) {
            const bool last = (t == nt - 2);
            const char* a1 = cA + (size_t)(t + 1) * kstep;
            const char* a2 = last ? nA : cA + (size_t)(t + 2) * kstep; const char* b2 = last ? nB : cB + (size_t)(t + 2) * kstep;
            const char* a3 = a2 + kstep; const char* b3 = b2 + kstep;
            if (last && has_next) S.a_ready(nxt);
            if constexpr (SP2) {
            PG8_LDB(B0, 0, 0); PG8_LDB(B1, 0, 1); PG8_SCHED; PG8_LDA(At, 0, 0); PG8_STAGE(PG8_SA(1, 1), a1 + hstep, voffA);
            PG8_WAIT_V(8); PG8_WAIT_L(0); PG8_BAR; PG8_MMA(0, 0, At, B0); PG8_MMA(0, 1, At, B1); PG8_BAR; PG8_SCHED;
            PG8_LDA(At, 0, 1); PG8_STAGE(PG8_SB(0, 0), b2, voffB); PG8_STAGE(PG8_SB(0, 1), b2 + hstep, voffB); PG8_STAGE(PG8_SA(0, 0), a2, voffA);
            PG8_WAIT_V(8); PG8_WAIT_L(0); PG8_BAR; PG8_MMA(1, 0, At, B0); PG8_MMA(1, 1, At, B1); PG8_BAR; PG8_SCHED;
            PG8_LDB(B0, 1, 0); PG8_LDB(B1, 1, 1); PG8_SCHED; PG8_LDA(At, 1, 0); PG8_STAGE(PG8_SA(0, 1), a2 + hstep, voffA);
            PG8_WAIT_V(8); PG8_WAIT_L(0); PG8_BAR; PG8_MMA(0, 0, At, B0); PG8_MMA(0, 1, At, B1); PG8_BAR; PG8_SCHED;
            PG8_LDA(At, 1, 1); PG8_STAGE(PG8_SB(1, 0), b3, voffB); PG8_STAGE(PG8_SB(1, 1), b3 + hstep, voffB); PG8_STAGE(PG8_SA(1, 0), a3, voffA);
            PG8_WAIT_V(8); PG8_WAIT_L(0); PG8_BAR; PG8_MMA(1, 0, At, B0); PG8_MMA(1, 1, At, B1); PG8_BAR; PG8_SCHED;
            } else {
            PG8_LDB(B0, 0, 0); PG8_SCHED; PG8_LDA(At, 0, 0); PG8_STAGE(PG8_SA(1, 1), a1 + hstep, voffA);
            PG8_WAIT_L(8); PG8_BAR; PG8_WAIT_L(0); PG8_MMA(0, 0, At, B0); PG8_BAR; PG8_SCHED;
            PG8_LDB(B1, 0, 1); PG8_STAGE(PG8_SB(0, 0), b2, voffB);
            PG8_BAR; PG8_WAIT_L(0); PG8_MMA(0, 1, At, B1); PG8_BAR;
            PG8_LDA(At, 0, 1); PG8_STAGE(PG8_SA(0, 0), a2, voffA);
            PG8_BAR; PG8_WAIT_L(0); PG8_MMA(1, 0, At, B0); PG8_BAR; PG8_SCHED;
            PG8_STAGE(PG8_SB(0, 1), b2 + hstep, voffB);
            PG8_WAIT_V(6); PG8_BAR; PG8_MMA(1, 1, At, B1); PG8_BAR;
            PG8_LDB(B0, 1, 0); PG8_SCHED; PG8_LDA(At, 1, 0); PG8_STAGE(PG8_SA(0, 1), a2 + hstep, voffA);
            PG8_WAIT_L(8); PG8_BAR; PG8_WAIT_L(0); PG8_MMA(0, 0, At, B0); PG8_BAR; PG8_SCHED;
            PG8_LDB(B1, 1, 1); PG8_STAGE(PG8_SB(1, 0), b3, voffB);
            PG8_BAR; PG8_WAIT_L(0); PG8_MMA(0, 1, At, B1); PG8_BAR;
            PG8_LDA(At, 1, 1); PG8_STAGE(PG8_SA(1, 0), a3, voffA);
            PG8_BAR; PG8_WAIT_L(0); PG8_MMA(1, 0, At, B0); PG8_BAR; PG8_SCHED;
            PG8_STAGE(PG8_SB(1, 1), b3 + hstep, voffB);
            PG8_WAIT_V(6); PG8_BAR; PG8_MMA(1, 1, At, B1); PG8_BAR;
            }
        }
        if constexpr (ALIGN_EPI) { if (wr == 0) PG8_BAR; }
        if constexpr (!Epi::AFTER_DRAIN) { E(acc, cur, wr, wc, fr, fq); S.done(cur); }
        if (!has_next) break;
#pragma unroll
        for (int a = 0; a < 2; ++a)
#pragma unroll
            for (int b = 0; b < 2; ++b)
#pragma unroll
                for (int m = 0; m < 4; ++m)
#pragma unroll
                    for (int n = 0; n < 2; ++n) acc[a][b][m][n] = (f32x4){0.f, 0.f, 0.f, 0.f};
        cur = nxt; cA = nA; cB = nB; ++ui;
        if constexpr (ALIGN_EPI) { if (wr == 1) PG8_BAR; }
    }
    PG8_WAIT_V(0);
    if constexpr (!ALIGN_EPI) { if (wr == 0) PG8_BAR; }
    PG8_BAR;
    if constexpr (Epi::AFTER_DRAIN) { E.fused(acc, cur, wr, wc, fr, fq, lds, wid, lane); S.done(cur); }
#undef PG8_SA
#undef PG8_SB
#undef PG8_STAGE
#undef PG8_LDA
#undef PG8_LDB
#undef PG8_MMA
#undef PG8_WAIT_V
#undef PG8_WAIT_L
#undef PG8_BAR
#undef PG8_SCHED
}
}

#ifndef PG8_SP2
#define PG8_SP2 true
#endif
#ifndef PG8_ALIGN
#define PG8_ALIGN true
#endif

constexpr int NWAVES = 8;
constexpr int DM = 4096, NBATCH = 4, SEQ = 2048, MROWS = NBATCH * SEQ, DEPTH = 4;
constexpr int MEMT = 256, XH = 4, XW = 1024, XHD = 256, MIXW = 3072, DFF = 6144;
constexpr int GH = 24, GHD = 128;
constexpr int SC_IN = 3 * MIXW + XW;
constexpr int GDN_SRC = 4 * MIXW + 2 * GH + XW;
constexpr int GDN_LD = 4 * MIXW + XW;
constexpr int GDN_N = GDN_LD + 256;
constexpr float EPS = 1e-6f;

constexpr size_t MiB = 1u << 20;
constexpr size_t WS_CTL = 0, CTL_ZERO_BYTES = 1 * MiB;
constexpr size_t WS_H = 1 * MiB;
constexpr size_t WS_A = WS_H + 128 * MiB;
constexpr size_t WS_OUT = WS_A + 64 * MiB;
constexpr size_t WS_CAT = WS_OUT + 64 * MiB;
constexpr size_t WS_ACT = WS_CAT + 64 * MiB;
constexpr size_t WS_PROJ = WS_ACT + 96 * MiB;
constexpr size_t WS_AUX = WS_PROJ + 208 * MiB;
constexpr size_t WS_AB = WS_AUX + 2 * MiB;
constexpr size_t WS_QKV = WS_AB + 2 * MiB;
constexpr size_t WS_O = WS_QKV + 144 * MiB;
constexpr size_t WS_KVOPS = WS_O + 96 * MiB;
constexpr size_t WS_KB = WS_KVOPS + 96 * MiB;
constexpr size_t WS_VTB = WS_KB + 8 * MiB;
constexpr size_t WS_WGU = WS_VTB + 8 * MiB;
constexpr size_t WS_WDN = WS_WGU + 768 * MiB;
constexpr size_t WS_WOUT = WS_WDN + 384 * MiB;
constexpr size_t WS_WSC = WS_WOUT + 128 * MiB;
constexpr size_t WS_WGDN = WS_WSC + 160 * MiB;
constexpr size_t WS_CHB = WS_WGDN + 212 * MiB;
constexpr size_t WS_UT = WS_CHB + 168 * MiB;
constexpr size_t WS_CD = WS_UT + 96 * MiB;
constexpr size_t WS_END = WS_CD + 1 * MiB;
constexpr int CW_BAR = 4096;

constexpr int RING_OFF = 0, RING_BYTES = 131072;
constexpr int XP_SCR = 64 * 65 * 4;
constexpr int LDSCTL_OFF = 139264, MISC_OFF = LDSCTL_OFF + 320;
static_assert(LDSCTL_OFF >= 8 * XP_SCR, "LDS map");
static_assert(LDSCTL_OFF >= RING_BYTES, "LDS map");
constexpr int LDS_BYTES = 147456;

#define GAS __attribute__((address_space(1)))
#define LAS __attribute__((address_space(3)))
typedef unsigned short bf16;
typedef unsigned v4u __attribute__((ext_vector_type(4)));
typedef unsigned v2u __attribute__((ext_vector_type(2)));
typedef float f32x4 __attribute__((ext_vector_type(4)));
typedef float f32x2 __attribute__((ext_vector_type(2)));
typedef short bf16x8 __attribute__((ext_vector_type(8)));
#define LDS_WAIT() asm volatile("s_waitcnt lgkmcnt(0)" ::: "memory")
#define VM_WAIT() asm volatile("s_waitcnt vmcnt(0)" ::: "memory")
__device__ __forceinline__ unsigned pk2(float lo, float hi) { return pg8::cvt_pk_bf16(lo, hi); }
__device__ __forceinline__ float bflo(unsigned u) { return __uint_as_float(u << 16); }
__device__ __forceinline__ float bfhi(unsigned u) { return __uint_as_float(u & 0xffff0000u); }
__device__ __forceinline__ float silu_f(float x) { return x * __builtin_amdgcn_rcpf(1.0f + __builtin_amdgcn_exp2f(x * -1.44269504089f)); }
__device__ __forceinline__ int opq_v(int x) { asm volatile("" : "+v"(x)); return x; }
__device__ __forceinline__ int opq_s(int x) { asm volatile("" : "+s"(x)); return x; }

#define XB_TMO      128
#define XB_XCNT(j)  (256  + 64 * (j))
#define XB_XSUB(j)  (1280 + 64 * (j))
#define XB_XGEN(j)  (2304 + 64 * (j))
#define XB_TOP      3328
#define XB_TOPGEN   3392
#define XCD_BAR_WORDS 3456
#define XB_SPIN_CAP (1u << 18)

__device__ __forceinline__ unsigned xb_ld(unsigned* p)              { return __hip_atomic_load(p, __ATOMIC_RELAXED, __HIP_MEMORY_SCOPE_AGENT); }
__device__ __forceinline__ unsigned xb_add(unsigned* p, unsigned v) { return __hip_atomic_fetch_add(p, v, __ATOMIC_RELAXED, __HIP_MEMORY_SCOPE_AGENT); }
__device__ __forceinline__ unsigned xb_xcc_id() { return (unsigned)__builtin_amdgcn_s_getreg((3 << 11) | 20) & 0xFu; }
#define XB_SPIN(cond, bar) do { unsigned _sp = 0; while (cond) { __builtin_amdgcn_s_sleep(1); \
    if ((++_sp & 255u) == 0u) { if (xb_ld(&(bar)[XB_TMO])) break; if (_sp > XB_SPIN_CAP) { atomicAdd(&(bar)[XB_TMO], 1u); break; } } } } while (0)

struct XcdBarrier {
    unsigned* bar; unsigned x;
    volatile LAS unsigned* st;
};
__device__ __forceinline__ XcdBarrier xcd_barrier_post(unsigned* bar, volatile LAS unsigned* st) {
    XcdBarrier b; b.bar = bar; b.x = xb_xcc_id(); b.st = st;
    if (threadIdx.x == 0) (void)xb_add(&bar[XB_XCNT(b.x)], 1u);
    return b;
}
__device__ __forceinline__ void xcd_barrier_complete(unsigned* bar, unsigned x, unsigned& nloc, unsigned& nx) {
    const unsigned G = gridDim.x * gridDim.y * gridDim.z;
    unsigned sum, cnt, mine, sp = 0u;
    for (;;) {
        sum = 0u; cnt = 0u; mine = 0u;
#pragma unroll
        for (unsigned j = 0; j < 16; ++j) { const unsigned c = xb_ld(&bar[XB_XCNT(j)]); sum += c; cnt += (c > 0u) ? 1u : 0u; mine = (j == x) ? c : mine; }
        if (sum == G) break;
        __builtin_amdgcn_s_sleep(1);
        if ((++sp & 255u) == 0u) { if (xb_ld(&bar[XB_TMO])) break; if (sp > XB_SPIN_CAP) { atomicAdd(&bar[XB_TMO], 1u); break; } }
    }
    nloc = mine > 0u ? mine : 1u; nx = cnt > 0u ? cnt : 1u;
}
__device__ __forceinline__ void xcd_barrier(const XcdBarrier& b) {
    asm volatile("s_waitcnt vmcnt(0)" ::: "memory");
    __syncthreads();
    if (threadIdx.x == 0) {
        unsigned* bar = b.bar;
        __builtin_amdgcn_s_waitcnt(0);
        unsigned nloc = b.st[0], nx = b.st[1];
        if (nloc == 0u) { xcd_barrier_complete(bar, b.x, nloc, nx); b.st[0] = nloc; b.st[1] = nx; }
        const unsigned old = xb_add(&bar[XB_XSUB(b.x)], 1u);
        const unsigned gen = old / nloc;
        if (old + 1u == (gen + 1u) * nloc) {
            __builtin_amdgcn_fence(__ATOMIC_RELEASE, "agent");
            asm volatile("s_waitcnt vmcnt(0)" ::: "memory");
            const unsigned og = xb_add(&bar[XB_TOP], 1u);
            const unsigned tg = og / nx;
            if (og + 1u == (tg + 1u) * nx) xb_add(&bar[XB_TOPGEN], 1u);
            else XB_SPIN(xb_ld(&bar[XB_TOPGEN]) == tg, bar);
            __builtin_amdgcn_fence(__ATOMIC_ACQUIRE, "agent");
            xb_add(&bar[XB_XGEN(b.x)], 1u);
            asm volatile("s_waitcnt vmcnt(0)" ::: "memory");
        } else {
            XB_SPIN(xb_ld(&bar[XB_XGEN(b.x)]) == gen, bar);
            __builtin_amdgcn_fence(__ATOMIC_ACQUIRE, "agent");
            asm volatile("s_waitcnt vmcnt(0)" ::: "memory");
        }
    }
    __syncthreads();
}

__device__ __forceinline__ float wave_sum(float v) {
#pragma unroll
    for (int o = 1; o < 64; o <<= 1) v += __shfl_xor(v, o);
    return v;
}
__device__ __forceinline__ float grp16_sum(float v) {
#pragma unroll
    for (int o = 1; o < 16; o <<= 1) v += __shfl_xor(v, o);
    return v;
}
template <int CTRL> __device__ __forceinline__ float dpp_mov(float v) {
    return __builtin_bit_cast(float, __builtin_amdgcn_update_dpp(0, __builtin_bit_cast(int, v), CTRL, 0xF, 0xF, true));
}
__device__ __forceinline__ float grp8_sum(float v) {
    v += dpp_mov<0xB1>(v); v += dpp_mov<0x4E>(v); v += dpp_mov<0x141>(v); return v;
}

__device__ __forceinline__ void xpose_load(f32x4 (&v)[16], const float* W, int N, int col0, int nvalid, int k0, int n0, int lane) {
    const int nn = n0 + 4 * (lane & 15); const bool ok = nn < nvalid;
    const float* p = W + (size_t)(k0 + (lane >> 4)) * N + col0 + nn;
#pragma unroll
    for (int i = 0; i < 16; ++i) v[i] = ok ? __builtin_nontemporal_load((const GAS f32x4*)(p + (size_t)(4 * i) * N)) : (f32x4){0.f, 0.f, 0.f, 0.f};
}
__device__ __forceinline__ void xpose_store(const f32x4 (&v)[16], bf16* WT, int Kd, int drow0, LAS float* scr, int k0, int lane) {
    LAS float* w = scr + (lane >> 4) * 65 + 4 * (lane & 15);
#pragma unroll
    for (int i = 0; i < 16; ++i) { w[(4 * i) * 65 + 0] = v[i][0]; w[(4 * i) * 65 + 1] = v[i][1]; w[(4 * i) * 65 + 2] = v[i][2]; w[(4 * i) * 65 + 3] = v[i][3]; }
    LDS_WAIT(); asm volatile("" ::: "memory");
    const int c = lane & 7;
#pragma unroll
    for (int j = 0; j < 8; ++j) { const int n = (lane >> 3) + 8 * j; const LAS float* s = scr + (8 * c) * 65 + n;
        v4u o; o.x = pk2(s[0 * 65], s[1 * 65]); o.y = pk2(s[2 * 65], s[3 * 65]); o.z = pk2(s[4 * 65], s[5 * 65]); o.w = pk2(s[6 * 65], s[7 * 65]);
        __builtin_nontemporal_store(o, (GAS v4u*)(WT + (size_t)(drow0 + n) * Kd + k0 + 8 * c)); }
    LDS_WAIT(); asm volatile("" ::: "memory");
}

struct Args { const float* in[19]; float* out; unsigned char* ws; };
enum { I_X = 0, I_MEM, I_FPRE, I_FPOST, I_MPRE, I_MPOST, I_MEMG, I_WG, I_WU, I_WD, I_WKV, I_WOUT, I_SCIN, I_SCCONV, I_GDNIN, I_GDNCONV, I_ALOG, I_DTB, I_NORMG };

__device__ __forceinline__ void norm_load(v4u (&hq)[16], v4u (&ov)[8], const void* hsrc, bool h16, const bf16* outb, int row, int lane) {
    if (h16) { const bf16* hr = (const bf16*)hsrc + (size_t)row * DM;
#pragma unroll
        for (int j = 0; j < 8; ++j) hq[j] = __builtin_nontemporal_load((const GAS v4u*)(hr + (j * 64 + lane) * 8)); }
    else { const float* hr = (const float*)hsrc + (size_t)row * DM;
#pragma unroll
        for (int j = 0; j < 8; ++j) { const int e = (j * 64 + lane) * 8; hq[2 * j] = __builtin_nontemporal_load((const GAS v4u*)(hr + e)); hq[2 * j + 1] = __builtin_nontemporal_load((const GAS v4u*)(hr + e + 4)); } }
    if (outb) {
#pragma unroll
        for (int j = 0; j < 8; ++j) ov[j] = __builtin_nontemporal_load((const GAS v4u*)(outb + (size_t)row * DM + (j * 64 + lane) * 8)); }
}
__device__ __forceinline__ void norm_unpack(f32x4 (&hv)[16], const v4u (&hq)[16], bool h16) {
    if (h16) {
#pragma unroll
        for (int j = 0; j < 8; ++j) { const v4u x = hq[j]; hv[2 * j] = (f32x4){bflo(x.x), bfhi(x.x), bflo(x.y), bfhi(x.y)}; hv[2 * j + 1] = (f32x4){bflo(x.z), bfhi(x.z), bflo(x.w), bfhi(x.w)}; } }
    else {
#pragma unroll
        for (int j = 0; j < 16; ++j) hv[j] = __builtin_bit_cast(f32x4, hq[j]); }
}
__device__ __forceinline__ void norm_row(f32x4 (&hv)[16], const v4u (&ov)[8], int row, int lane, bool has_out, float w, const float* g_post, void* hdst, bool d16, const float* g_pre, bf16* Adst) {
    if (has_out) {
        float ss = 0.f;
#pragma unroll
        for (int j = 0; j < 8; ++j)
#pragma unroll
            for (int q = 0; q < 4; ++q) { const float a = bflo(ov[j][q]), b = bfhi(ov[j][q]); ss += a * a + b * b; }
        ss = wave_sum(ss);
        const float sc = w / sqrtf(ss * (1.0f / DM) + EPS);
#pragma unroll
        for (int j = 0; j < 8; ++j) { const int e = (j * 64 + lane) * 8;
            const f32x4 g0 = *(const GAS f32x4*)(g_post + e), g1 = *(const GAS f32x4*)(g_post + e + 4);
            f32x4 o0, o1; o0[0] = bflo(ov[j][0]); o0[1] = bfhi(ov[j][0]); o0[2] = bflo(ov[j][1]); o0[3] = bfhi(ov[j][1]);
            o1[0] = bflo(ov[j][2]); o1[1] = bfhi(ov[j][2]); o1[2] = bflo(ov[j][3]); o1[3] = bfhi(ov[j][3]);
            hv[2 * j] += o0 * g0 * sc; hv[2 * j + 1] += o1 * g1 * sc; __builtin_amdgcn_sched_barrier(0); }
    }
    if (hdst) {
        if (d16) { bf16* hw = (bf16*)hdst + (size_t)row * DM;
#pragma unroll
            for (int j = 0; j < 8; ++j) { v4u o; o.x = pk2(hv[2 * j][0], hv[2 * j][1]); o.y = pk2(hv[2 * j][2], hv[2 * j][3]); o.z = pk2(hv[2 * j + 1][0], hv[2 * j + 1][1]); o.w = pk2(hv[2 * j + 1][2], hv[2 * j + 1][3]);
                __builtin_nontemporal_store(o, (GAS v4u*)(hw + (j * 64 + lane) * 8)); } }
        else { float* hw = (float*)hdst + (size_t)row * DM;
#pragma unroll
            for (int j = 0; j < 8; ++j) { const int e = (j * 64 + lane) * 8; __builtin_nontemporal_store(hv[2 * j], (GAS f32x4*)(hw + e)); __builtin_nontemporal_store(hv[2 * j + 1], (GAS f32x4*)(hw + e + 4)); } } }
    if (Adst) {
        float ss = 0.f;
#pragma unroll
        for (int j = 0; j < 16; ++j) ss += (hv[j][0] * hv[j][0] + hv[j][1] * hv[j][1]) + (hv[j][2] * hv[j][2] + hv[j][3] * hv[j][3]);
        ss = wave_sum(ss);
        const float sc = 1.0f / sqrtf(ss * (1.0f / DM) + EPS);
#pragma unroll
        for (int j = 0; j < 8; ++j) { const int e = (j * 64 + lane) * 8;
            const f32x4 g0 = *(const GAS f32x4*)(g_pre + e), g1 = *(const GAS f32x4*)(g_pre + e + 4);
            const f32x4 a0 = hv[2 * j] * g0 * sc, a1 = hv[2 * j + 1] * g1 * sc;
            v4u o; o.x = pk2(a0[0], a0[1]); o.y = pk2(a0[2], a0[3]); o.z = pk2(a1[0], a1[1]); o.w = pk2(a1[2], a1[3]);
            *(GAS v4u*)(Adst + (size_t)row * DM + e) = o; __builtin_amdgcn_sched_barrier(0); }
    }
}
__device__ __forceinline__ void norm_phase(int gw, int NGW, int lane, const bf16* outb, float w, const float* g_post, const void* hsrc, bool h16, void* hdst, bool d16, const float* g_pre, bf16* Adst) {
    for (int row = gw; row < MROWS; row += NGW) {
        v4u qa[16], oa[8]; f32x4 hv[16];
#pragma unroll
        for (int j = 0; j < 8; ++j) oa[j] = (v4u){0u, 0u, 0u, 0u};
        norm_load(qa, oa, hsrc, h16, outb, row, lane);
        norm_unpack(hv, qa, h16);
        norm_row(hv, oa, row, lane, outb != nullptr, w, g_post, hdst, d16, g_pre, Adst);
    }
}

constexpr int XA_PITCH = 544;
__device__ __forceinline__ void xa_stage(LAS unsigned char* ldsb, const bf16* src, int tid) {
#pragma unroll
    for (int hf = 0; hf < 2; ++hf) { v4u t[8];
#pragma unroll
        for (int e = 0; e < 8; ++e) { const int p = tid + 512 * (8 * hf + e); t[e] = *(const GAS v4u*)(src + (size_t)(p >> 5) * 1024 + (p & 31) * 8); }
#pragma unroll
        for (int e = 0; e < 8; ++e) { const int p = tid + 512 * (8 * hf + e); *(LAS v4u*)(ldsb + (p >> 5) * XA_PITCH + (p & 31) * 16) = t[e]; } }
}
__device__ __forceinline__ void xattn_unit(int unit, LAS unsigned char* ldsb, const bf16* proj, int ldp, int xq_col0, const bf16* Kb, const bf16* VTb, bf16* cat, int tid, int wave, int lane) {
    const int rb = unit & 15, h = (unit >> 4) & 3, b = unit >> 6;
    const int r0 = b * SEQ + rb * 128 + wave * 16, c15 = lane & 15, q4 = lane >> 4;
    xa_stage(ldsb, Kb + (size_t)(b * MEMT) * 1024 + h * XHD, tid);
    bf16x8 qf[8];
    const bf16* qp = proj + (size_t)(r0 + c15) * ldp + xq_col0 + h * XHD + 8 * q4;
#pragma unroll
    for (int s = 0; s < 8; ++s) qf[s] = *(const GAS bf16x8*)(qp + 32 * s);
    __syncthreads();
    f32x4 st[16];
    const LAS unsigned char* fp = ldsb + c15 * XA_PITCH + 16 * q4;
#pragma unroll
    for (int kb = 0; kb < 16; ++kb) { f32x4 acc = {0.f, 0.f, 0.f, 0.f};
#pragma unroll
        for (int s = 0; s < 8; ++s) acc = __builtin_amdgcn_mfma_f32_16x16x32_bf16(*(const LAS bf16x8*)(fp + (16 * kb) * XA_PITCH + 64 * s), qf[s], acc, 0, 0, 0);
        st[kb] = acc; }
    __syncthreads();
    xa_stage(ldsb, VTb + (size_t)(h * XHD) * 1024 + b * MEMT, tid);
    float mx = -3.0e38f;
#pragma unroll
    for (int kb = 0; kb < 16; ++kb)
#pragma unroll
        for (int j = 0; j < 4; ++j) mx = fmaxf(mx, st[kb][j]);
    mx = fmaxf(mx, __shfl_xor(mx, 16)); mx = fmaxf(mx, __shfl_xor(mx, 32));
    const float sc = 0.0625f * 1.44269504089f; float sum = 0.f;
#pragma unroll
    for (int kb = 0; kb < 16; ++kb)
#pragma unroll
        for (int j = 0; j < 4; ++j) { const float p = __builtin_amdgcn_exp2f((st[kb][j] - mx) * sc); st[kb][j] = p; sum += p; }
    sum += __shfl_xor(sum, 16); sum += __shfl_xor(sum, 32);
    const float inv = 1.0f / sum;
    bf16x8 pf[8];
#pragma unroll
    for (int s = 0; s < 8; ++s) { v4u w; w.x = pk2(st[2 * s][0], st[2 * s][1]); w.y = pk2(st[2 * s][2], st[2 * s][3]); w.z = pk2(st[2 * s + 1][0], st[2 * s + 1][1]); w.w = pk2(st[2 * s + 1][2], st[2 * s + 1][3]);
        pf[s] = __builtin_bit_cast(bf16x8, w); }
    __syncthreads();
    bf16* op = cat + (size_t)(r0 + c15) * DM + MIXW + h * XHD + 4 * q4;
#pragma unroll 4
    for (int db = 0; db < 16; ++db) { f32x4 acc = {0.f, 0.f, 0.f, 0.f};
#pragma unroll
        for (int s = 0; s < 8; ++s) acc = __builtin_amdgcn_mfma_f32_16x16x32_bf16(*(const LAS bf16x8*)(fp + (16 * db) * XA_PITCH + 64 * s), pf[s], acc, 0, 0, 0);
        v2u o; o.x = pk2(acc[0] * inv, acc[1] * inv); o.y = pk2(acc[2] * inv, acc[3] * inv);
        *(GAS v2u*)(op + 16 * db) = o; }
    __syncthreads();
}

__device__ __forceinline__ void sc_gate_phase(int gw, int NGW, int lane, const bf16* proj, const float* convw, bf16* cat) {
    for (int task = gw; task < (MROWS / 16) * 6; task += NGW) {
        const int row0 = (task / 6) * 16, c = (task % 6) * 512 + lane * 8;
        float cw[3][8];
#pragma unroll
        for (int j = 0; j < 3; ++j) { const f32x4 a = *(const GAS f32x4*)(convw + j * MIXW + c), b = *(const GAS f32x4*)(convw + j * MIXW + c + 4);
            cw[j][0] = a[0]; cw[j][1] = a[1]; cw[j][2] = a[2]; cw[j][3] = a[3]; cw[j][4] = b[0]; cw[j][5] = b[1]; cw[j][6] = b[2]; cw[j][7] = b[3]; }
        float u2[8], u1[8];
#pragma unroll
        for (int e = 0; e < 8; ++e) { u2[e] = 0.f; u1[e] = 0.f; }
        if ((row0 % SEQ) != 0) {
#pragma unroll
            for (int hrow = 0; hrow < 2; ++hrow) { const bf16* pr = proj + (size_t)(row0 - 2 + hrow) * SC_IN + c;
                const v4u cv = __builtin_nontemporal_load((const GAS v4u*)(pr + MIXW)), hv = __builtin_nontemporal_load((const GAS v4u*)(pr + 2 * MIXW));
#pragma unroll
                for (int q = 0; q < 4; ++q) { const float a = bflo(cv[q]) * bflo(hv[q]), b = bfhi(cv[q]) * bfhi(hv[q]);
                    if (hrow == 0) { u2[2 * q] = a; u2[2 * q + 1] = b; } else { u1[2 * q] = a; u1[2 * q + 1] = b; } } }
        }
#pragma unroll 4
        for (int r = 0; r < 16; ++r) { const bf16* pr = proj + (size_t)(row0 + r) * SC_IN + c;
            const v4u bv = __builtin_nontemporal_load((const GAS v4u*)(pr)), cv = __builtin_nontemporal_load((const GAS v4u*)(pr + MIXW)), hv = __builtin_nontemporal_load((const GAS v4u*)(pr + 2 * MIXW));
            float u0[8], y[8];
#pragma unroll
            for (int q = 0; q < 4; ++q) { u0[2 * q] = bflo(cv[q]) * bflo(hv[q]); u0[2 * q + 1] = bfhi(cv[q]) * bfhi(hv[q]); }
#pragma unroll
            for (int q = 0; q < 4; ++q) {
                y[2 * q] = bflo(bv[q]) * (cw[0][2 * q] * u2[2 * q] + cw[1][2 * q] * u1[2 * q] + cw[2][2 * q] * u0[2 * q]);
                y[2 * q + 1] = bfhi(bv[q]) * (cw[0][2 * q + 1] * u2[2 * q + 1] + cw[1][2 * q + 1] * u1[2 * q + 1] + cw[2][2 * q + 1] * u0[2 * q + 1]); }
            v4u o; o.x = pk2(y[0], y[1]); o.y = pk2(y[2], y[3]); o.z = pk2(y[4], y[5]); o.w = pk2(y[6], y[7]);
            *(GAS v4u*)(cat + (size_t)(row0 + r) * DM + c) = o;
#pragma unroll
            for (int e = 0; e < 8; ++e) { u2[e] = u1[e]; u1[e] = u0[e]; } }
    }
}

__device__ __forceinline__ void gdn_prep_phase(int gw, int NGW, int lane, const bf16* proj, const float* convw, bf16* qkvn, const float* aux, const float* alog, const float* dtb, float* ab) {
    for (int task = gw; task < (MROWS / 16) * 18; task += NGW) {
        const int row0 = (task / 18) * 16, slot = (task % 18) * 4 + (lane >> 4), type = slot / GH, ch = slot * GHD + (lane & 15) * 8;
        float cw[4][8];
#pragma unroll
        for (int j = 0; j < 4; ++j) { const f32x4 a = *(const GAS f32x4*)(convw + j * (3 * MIXW) + ch), b = *(const GAS f32x4*)(convw + j * (3 * MIXW) + ch + 4);
            cw[j][0] = a[0]; cw[j][1] = a[1]; cw[j][2] = a[2]; cw[j][3] = a[3]; cw[j][4] = b[0]; cw[j][5] = b[1]; cw[j][6] = b[2]; cw[j][7] = b[3]; }
        float w0[8], w1[8], w2[8];
#pragma unroll
        for (int e = 0; e < 8; ++e) { w0[e] = 0.f; w1[e] = 0.f; w2[e] = 0.f; }
        if ((row0 % SEQ) != 0) {
#pragma unroll
            for (int hrow = 0; hrow < 3; ++hrow) { const v4u xv = __builtin_nontemporal_load((const GAS v4u*)(proj + (size_t)(row0 - 3 + hrow) * GDN_LD + ch));
#pragma unroll
                for (int q = 0; q < 4; ++q) { const float a = bflo(xv[q]), b = bfhi(xv[q]);
                    if (hrow == 0) { w0[2 * q] = a; w0[2 * q + 1] = b; } else if (hrow == 1) { w1[2 * q] = a; w1[2 * q + 1] = b; } else { w2[2 * q] = a; w2[2 * q + 1] = b; } } }
        }
        const float post = (type == 0) ? 0.08838834764831845f : 1.0f;
#pragma unroll 4
        for (int r = 0; r < 16; ++r) { const v4u xv = __builtin_nontemporal_load((const GAS v4u*)(proj + (size_t)(row0 + r) * GDN_LD + ch));
            float x[8], y[8]; float ss = 0.f;
#pragma unroll
            for (int q = 0; q < 4; ++q) { x[2 * q] = bflo(xv[q]); x[2 * q + 1] = bfhi(xv[q]); }
#pragma unroll
            for (int e = 0; e < 8; ++e) { const float v = cw[0][e] * w0[e] + cw[1][e] * w1[e] + cw[2][e] * w2[e] + cw[3][e] * x[e]; y[e] = silu_f(v); ss += y[e] * y[e]; }
            if (type < 2) { ss = grp16_sum(ss); const float sc = post / sqrtf(ss + EPS);
#pragma unroll
                for (int e = 0; e < 8; ++e) y[e] *= sc; }
            v4u o; o.x = pk2(y[0], y[1]); o.y = pk2(y[2], y[3]); o.z = pk2(y[4], y[5]); o.w = pk2(y[6], y[7]);
            *(GAS v4u*)(qkvn + (size_t)(row0 + r) * (3 * MIXW) + ch) = o;
#pragma unroll
            for (int e = 0; e < 8; ++e) { w0[e] = w1[e]; w1[e] = w2[e]; w2[e] = x[e]; } }
    }
    for (int idx = gw * 64 + lane; idx < MROWS * GH; idx += NGW * 64) { const int row = idx / GH, h = idx % GH;
        const float bi = aux[(size_t)row * 64 + h], ai = aux[(size_t)row * 64 + GH + h] + dtb[h];
        const float sp = ai > 20.f ? ai : log1pf(expf(ai));
        ab[(size_t)row * 48 + h] = 1.0f / (1.0f + expf(-bi));
        ab[(size_t)row * 48 + GH + h] = -expf(alog[h]) * sp; }
}

constexpr int NCHUNK = SEQ / 64;
constexpr int CHB_WC = 0, CHB_QD = 16384, CHB_IN = 32768, CHB_KT = 40960, CHB_BYTES = 57344;
constexpr int P2_PITCH = 272;
constexpr int P2_GC = 0, P2_BETA = 256, P2_EG = 512, P2_Q = 768, P2_K = P2_Q + 64 * P2_PITCH, P2_V = P2_K + 64 * P2_PITCH, P2_A = P2_V + 64 * P2_PITCH, P2_HALF = P2_A + 16384;
__device__ __forceinline__ int kperm_pos(int col) { const int o = col & 31; return (col & ~31) + 8 * ((o & 15) >> 2) + (o & 3) + ((o >> 4) << 2); }
__device__ __forceinline__ unsigned short bf1(float x) { return (unsigned short)(pk2(x, 0.f) & 0xffffu); }
__device__ __forceinline__ float ldbf(const LAS unsigned char* p) { return __uint_as_float((unsigned)(*(const LAS unsigned short*)p) << 16); }

__device__ __forceinline__ void gdn_chunk_phase(int c, int G, int tid, LAS unsigned char* ldsb, const bf16* proj, const float* convw, const float* aux, const float* alog, const float* dtb, unsigned char* chb, float* utb, float* cdb) {
    const int half = __builtin_amdgcn_readfirstlane(tid >> 8), w4 = __builtin_amdgcn_readfirstlane((tid >> 6) & 3);
    const int role = half ? (w4 - 2) : w4;
    const int ew = half ? w4 : (w4 - 2);
    const int npair = (NBATCH * GH * NCHUNK) / 2;
    for (int pr = c; pr < npair; pr += G) {
        const int ci = pr * 2 + half;
        const int n = ci % NCHUNK, bh = ci / NCHUNK, h = bh % GH, b = bh / GH;
        const size_t row0 = (size_t)b * SEQ + (size_t)n * 64;
        unsigned char* blob = chb + (size_t)ci * CHB_BYTES;
#define P2_FRESH() unsigned lbv = (unsigned)(size_t)(ldsb + half * P2_HALF), afv = lbv + P2_A; asm volatile("" : "+v"(lbv)); asm volatile("" : "+v"(afv)); \
        LAS unsigned char* lb = (LAS unsigned char*)(size_t)lbv; LAS float* Af = (LAS float*)(size_t)afv; LAS float* gcs = (LAS float*)(lb + P2_GC); LAS float* bts = (LAS float*)(lb + P2_BETA); LAS float* egs = (LAS float*)(lb + P2_EG); \
        const int t = opq_v(tid) & 255, lane = t & 63; (void)Af; (void)gcs; (void)bts; (void)egs; (void)lane
        { P2_FRESH();
          const int cg = t & 15, rg = t >> 4;
#pragma unroll
          for (int ty = 0; ty < 3; ++ty) {
              const int ch = ty * MIXW + h * GHD + cg * 8;
              float cw[4][8];
#pragma unroll
              for (int j = 0; j < 4; ++j) { const f32x4 a = *(const GAS f32x4*)(convw + j * (3 * MIXW) + ch), b4 = *(const GAS f32x4*)(convw + j * (3 * MIXW) + ch + 4);
                  cw[j][0] = a[0]; cw[j][1] = a[1]; cw[j][2] = a[2]; cw[j][3] = a[3]; cw[j][4] = b4[0]; cw[j][5] = b4[1]; cw[j][6] = b4[2]; cw[j][7] = b4[3]; }
              v4u xr[7];
#pragma unroll
              for (int rr = 0; rr < 7; ++rr) { const int lr = 4 * rg - 3 + rr;
                  xr[rr] = (lr < 0 && n == 0) ? (v4u){0u, 0u, 0u, 0u} : *(const GAS v4u*)(proj + (size_t)((long)row0 + lr) * GDN_LD + ch); }
              const float post = (ty == 0) ? 0.08838834764831845f : 1.0f;
#pragma unroll
              for (int r = 0; r < 4; ++r) { float y[8]; float ss = 0.f;
#pragma unroll
                  for (int q = 0; q < 4; ++q) {
                      const float v0 = cw[0][2 * q] * bflo(xr[r][q]) + cw[1][2 * q] * bflo(xr[r + 1][q]) + cw[2][2 * q] * bflo(xr[r + 2][q]) + cw[3][2 * q] * bflo(xr[r + 3][q]);
                      const float v1 = cw[0][2 * q + 1] * bfhi(xr[r][q]) + cw[1][2 * q + 1] * bfhi(xr[r + 1][q]) + cw[2][2 * q + 1] * bfhi(xr[r + 2][q]) + cw[3][2 * q + 1] * bfhi(xr[r + 3][q]);
                      y[2 * q] = silu_f(v0); y[2 * q + 1] = silu_f(v1); ss += y[2 * q] * y[2 * q] + y[2 * q + 1] * y[2 * q + 1]; }
                  if (ty < 2) { ss = grp16_sum(ss); const float sc = post / sqrtf(ss + EPS);
#pragma unroll
                      for (int e = 0; e < 8; ++e) y[e] *= sc; }
                  v4u o; o.x = pk2(y[0], y[1]); o.y = pk2(y[2], y[3]); o.z = pk2(y[4], y[5]); o.w = pk2(y[6], y[7]);
                  *(LAS v4u*)(lb + P2_Q + ty * (64 * P2_PITCH) + (4 * rg + r) * P2_PITCH + cg * 16) = o; }
          }
        if (w4 == 0) { const float bi = aux[(row0 + lane) * 64 + h], ai = aux[(row0 + lane) * 64 + GH + h] + dtb[h];
            const float sp = ai > 20.f ? ai : log1pf(expf(ai));
            float g = -expf(alog[h]) * sp; const float be = 1.0f / (1.0f + expf(-bi));
#pragma unroll
            for (int o = 1; o < 64; o <<= 1) { const float y = __shfl_up(g, o); if (lane >= o) g += y; }
            gcs[lane] = g; bts[lane] = be; egs[lane] = __expf(g); }
        }
        __syncthreads();
        { P2_FRESH();
            const int i15 = lane & 15, q4 = lane >> 4;
            bf16x8 kA[4], qA[4];
#pragma unroll
            for (int s = 0; s < 4; ++s) { kA[s] = *(const LAS bf16x8*)(lb + P2_K + (16 * w4 + i15) * P2_PITCH + (32 * s + 8 * q4) * 2);
                                          qA[s] = *(const LAS bf16x8*)(lb + P2_Q + (16 * w4 + i15) * P2_PITCH + (32 * s + 8 * q4) * 2); }
            bf16* In = (bf16*)(blob + CHB_IN);
#pragma unroll
            for (int nb = 0; nb < 4; ++nb) {
                const int jg = 16 * nb + i15;
                if (nb <= w4) {
                    f32x4 akk = {0.f, 0.f, 0.f, 0.f}, aqk = {0.f, 0.f, 0.f, 0.f};
#pragma unroll
                    for (int s = 0; s < 4; ++s) { const bf16x8 kB = *(const LAS bf16x8*)(lb + P2_K + (16 * nb + i15) * P2_PITCH + (32 * s + 8 * q4) * 2);
                        akk = __builtin_amdgcn_mfma_f32_16x16x32_bf16(kA[s], kB, akk, 0, 0, 0); aqk = __builtin_amdgcn_mfma_f32_16x16x32_bf16(qA[s], kB, aqk, 0, 0, 0); }
                    const float gj = gcs[jg];
#pragma unroll
                    for (int r = 0; r < 4; ++r) { const int ig = 16 * w4 + 4 * q4 + r;
                        const float dec = (ig >= jg) ? __expf(gcs[ig] - gj) : 0.f;
                        Af[ig * 64 + jg] = (ig > jg) ? bts[ig] * akk[r] * dec : 0.f;
                        *(GAS unsigned short*)(In + ig * 64 + kperm_pos(jg)) = bf1(aqk[r] * dec); }
                } else {
#pragma unroll
                    for (int r = 0; r < 4; ++r) { const int ig = 16 * w4 + 4 * q4 + r; *(GAS unsigned short*)(In + ig * 64 + kperm_pos(jg)) = 0; }
                }
            }
        }
        __syncthreads();
        if (role == 0 || role == 1) { P2_FRESH();
            f32x2 x[64];
            const LAS unsigned char* tp = lb + (role ? P2_K : P2_V) + lane * 2;
#pragma unroll
            for (int g8 = 0; g8 < 8; ++g8) {
#pragma unroll
                for (int ii = 0; ii < 8; ++ii) { const int i = 8 * g8 + ii; const float e = egs[i], sc = bts[i] * (role ? e : 1.0f);
                    x[i] = (f32x2){ldbf(tp + i * P2_PITCH) * sc, ldbf(tp + i * P2_PITCH + 128) * sc}; asm volatile("" : "+v"(x[i])); }
                __builtin_amdgcn_sched_barrier(0);
            }
            f32x4 cur[4], nxt[4];
            cur[0] = *(const LAS f32x4*)(Af + 64);
#define P2_ROWS(NSEG, ILO, IHI) \
            _Pragma("unroll") for (int i = (ILO); i <= (IHI); ++i) { \
                f32x2 a0 = x[i], a1 = {0.f, 0.f}; \
                _Pragma("unroll") for (int sg = 0; sg < (NSEG); ++sg) { \
                    const bool more = (sg + 1 < (NSEG)); const int ni = more ? i : i + 1, nsg = more ? sg + 1 : 0; \
                    if (ni < 64) { _Pragma("unroll") for (int q = 0; q < 4; ++q) if (16 * nsg + 4 * q < ni) nxt[q] = *(const LAS f32x4*)(Af + ni * 64 + 16 * nsg + 4 * q); } \
                    __builtin_amdgcn_sched_barrier(0); \
                    _Pragma("unroll") for (int jj = 0; jj < (more ? 16 : i - 16 * sg); ++jj) { const int j = 16 * sg + jj; const float aij = cur[jj >> 2][jj & 3]; if (j & 1) a1 -= x[j] * aij; else a0 -= x[j] * aij; } \
                    __builtin_amdgcn_sched_barrier(0); \
                    _Pragma("unroll") for (int q = 0; q < 4; ++q) cur[q] = nxt[q]; \
                } \
                x[i] = a0 + a1; \
            }
            P2_ROWS(1, 1, 16)
            P2_ROWS(2, 17, 32)
            P2_ROWS(3, 33, 48)
            P2_ROWS(4, 49, 63)
#undef P2_ROWS
            if (role == 0) { float* up = utb + (size_t)ci * 8192 + lane * 64;
#pragma unroll
                for (int i = 0; i < 16; ++i) { *(GAS f32x4*)(up + 4 * i) = (f32x4){x[4 * i][0], x[4 * i + 1][0], x[4 * i + 2][0], x[4 * i + 3][0]};
                                               *(GAS f32x4*)(up + 4096 + 4 * i) = (f32x4){x[4 * i][1], x[4 * i + 1][1], x[4 * i + 2][1], x[4 * i + 3][1]}; } }
            else { bf16* wp = (bf16*)(blob + CHB_WC) + kperm_pos(lane);
#pragma unroll
                for (int i = 0; i < 64; ++i) { *(GAS unsigned short*)(wp + i * 128) = bf1(x[i][0]); *(GAS unsigned short*)(wp + i * 128 + 64) = bf1(x[i][1]); } }
        } else { P2_FRESH();
            const int t2 = ew * 64 + lane;
#pragma unroll
            for (int ps = 0; ps < 2; ++ps) { const int tt = t2 + 128 * ps; const int i = tt >> 2, cseg = (tt & 3) * 32; const float e = egs[i];
                v4u sv[4];
#pragma unroll
                for (int q = 0; q < 4; ++q) { const v4u xv = *(const LAS v4u*)(lb + P2_Q + i * P2_PITCH + (cseg + 8 * q) * 2);
                    sv[q].x = pk2(bflo(xv.x) * e, bfhi(xv.x) * e); sv[q].y = pk2(bflo(xv.y) * e, bfhi(xv.y) * e); sv[q].z = pk2(bflo(xv.z) * e, bfhi(xv.z) * e); sv[q].w = pk2(bflo(xv.w) * e, bfhi(xv.w) * e); }
#pragma unroll
                for (int q = 0; q < 4; ++q) { const v4u lo = sv[q >> 1], hi = sv[2 + (q >> 1)];
                    v4u o; o.x = (q & 1) ? lo.z : lo.x; o.y = (q & 1) ? lo.w : lo.y; o.z = (q & 1) ? hi.z : hi.x; o.w = (q & 1) ? hi.w : hi.y;
                    *(GAS v4u*)(blob + CHB_QD + (i * 128 + cseg + 8 * q) * 2) = o; } }
            const float gl = gcs[63];
#pragma unroll
            for (int ps = 0; ps < 2; ++ps) { const int d = t2, hh = ps; float y[32];
#pragma unroll
                for (int jj = 0; jj < 32; ++jj) { const int i = 32 * hh + jj; y[jj] = ldbf(lb + P2_K + i * P2_PITCH + d * 2) * __expf(gl - gcs[i]); }
#pragma unroll
                for (int q = 0; q < 4; ++q) { v4u o; o.x = pk2(y[4 * q], y[4 * q + 1]); o.y = pk2(y[4 * q + 2], y[4 * q + 3]); o.z = pk2(y[16 + 4 * q], y[16 + 4 * q + 1]); o.w = pk2(y[16 + 4 * q + 2], y[16 + 4 * q + 3]);
                    *(GAS v4u*)(blob + CHB_KT + (d * 64 + 32 * hh + 8 * q) * 2) = o; } }
            if (t2 == 0) cdb[ci] = __expf(gl);
        }
        __syncthreads();
    }
#undef P2_FRESH
}

constexpr int S2_WC = 0, S2_QD = 18432, S2_IN = 36864, S2_KT = 47104, S2_BUF = 67584;
__device__ __forceinline__ bf16x8 s2_frag(const LAS unsigned char* p) { return *(const LAS bf16x8*)p; }
__device__ __forceinline__ bf16x8 s2_pack(const f32x4& a, const f32x4& b) { v4u w; w.x = pk2(a[0], a[1]); w.y = pk2(a[2], a[3]); w.z = pk2(b[0], b[1]); w.w = pk2(b[2], b[3]); return __builtin_bit_cast(bf16x8, w); }
__device__ __forceinline__ void gdn_scan2_unit(int bh, LAS unsigned char* ldsb, const unsigned char* chb, const float* utb, const float* cdb, float* O, int tid, int wave, int lane) {
    const int b = bh / GH, h = bh % GH, i15 = lane & 15, q4 = lane >> 4, n0 = wave * 16;
    const size_t ci0 = (size_t)bh * NCHUNK;
    f32x4 S[8];
#pragma unroll
    for (int kb = 0; kb < 8; ++kb) S[kb] = (f32x4){0.f, 0.f, 0.f, 0.f};
    v4u r[7]; f32x4 utn[4], ocp[4];
#define S2_STORE_O(cc_) do { float* op_ = O + ((size_t)b * SEQ + (size_t)(cc_) * 64 + 4 * q4) * MIXW + h * GHD + n0 + i15; \
        _Pragma("unroll") for (int mb = 0; mb < 4; ++mb) _Pragma("unroll") for (int j = 0; j < 4; ++j) op_[(size_t)(16 * mb + j) * MIXW] = ocp[mb][j]; } while (0)
#define S2_ISSUE(cc_) do { const unsigned char* bp_ = chb + (ci0 + (cc_)) * CHB_BYTES + tid * 16; \
        _Pragma("unroll") for (int e = 0; e < 7; ++e) r[e] = __builtin_nontemporal_load((const GAS v4u*)(bp_ + e * 8192)); \
        const float* up_ = utb + (ci0 + (cc_)) * 8192 + (n0 + i15) * 64 + 4 * q4; \
        _Pragma("unroll") for (int mb = 0; mb < 4; ++mb) utn[mb] = __builtin_nontemporal_load((const GAS f32x4*)(up_ + 16 * mb)); } while (0)
    S2_ISSUE(0);
#if defined(TPROBE) && TPROBE >= 11 && TPROBE <= 13
    volatile LAS unsigned* MISCp = (volatile LAS unsigned*)(ldsb - RING_OFF + MISC_OFF); const bool prb = (bh == 0 && tid == 0);
#define S2_T0() unsigned long long pt0_ = prb ? __builtin_amdgcn_s_memrealtime() : 0ull
#define S2_T1(k) do { if ((k) == TPROBE && prb) { const unsigned long long d_ = __builtin_amdgcn_s_memrealtime() - pt0_; const unsigned long long a_ = ((((unsigned long long)MISCp[19] << 32) | MISCp[18])) + d_; MISCp[18] = (unsigned)a_; MISCp[19] = (unsigned)(a_ >> 32); } } while (0)
#else
#define S2_T0() do {} while (0)
#define S2_T1(k) do {} while (0)
#endif
    for (int cc = 0; cc < NCHUNK; ++cc) {
        LAS unsigned char* buf = ldsb + (cc & 1) * S2_BUF;
        { S2_T0(); asm volatile("s_waitcnt vmcnt(0)" ::: "memory"); S2_T1(11); }
        *(LAS v4u*)(buf + S2_WC + (tid >> 4) * 288 + (tid & 15) * 16) = r[0];
        *(LAS v4u*)(buf + S2_WC + ((tid + 512) >> 4) * 288 + (tid & 15) * 16) = r[1];
        *(LAS v4u*)(buf + S2_QD + (tid >> 4) * 288 + (tid & 15) * 16) = r[2];
        *(LAS v4u*)(buf + S2_QD + ((tid + 512) >> 4) * 288 + (tid & 15) * 16) = r[3];
        *(LAS v4u*)(buf + S2_IN + (tid >> 3) * 160 + (tid & 7) * 16) = r[4];
        *(LAS v4u*)(buf + S2_KT + (tid >> 3) * 160 + (tid & 7) * 16) = r[5];
        *(LAS v4u*)(buf + S2_KT + ((tid + 512) >> 3) * 160 + (tid & 7) * 16) = r[6];
        f32x4 ut[4];
#pragma unroll
        for (int mb = 0; mb < 4; ++mb) ut[mb] = utn[mb];
        const float cd = cdb[ci0 + cc];
        { S2_T0(); __syncthreads(); S2_T1(12); }
        S2_T0();
        if (cc > 0) S2_STORE_O(cc - 1);
        if (cc + 1 < NCHUNK) S2_ISSUE(cc + 1);
        bf16x8 sb[4];
#pragma unroll
        for (int s = 0; s < 4; ++s) sb[s] = s2_pack(S[2 * s], S[2 * s + 1]);
#define S2_LD4x2(dst, base, pitch, s0) do { _Pragma("unroll") for (int e_ = 0; e_ < 8; ++e_) dst[e_] = s2_frag(buf + (base) + (16 * (e_ & 3) + i15) * (pitch) + (32 * ((s0) + (e_ >> 2)) + 8 * q4) * 2); } while (0)
#define S2_LD8x1(dst, base, pitch, s0) do { _Pragma("unroll") for (int e_ = 0; e_ < 8; ++e_) dst[e_] = s2_frag(buf + (base) + (16 * e_ + i15) * (pitch) + (32 * (s0) + 8 * q4) * 2); } while (0)
#define S2_SB() __builtin_amdgcn_sched_barrier(0)
        bf16x8 fa[8], fb[8];
        f32x4 vn[4], oc[4];
#pragma unroll
        for (int mb = 0; mb < 4; ++mb) { vn[mb] = (f32x4){0.f, 0.f, 0.f, 0.f}; oc[mb] = (f32x4){0.f, 0.f, 0.f, 0.f}; }
        S2_LD4x2(fa, S2_WC, 288, 0); S2_LD4x2(fb, S2_WC, 288, 2); S2_SB();
#pragma unroll
        for (int e = 0; e < 8; ++e) vn[e & 3] = __builtin_amdgcn_mfma_f32_16x16x32_bf16(fa[e], sb[e >> 2], vn[e & 3], 0, 0, 0);
        S2_SB(); S2_LD4x2(fa, S2_QD, 288, 0); S2_SB();
#pragma unroll
        for (int e = 0; e < 8; ++e) vn[e & 3] = __builtin_amdgcn_mfma_f32_16x16x32_bf16(fb[e], sb[2 + (e >> 2)], vn[e & 3], 0, 0, 0);
        S2_SB(); S2_LD4x2(fb, S2_QD, 288, 2); S2_SB();
#pragma unroll
        for (int e = 0; e < 8; ++e) oc[e & 3] = __builtin_amdgcn_mfma_f32_16x16x32_bf16(fa[e], sb[e >> 2], oc[e & 3], 0, 0, 0);
        S2_SB(); S2_LD4x2(fa, S2_IN, 160, 0); S2_SB();
#pragma unroll
        for (int mb = 0; mb < 4; ++mb) vn[mb] = ut[mb] - vn[mb];
        bf16x8 vb[2];
        vb[0] = s2_pack(vn[0], vn[1]); vb[1] = s2_pack(vn[2], vn[3]);
#pragma unroll
        for (int e = 0; e < 8; ++e) oc[e & 3] = __builtin_amdgcn_mfma_f32_16x16x32_bf16(fb[e], sb[2 + (e >> 2)], oc[e & 3], 0, 0, 0);
        S2_SB(); S2_LD8x1(fb, S2_KT, 160, 0); S2_SB();
#pragma unroll
        for (int e = 0; e < 8; ++e) oc[e & 3] = __builtin_amdgcn_mfma_f32_16x16x32_bf16(fa[e], vb[e >> 2], oc[e & 3], 0, 0, 0);
        S2_SB(); S2_LD8x1(fa, S2_KT, 160, 1); S2_SB();
#pragma unroll
        for (int kb = 0; kb < 8; ++kb) S[kb] = __builtin_amdgcn_mfma_f32_16x16x32_bf16(fb[kb], vb[0], S[kb] * cd, 0, 0, 0);
        S2_SB();
#pragma unroll
        for (int mb = 0; mb < 4; ++mb) ocp[mb] = oc[mb];
        asm volatile("" :: "v"(S[0]), "v"(S[7]), "v"(ocp[3])); S2_T1(13);
#pragma unroll
        for (int kb = 0; kb < 8; ++kb) S[kb] = __builtin_amdgcn_mfma_f32_16x16x32_bf16(fa[kb], vb[1], S[kb], 0, 0, 0);
#undef S2_LD4x2
#undef S2_LD8x1
#undef S2_SB
    }
    S2_STORE_O(NCHUNK - 1);
    __syncthreads();
#undef S2_STORE_O
#undef S2_ISSUE
}

__device__ __forceinline__ void gdn_out_phase(int gw, int NGW, int lane, const float* O, const bf16* proj, const float* normg, bf16* cat) {
    const int dl = (lane & 15) * 8;
    const f32x4 g0 = *(const GAS f32x4*)(normg + dl), g1 = *(const GAS f32x4*)(normg + dl + 4);
    for (int row = gw; row < MROWS; row += NGW) {
#pragma unroll 2
        for (int it = 0; it < 6; ++it) { const int ch = (it * 4 + (lane >> 4)) * GHD + dl;
            const f32x4 o0 = __builtin_nontemporal_load((const GAS f32x4*)(O + (size_t)row * MIXW + ch)), o1 = __builtin_nontemporal_load((const GAS f32x4*)(O + (size_t)row * MIXW + ch + 4));
            const v4u zv = __builtin_nontemporal_load((const GAS v4u*)(proj + (size_t)row * GDN_LD + 3 * MIXW + ch));
            float ss = (o0[0] * o0[0] + o0[1] * o0[1]) + (o0[2] * o0[2] + o0[3] * o0[3]) + (o1[0] * o1[0] + o1[1] * o1[1]) + (o1[2] * o1[2] + o1[3] * o1[3]);
            ss = grp16_sum(ss);
            const float r = 1.0f / sqrtf(ss * (1.0f / GHD) + EPS);
            float y[8];
            y[0] = o0[0] * r * g0[0] * silu_f(bflo(zv[0])); y[1] = o0[1] * r * g0[1] * silu_f(bfhi(zv[0])); y[2] = o0[2] * r * g0[2] * silu_f(bflo(zv[1])); y[3] = o0[3] * r * g0[3] * silu_f(bfhi(zv[1]));
            y[4] = o1[0] * r * g1[0] * silu_f(bflo(zv[2])); y[5] = o1[1] * r * g1[1] * silu_f(bfhi(zv[2])); y[6] = o1[2] * r * g1[2] * silu_f(bflo(zv[3])); y[7] = o1[3] * r * g1[3] * silu_f(bfhi(zv[3]));
            v4u w; w.x = pk2(y[0], y[1]); w.y = pk2(y[2], y[3]); w.z = pk2(y[4], y[5]); w.w = pk2(y[6], y[7]);
            *(GAS v4u*)(cat + (size_t)row * DM + ch) = w; }
    }
}

typedef unsigned char* const __attribute__((address_space(4)))* karg_tab_t;
__device__ __forceinline__ unsigned char* karg_ptr(int i) { asm volatile("" : "+s"(i)); return ((karg_tab_t)__builtin_amdgcn_kernarg_segment_ptr())[i]; }
#define INP(i) ((const float*)karg_ptr(i))
#define WSP(off) (karg_ptr(20) + (off))

__global__ void __launch_bounds__(NWAVES * 64, 2) fwd_kernel(Args args) {
    extern __shared__ __attribute__((aligned(16))) unsigned char lds[];
    LAS unsigned char* L = (LAS unsigned char*)lds;
    volatile LAS unsigned* MISC = (volatile LAS unsigned*)(L + MISC_OFF);
    const int tid0 = threadIdx.x;
    const int G = gridDim.x, c = blockIdx.x;
#define tid (opq_v(tid0))
#define lane (opq_v(tid0) & 63)
#define wave (__builtin_amdgcn_readfirstlane(opq_v(tid0) >> 6))
#define gw (opq_s(c) * NWAVES + __builtin_amdgcn_readfirstlane(opq_v(tid0) >> 6))
#define NGW (opq_s(G) * NWAVES)
    for (int u = tid0; u < (LDS_BYTES - LDSCTL_OFF) / 4; u += NWAVES * 64) ((LAS unsigned*)(L + LDSCTL_OFF))[u] = 0u;
    __syncthreads();
    (void)xcd_barrier_post((unsigned*)(WSP(WS_CTL)) + CW_BAR, MISC + 8);
#define GRID_BAR() do { XcdBarrier bar_; bar_.bar = (unsigned*)(WSP(WS_CTL)) + CW_BAR; bar_.x = xb_xcc_id(); bar_.st = MISC + 8; xcd_barrier(bar_); } while (0)
#if defined(TPROBE) && TPROBE == 8
#define TP_BEGIN(k) do { if ((k) == 3 && c == 0 && tid0 == 0) { const unsigned long long t_ = __builtin_amdgcn_s_memrealtime(), y_ = __builtin_amdgcn_s_memtime(); MISC[16] = (unsigned)t_; MISC[17] = (unsigned)(t_ >> 32); MISC[20] = (unsigned)y_; MISC[21] = (unsigned)(y_ >> 32); } } while (0)
#define TP_END(k) do { if ((k) == 3 && c == 0 && tid0 == 0) { const unsigned long long t_ = __builtin_amdgcn_s_memrealtime() - (((unsigned long long)MISC[17] << 32) | MISC[16]), y_ = __builtin_amdgcn_s_memtime() - (((unsigned long long)MISC[21] << 32) | MISC[20]); \
        const unsigned long long a_ = ((((unsigned long long)MISC[19] << 32) | MISC[18])) + t_, b_ = ((((unsigned long long)MISC[23] << 32) | MISC[22])) + y_; MISC[18] = (unsigned)a_; MISC[19] = (unsigned)(a_ >> 32); MISC[22] = (unsigned)b_; MISC[23] = (unsigned)(b_ >> 32); } } while (0)
#elif defined(TPROBE)
#define TP_BEGIN(k) do { if ((k) == TPROBE && c == 0 && tid0 == 0) { const unsigned long long t_ = __builtin_amdgcn_s_memrealtime(); MISC[16] = (unsigned)t_; MISC[17] = (unsigned)(t_ >> 32); } } while (0)
#define TP_END(k) do { if ((k) == TPROBE && c == 0 && tid0 == 0) { const unsigned long long t_ = __builtin_amdgcn_s_memrealtime() - (((unsigned long long)MISC[17] << 32) | MISC[16]); \
        const unsigned long long a_ = ((((unsigned long long)MISC[19] << 32) | MISC[18])) + t_; MISC[18] = (unsigned)a_; MISC[19] = (unsigned)(a_ >> 32); } } while (0)
#else
#define TP_BEGIN(k) do {} while (0)
#define TP_END(k) do {} while (0)
#endif
#ifdef NO_P0
#define PH_P0(x)
#else
#define PH_P0(x) x
#endif
#ifdef NO_KV
#define PH_KV(x)
#else
#define PH_KV(x) x
#endif
#ifdef NO_GU
#define PH_GU(x)
#else
#define PH_GU(x) x
#endif
#ifdef NO_DN
#define PH_DN(x)
#else
#define PH_DN(x) x
#endif
#ifdef NO_NORM
#define PH_NORM(x)
#else
#define PH_NORM(x) x
#endif
#ifdef NO_SCIN
#define PH_SCIN(x)
#else
#define PH_SCIN(x) x
#endif
#ifdef NO_SCG
#define PH_SCG(x)
#else
#define PH_SCG(x) x
#endif
#ifdef NO_XA
#define PH_XA(x)
#else
#define PH_XA(x) x
#endif
#ifdef NO_GDNIN
#define PH_GDNIN(x)
#else
#define PH_GDNIN(x) x
#endif
#ifdef NO_PREP
#define PH_PREP(x)
#else
#define PH_PREP(x) x
#endif
#ifdef NO_GOUT
#define PH_GOUT(x)
#else
#define PH_GOUT(x) x
#endif
#ifdef NO_WOUT
#define PH_WOUT(x)
#else
#define PH_WOUT(x) x
#endif
#ifdef NO_SCAN
#define DO_SCAN(x)
#else
#define DO_SCAN(x) x
#endif

#define Hbuf ((bf16*)WSP(WS_H))
#define Abuf ((bf16*)WSP(WS_A))
#define OUTb ((bf16*)WSP(WS_OUT))
#define CAT ((bf16*)WSP(WS_CAT))
#define ACT ((bf16*)WSP(WS_ACT))
#define PROJ ((bf16*)WSP(WS_PROJ))
#define AUX ((float*)WSP(WS_AUX))
#define AB ((float*)WSP(WS_AB))
#define QKVN ((bf16*)WSP(WS_QKV))
#define OBUF ((float*)WSP(WS_O))
#define KVOPS ((bf16*)WSP(WS_KVOPS))
#define KB ((bf16*)WSP(WS_KB))
#define VTB ((bf16*)WSP(WS_VTB))
#define WGU ((bf16*)WSP(WS_WGU))
#define WDN ((bf16*)WSP(WS_WDN))
#define WOUT ((bf16*)WSP(WS_WOUT))
#define WSC ((bf16*)WSP(WS_WSC))
#define WGDN ((bf16*)WSP(WS_WGDN))
#define CHB ((unsigned char*)WSP(WS_CHB))
#define UTB ((float*)WSP(WS_UT))
#define CDB ((float*)WSP(WS_CD))

    TP_BEGIN(1);
#ifndef NO_P0
    {
        LAS float* scr = (LAS float*)(L + RING_OFF + wave * XP_SCR);
        long base = 0;
        for (int job = 0; job < 40; ++job) {
            const float* W; bf16* WT; int K, N, col0 = 0, ncols, nvalid, mode = 0, roff = 0;
            if (job < 8)       { W = INP(I_WG) + (size_t)job * DM * DFF; K = DM; N = DFF; ncols = DFF; WT = WGU + (size_t)job * 2 * DFF * DM; mode = 1; roff = 0; }
            else if (job < 16) { W = INP(I_WU) + (size_t)(job - 8) * DM * DFF; K = DM; N = DFF; ncols = DFF; WT = WGU + (size_t)(job - 8) * 2 * DFF * DM; mode = 1; roff = 128; }
            else if (job < 24) { W = INP(I_WD) + (size_t)(job - 16) * DFF * DM; K = DFF; N = DM; ncols = DM; WT = WDN + (size_t)(job - 16) * DM * DFF; }
            else if (job < 28) { W = INP(I_WOUT) + (size_t)(job - 24) * DM * DM; K = DM; N = DM; ncols = DM; WT = WOUT + (size_t)(job - 24) * DM * DM; }
            else if (job < 32) { W = INP(I_WKV) + (size_t)(job - 28) * DM * 2 * XW; K = DM; N = 2 * XW; ncols = 2 * XW; WT = KVOPS + ((size_t)(job - 28) * 3072 + 1024) * DM; }
            else if (job < 34) { W = INP(I_SCIN) + (size_t)(job - 32) * DM * SC_IN; K = DM; N = SC_IN; ncols = SC_IN; WT = WSC + (size_t)(job - 32) * SC_IN * DM; }
            else if (job < 36) { W = INP(I_GDNIN) + (size_t)(job - 34) * DM * GDN_SRC; K = DM; N = GDN_SRC; ncols = 4 * MIXW; WT = WGDN + (size_t)(job - 34) * GDN_N * DM; }
            else if (job < 38) { W = INP(I_GDNIN) + (size_t)(job - 36) * DM * GDN_SRC; K = DM; N = GDN_SRC; col0 = 4 * MIXW + 2 * GH; ncols = XW; WT = WGDN + (size_t)(job - 36) * GDN_N * DM; roff = 4 * MIXW; }
            else               { W = INP(I_GDNIN) + (size_t)(job - 38) * DM * GDN_SRC; K = DM; N = GDN_SRC; col0 = 4 * MIXW; ncols = 64; WT = WGDN + (size_t)(job - 38) * GDN_N * DM; roff = GDN_LD; }
            nvalid = (job >= 38) ? 2 * GH : ncols;
            const int nblk = ncols / 64, items = (K / 64) * nblk;
            int first = (int)(((long)gw - base) % NGW); if (first < 0) first += NGW;
            const int step = NGW;
#define XP_DROW(nb_) (mode ? (256 * ((nb_) >> 1) + 64 * ((nb_) & 1) + roff) : (64 * (nb_) + roff))
            if (first < items) {
                f32x4 va[16], vb[16];
                int it = first;
                xpose_load(va, W, N, col0, nvalid, 64 * (it / nblk), 64 * (it % nblk), lane);
                for (;;) {
                    const int it1 = it + step;
                    if (it1 < items) xpose_load(vb, W, N, col0, nvalid, 64 * (it1 / nblk), 64 * (it1 % nblk), lane);
                    xpose_store(va, WT, K, XP_DROW(it % nblk), scr, 64 * (it / nblk), lane);
                    if (it1 >= items) break;
                    const int it2 = it1 + step;
                    if (it2 < items) xpose_load(va, W, N, col0, nvalid, 64 * (it2 / nblk), 64 * (it2 % nblk), lane);
                    xpose_store(vb, WT, K, XP_DROW(it1 % nblk), scr, 64 * (it1 / nblk), lane);
                    if (it2 >= items) break;
                    it = it2;
                }
            }
#undef XP_DROW
            base += items;
        }
        for (int r = gw; r < 2 * 192; r += NGW) { bf16* p = WGDN + ((size_t)(r / 192) * GDN_N + GDN_LD + 64 + (r % 192)) * DM;
#pragma unroll
            for (int j = 0; j < 8; ++j) *(GAS v4u*)(p + (j * 64 + lane) * 8) = (v4u){0u, 0u, 0u, 0u}; }
        for (int r = gw; r < NBATCH * MEMT; r += NGW) { const float* mr = INP(I_MEM) + (size_t)r * DM;
            f32x4 v[16]; float ss = 0.f;
#pragma unroll
            for (int j = 0; j < 16; ++j) { v[j] = *(const GAS f32x4*)(mr + (j * 64 + lane) * 4); ss += (v[j][0] * v[j][0] + v[j][1] * v[j][1]) + (v[j][2] * v[j][2] + v[j][3] * v[j][3]); }
            ss = wave_sum(ss); const float sc = 1.0f / sqrtf(ss * (1.0f / DM) + EPS);
            for (int l = 0; l < DEPTH; ++l) { const float* g = INP(I_MEMG) + (size_t)l * DM; bf16* dst = KVOPS + ((size_t)l * 3072 + r) * DM;
#pragma unroll
                for (int j = 0; j < 16; ++j) { const f32x4 gg = *(const GAS f32x4*)(g + (j * 64 + lane) * 4); const f32x4 a = v[j] * gg * sc;
                    v2u o; o.x = pk2(a[0], a[1]); o.y = pk2(a[2], a[3]); *(GAS v2u*)(dst + (j * 64 + lane) * 4) = o; } } }
        norm_phase(gw, NGW, lane, nullptr, 0.f, nullptr, INP(I_X), false, Hbuf, true, INP(I_FPRE), Abuf);
    }
#endif
    GRID_BAR();
    TP_END(1);

#define FFN_GEMMS(f_) do { \
        TP_BEGIN(3); \
        { pg8::Gemm g{Abuf, WGU + (size_t)(l * 2 + (f_)) * 2 * DFF * DM, MROWS, 2 * DFF, DM}; pg8::StaticOrder S; S.init(MROWS, 2 * DFF, opq_s(G), opq_s(c)); pg8::EpiSwiGLU E{ACT, DFF}; \
          PH_GU((pg8::gemm_phase<pg8::EpiSwiGLU, pg8::StaticOrder, PG8_ALIGN, PG8_SP2>(L + RING_OFF, g, S, E))); } \
        GRID_BAR(); \
        { pg8::Gemm g{ACT, WDN + (size_t)(l * 2 + (f_)) * DM * DFF, MROWS, DM, DFF}; pg8::StaticOrder S; S.init(MROWS, DM, opq_s(G), opq_s(c)); pg8::EpiProj E{OUTb, DM, nullptr, -1}; \
          PH_DN((pg8::gemm_phase<pg8::EpiProj, pg8::StaticOrder, PG8_ALIGN, PG8_SP2>(L + RING_OFF, g, S, E))); } \
        GRID_BAR(); \
        TP_END(3); \
    } while (0)

    for (int l = 0; l < DEPTH; ++l) {
        const int j2 = l >> 1; const bool gdn = (l & 1) != 0;
        FFN_GEMMS(0);
        TP_BEGIN(6);
        { const int Gq = opq_s(G), cq = opq_s(c); const int nkv = (l == 0 && Gq > 64) ? 32 : 0;
          if (cq < nkv) { pg8::Gemm g{KVOPS, KVOPS, 4 * 3072, 4 * 3072, DM}; pg8::KvOrder S{nkv, cq, 0, 32}; pg8::EpiKV E{KB, VTB};
              PH_KV((pg8::gemm_phase<pg8::EpiKV, pg8::KvOrder, PG8_ALIGN, PG8_SP2>(L + RING_OFF, g, S, E))); }
          else { PH_NORM(norm_phase((cq - nkv) * NWAVES + wave, (Gq - nkv) * NWAVES, lane, OUTb, 0.5f, INP(I_FPOST) + (size_t)(l * 2) * DM, Hbuf, true, Hbuf, true, INP(I_MPRE) + (size_t)l * DM, Abuf);) }
          if (l == 0 && nkv == 0) { pg8::Gemm g{KVOPS, KVOPS, 4 * 3072, 4 * 3072, DM}; pg8::KvOrder S{Gq, cq, 0, 32}; pg8::EpiKV E{KB, VTB};
              PH_KV((pg8::gemm_phase<pg8::EpiKV, pg8::KvOrder, PG8_ALIGN, PG8_SP2>(L + RING_OFF, g, S, E))); } }
        GRID_BAR();
        TP_END(6);
        if (!gdn) {
            TP_BEGIN(3);
            { pg8::Gemm g{Abuf, WSC + (size_t)j2 * SC_IN * DM, MROWS, SC_IN, DM}; pg8::StaticOrder S; S.init(MROWS, SC_IN, opq_s(G), opq_s(c)); pg8::EpiProj E{PROJ, SC_IN, nullptr, -1};
              PH_SCIN((pg8::gemm_phase<pg8::EpiProj, pg8::StaticOrder, PG8_ALIGN, PG8_SP2>(L + RING_OFF, g, S, E))); }
            GRID_BAR();
            TP_END(3);
            TP_BEGIN(4);
            PH_SCG(sc_gate_phase(gw, NGW, lane, PROJ, INP(I_SCCONV) + (size_t)j2 * 3 * MIXW, CAT);)
            for (int u = opq_s(c); u < 256; u += opq_s(G)) { PH_XA(xattn_unit(u, L + RING_OFF, PROJ, SC_IN, 3 * MIXW, KB + (size_t)l * 1048576, VTB + (size_t)l * 1048576, CAT, tid, wave, lane);) }
            GRID_BAR();
            TP_END(4);
        } else {
            TP_BEGIN(3);
            { pg8::Gemm g{Abuf, WGDN + (size_t)j2 * GDN_N * DM, MROWS, GDN_N, DM}; pg8::StaticOrder S; S.init(MROWS, GDN_N, opq_s(G), opq_s(c)); pg8::EpiProj E{PROJ, GDN_LD, AUX, GDN_LD / 256};
              PH_GDNIN((pg8::gemm_phase<pg8::EpiProj, pg8::StaticOrder, PG8_ALIGN, PG8_SP2>(L + RING_OFF, g, S, E))); }
            if (l == 1) { const int Gq = opq_s(G), cq = opq_s(c); const int first = (Gq == 256) ? 160 : 0;
              pg8::Gemm g{KVOPS, KVOPS, 4 * 3072, 4 * 3072, DM}; pg8::KvOrder S{Gq - first, cq - first, 1, 96}; pg8::EpiKV E{KB, VTB};
              PH_KV((pg8::gemm_phase<pg8::EpiKV, pg8::KvOrder, PG8_ALIGN, PG8_SP2>(L + RING_OFF, g, S, E))); }
            GRID_BAR();
            TP_END(3);
            TP_BEGIN(2);
            DO_SCAN(gdn_chunk_phase(opq_s(c), opq_s(G), tid, L + RING_OFF, PROJ, INP(I_GDNCONV) + (size_t)j2 * 4 * 3 * MIXW, AUX, INP(I_ALOG) + j2 * GH, INP(I_DTB) + j2 * GH, CHB, UTB, CDB));
            GRID_BAR();
            TP_END(2);
            TP_BEGIN(7);
            {
                const int nscan = NBATCH * GH;
                const int cq = opq_s(c);
                if (opq_s(G) == 256) {
                    if (cq < nscan) { TP_BEGIN(9); DO_SCAN(gdn_scan2_unit(cq, L + RING_OFF, CHB, UTB, CDB, OBUF, tid, wave, lane)); TP_END(9); }
                    else for (int u = cq - nscan; u < 256; u += 256 - nscan) { PH_XA(xattn_unit(u, L + RING_OFF, PROJ, GDN_LD, 4 * MIXW, KB + (size_t)l * 1048576, VTB + (size_t)l * 1048576, CAT, tid, wave, lane);) }
                } else {
                    for (int u = opq_s(c); u < nscan; u += opq_s(G)) { DO_SCAN(gdn_scan2_unit(u, L + RING_OFF, CHB, UTB, CDB, OBUF, tid, wave, lane)); }
                    for (int u = opq_s(c); u < 256; u += opq_s(G)) { PH_XA(xattn_unit(u, L + RING_OFF, PROJ, GDN_LD, 4 * MIXW, KB + (size_t)l * 1048576, VTB + (size_t)l * 1048576, CAT, tid, wave, lane);) }
                }
            }
            GRID_BAR();
            TP_END(7);
            TP_BEGIN(5);
            PH_GOUT(gdn_out_phase(gw, NGW, lane, OBUF, PROJ, INP(I_NORMG) + j2 * GHD, CAT);)
            GRID_BAR();
            TP_END(5);
        }
        TP_BEGIN(3);
        { pg8::Gemm g{CAT, WOUT + (size_t)l * DM * DM, MROWS, DM, DM}; pg8::StaticOrder S; S.init(MROWS, DM, opq_s(G), opq_s(c)); pg8::EpiProj E{OUTb, DM, nullptr, -1};
          PH_WOUT((pg8::gemm_phase<pg8::EpiProj, pg8::StaticOrder, PG8_ALIGN, PG8_SP2>(L + RING_OFF, g, S, E))); }
        GRID_BAR();
        TP_END(3);
        TP_BEGIN(6);
        PH_NORM(norm_phase(gw, NGW, lane, OUTb, 1.0f, INP(I_MPOST) + (size_t)l * DM, Hbuf, true, Hbuf, true, INP(I_FPRE) + (size_t)(l * 2 + 1) * DM, Abuf);)
        GRID_BAR();
        TP_END(6);
        FFN_GEMMS(1);
        TP_BEGIN(6);
        if (l < DEPTH - 1) {
            PH_NORM(norm_phase(gw, NGW, lane, OUTb, 0.5f, INP(I_FPOST) + (size_t)(l * 2 + 1) * DM, Hbuf, true, Hbuf, true, INP(I_FPRE) + (size_t)((l + 1) * 2) * DM, Abuf);)
            GRID_BAR();
        } else {
            PH_NORM(norm_phase(gw, NGW, lane, OUTb, 0.5f, INP(I_FPOST) + (size_t)(l * 2 + 1) * DM, Hbuf, true, ((float*)karg_ptr(19)), false, nullptr, nullptr);)
        }
        TP_END(6);
    }
#ifdef TPROBE
    if (c == 0 && tid0 == 0) { unsigned long long a_ = (((unsigned long long)MISC[19] << 32) | MISC[18]); const unsigned long long t0_ = __builtin_amdgcn_s_memrealtime();
#if TPROBE == 8
        { const unsigned long long b_ = (((unsigned long long)MISC[23] << 32) | MISC[22]); a_ = b_ * 10000ull / (a_ ? a_ : 1ull); }
#endif
        while (__builtin_amdgcn_s_memrealtime() - t0_ < a_) __builtin_amdgcn_s_sleep(8); }
#endif
#undef FFN_GEMMS
#undef GRID_BAR
#undef tid
#undef lane
#undef wave
#undef gw
#undef NGW
}

extern "C" void kernel_launch(void* const* d_in, const int* in_sizes, int n_in, void* d_out, int out_size, void* d_ws, size_t ws_size, hipStream_t stream) {
    static int grid = 0;
    if (grid == 0) {
        if (n_in != 19 || in_sizes[0] != MROWS * DM || out_size != MROWS * DM || ws_size < WS_END) {
            fprintf(stderr, "kernel_launch: unexpected problem (n_in %d, in0 %d, out %d, ws %zu, need %zu); nothing launched\n", n_in, n_in > 0 ? in_sizes[0] : -1, out_size, ws_size, (size_t)WS_END); grid = -1; return; }
        int dev = 0, cus = 0, per_cu = 0;
        if (hipGetDevice(&dev) != hipSuccess || hipDeviceGetAttribute(&cus, hipDeviceAttributeMultiprocessorCount, dev) != hipSuccess) { fprintf(stderr, "kernel_launch: device query failed\n"); grid = -1; return; }
        if (hipFuncSetAttribute((const void*)fwd_kernel, hipFuncAttributeMaxDynamicSharedMemorySize, LDS_BYTES) != hipSuccess) { fprintf(stderr, "kernel_launch: hipFuncSetAttribute failed\n"); grid = -1; return; }
        if (hipOccupancyMaxActiveBlocksPerMultiprocessor(&per_cu, (const void*)fwd_kernel, NWAVES * 64, LDS_BYTES) != hipSuccess || per_cu < 1)
            fprintf(stderr, "kernel_launch: note: occupancy query reports %d workgroups per CU\n", per_cu);
        (void)hipGetLastError();
        grid = cus;
    }
    if (grid < 0) return;
    if (hipMemsetAsync((char*)d_ws + WS_CTL, 0, CTL_ZERO_BYTES, stream) != hipSuccess) { fprintf(stderr, "kernel_launch: memset failed\n"); return; }
    Args a{};
    for (int i = 0; i < 19; ++i) a.in[i] = (const float*)d_in[i];
    a.out = (float*)d_out; a.ws = (unsigned char*)d_ws;
    hipLaunchKernelGGL(fwd_kernel, dim3(grid), dim3(NWAVES * 64), LDS_BYTES, stream, a);
    const hipError_t le = hipPeekAtLastError();
    if (le != hipSuccess) fprintf(stderr, "kernel_launch: launch failed: %s\n", hipGetErrorName(le));
}
```

```cpp
#include <hip/hip_runtime.h>
#include <cstdio>
#include <cstdint>
namespace pg8 {
#define PG8_LAS __attribute__((address_space(3)))
typedef unsigned short bf16_t;
typedef short bf16x8 __attribute__((ext_vector_type(8)));
typedef float f32x4 __attribute__((ext_vector_type(4)));
typedef unsigned u32x4 __attribute__((ext_vector_type(4)));
constexpr int BM = 256, BK = 64, HALF = 128, HTB = HALF * BK * 2  , STAGE_BYTES = 8 * HTB, NXCD = 8, WGM = 8;

__host__ __device__ __forceinline__ int lds_byte(int r, int c) { const int st = (r >> 4) * 2 + (c >> 5), rr = r & 15, cc = c & 31, ob = rr * 64 + cc * 2; return st * 1024 + (ob ^ (((ob >> 9) & 1) << 5)); }
__host__ __device__ __forceinline__ void stage_rc(int b, int& R, int& C) { const int st = b / 1024, sb = b % 1024, swz = sb ^ (((sb >> 9) & 1) << 5); R = (st >> 1) * 16 + swz / 64; C = (st & 1) * 32 + (swz % 64) / 2; }
__host__ __device__ __forceinline__ int perm32(int rho) { const int n = rho >> 4, i = rho & 15; return 8 * (i >> 2) + 4 * n + (i & 3); }

struct Unit { int pm, pn; };
struct Gemm { const bf16_t* A; const bf16_t* Bt; int M, N, K; };

struct StaticOrder {
    int nM, nN, nwg, G, c;
    __host__ __device__ void init(int M, int N, int G_, int c_) { nM = M / BM; nN = N / BM; nwg = nM * nN; G = G_; c = c_; }
    __host__ __device__ bool next(int i, Unit& u) const {
        const long L = (long)i * G + c; if (L >= nwg) return false;
        int wgid = (int)L; { const int q = nwg / NXCD, r = nwg % NXCD, xcd = wgid % NXCD, off = wgid / NXCD; wgid = (xcd < r ? xcd * (q + 1) : r * (q + 1) + (xcd - r) * q) + off; }
        const int nig = WGM * nN, gid = wgid / nig, fm = gid * WGM, gsz = (nM - fm) < WGM ? (nM - fm) : WGM;
        u.pm = fm + ((wgid % nig) % gsz); u.pn = (wgid % nig) / gsz; return true;
    }
    __device__ __forceinline__ void a_ready(const Unit&) const {}
    __device__ __forceinline__ void done(const Unit&) const {}
};

__device__ __forceinline__ unsigned cvt_pk_bf16(float lo, float hi) { unsigned r; asm volatile("v_cvt_pk_bf16_f32 %0, %1, %2" : "=v"(r) : "v"(lo), "v"(hi)); return r; }

struct EpiProj {
    static constexpr bool PERM = true, AFTER_DRAIN = false;
    bf16_t* O; int ldc; float* aux; int aux_pn; const float* rs;
    __device__ __forceinline__ void operator()(const f32x4 (&acc)[2][2][4][2], const Unit& u, int wr, int wc, int fr, int fq) const {
        const int row0 = u.pm * BM + wr * 64 + fr;
        float rv[2][4];
#pragma unroll
        for (int ai = 0; ai < 2; ++ai)
#pragma unroll
            for (int m = 0; m < 4; ++m) rv[ai][m] = rs ? rs[row0 + ai * HALF + m * 16] : 1.0f;
        if (u.pn == aux_pn) {
            if (wc < 2) {
#pragma unroll
                for (int ai = 0; ai < 2; ++ai)
#pragma unroll
                    for (int m = 0; m < 4; ++m) { float* rowp = aux + (size_t)(row0 + ai * HALF + m * 16) * 64 + wc * 32 + 8 * fq;
                        *(f32x4*)(rowp) = acc[ai][0][m][0] * rv[ai][m]; *(f32x4*)(rowp + 4) = acc[ai][0][m][1] * rv[ai][m]; }
            }
            return;
        }
        const int col0 = u.pn * BM + wc * 32 + 8 * fq;
#pragma unroll
        for (int ai = 0; ai < 2; ++ai)
#pragma unroll
            for (int m = 0; m < 4; ++m) { bf16_t* rowp = O + (size_t)(row0 + ai * HALF + m * 16) * ldc + col0;
#pragma unroll
                for (int bj = 0; bj < 2; ++bj) { const f32x4 v0 = acc[ai][bj][m][0] * rv[ai][m], v1 = acc[ai][bj][m][1] * rv[ai][m];
                    u32x4 w; w.x = cvt_pk_bf16(v0[0], v0[1]); w.y = cvt_pk_bf16(v0[2], v0[3]); w.z = cvt_pk_bf16(v1[0], v1[1]); w.w = cvt_pk_bf16(v1[2], v1[3]);
                    *(u32x4*)(rowp + bj * HALF) = w; } }
    }
};
struct EpiSwiGLU {
    static constexpr bool PERM = true, AFTER_DRAIN = false;
    bf16_t* O; int ldc; const float* rs;
    __device__ __forceinline__ void operator()(const f32x4 (&acc)[2][2][4][2], const Unit& u, int wr, int wc, int fr, int fq) const {
        const int row0 = u.pm * BM + wr * 64 + fr, col0 = u.pn * HALF + wc * 32 + 8 * fq;
#pragma unroll
        for (int ai = 0; ai < 2; ++ai)
#pragma unroll
            for (int m = 0; m < 4; ++m) { bf16_t* rowp = O + (size_t)(row0 + ai * HALF + m * 16) * ldc + col0; const float rsc = rs[row0 + ai * HALF + m * 16];
                f32x4 r[2];
#pragma unroll
                for (int n = 0; n < 2; ++n)
#pragma unroll
                    for (int j = 0; j < 4; ++j) { const float g = acc[ai][0][m][n][j] * rsc, up = acc[ai][1][m][n][j] * rsc;
                        r[n][j] = g * up * __builtin_amdgcn_rcpf(1.0f + __builtin_amdgcn_exp2f(g * -1.44269504089f)); }
                u32x4 w; w.x = cvt_pk_bf16(r[0][0], r[0][1]); w.y = cvt_pk_bf16(r[0][2], r[0][3]); w.z = cvt_pk_bf16(r[1][0], r[1][1]); w.w = cvt_pk_bf16(r[1][2], r[1][3]);
                *(u32x4*)(rowp) = w; }
    }
};
struct EpiKV {
    static constexpr bool PERM = true, AFTER_DRAIN = false;
    bf16_t* Kb; bf16_t* VTb;
    __device__ __forceinline__ void operator()(const f32x4 (&acc)[2][2][4][2], const Unit& u, int wr, int wc, int fr, int fq) const {
        const int l = u.pm / 12, ri = u.pm % 12, rj = u.pn % 12;
        bf16_t* base = (ri < 4) ? Kb + (size_t)l * 1048576 + (size_t)(ri * 256) * 1024 + (rj - 4) * 256
                                : VTb + (size_t)l * 1048576 + (size_t)((ri - 8) * 256) * 1024 + rj * 256;
        const int row0 = wr * 64 + fr, col0 = wc * 32 + 8 * fq;
        const int p0 = 8 * ((2 * fq) & 3) + 4 * (fq >> 1), p1 = 8 * ((2 * fq + 1) & 3) + 4 * (fq >> 1);
        typedef unsigned u32x2e __attribute__((ext_vector_type(2)));
#pragma unroll
        for (int ai = 0; ai < 2; ++ai)
#pragma unroll
            for (int m = 0; m < 4; ++m) { bf16_t* rowp = base + (size_t)(row0 + ai * HALF + m * 16) * 1024;
#pragma unroll
                for (int bj = 0; bj < 2; ++bj) { const f32x4 v0 = acc[ai][bj][m][0], v1 = acc[ai][bj][m][1];
                    u32x4 w; w.x = cvt_pk_bf16(v0[0], v0[1]); w.y = cvt_pk_bf16(v0[2], v0[3]); w.z = cvt_pk_bf16(v1[0], v1[1]); w.w = cvt_pk_bf16(v1[2], v1[3]);
                    if (ri < 4) *(u32x4*)(rowp + col0 + bj * HALF) = w;
                    else { *(u32x2e*)(rowp + wc * 32 + bj * HALF + p0) = (u32x2e){w.x, w.y}; *(u32x2e*)(rowp + wc * 32 + bj * HALF + p1) = (u32x2e){w.z, w.w}; } } }
    }
};
struct KvOrder {
    int nwg, c, lbase, nunits;
    __device__ __forceinline__ bool next(int i, Unit& u) const {
        if (c < 0) return false;
        const int L = i * nwg + c; if (L >= nunits) return false;
        const int l = lbase + (L >> 5), r = L & 31;
        if (r < 16) { u.pm = 12 * l + (r >> 2); u.pn = 12 * l + 4 + (r & 3); }
        else { u.pm = 12 * l + 8 + ((r - 16) >> 2); u.pn = 12 * l + (r & 3); }
        return true;
    }
    __device__ __forceinline__ void a_ready(const Unit&) const {}
    __device__ __forceinline__ void done(const Unit&) const {}
};

template <class Epi, class Sched, bool ALIGN_EPI = false, bool SP2 = false>
__device__ __forceinline__ void gemm_phase(PG8_LAS unsigned char* lds, const Gemm g, const Sched& S, const Epi& E) {
    int tid_o = threadIdx.x; asm volatile("" : "+v"(tid_o));
    const int tid = tid_o, wid = __builtin_amdgcn_readfirstlane(tid >> 6), lane = tid & 63, wr = wid >> 2, wc = wid & 3, fr = lane & 15, fq = lane >> 4;
    const int K = g.K, nt = K / BK;
    unsigned voffA[2], voffB[2];
#pragma unroll
    for (int i = 0; i < 2; ++i) { int R, C; stage_rc(tid * 16 + i * 8192, R, C); const int Rb = Epi::PERM ? ((R & ~31) + perm32(R & 31)) : R;
        voffA[i] = (unsigned)(R * K + C) * 2u; voffB[i] = (unsigned)(Rb * K + C) * 2u; }
    const size_t kstep = (size_t)(BK * 2);
    const size_t hstep = (size_t)HALF * K * 2;
    const size_t tstep = 2 * hstep;
    const unsigned ldsw = (unsigned)wid * 1024u;
    const int aoff = lds_byte(wr * 64 + fr, fq * 8), boff = lds_byte(wc * 32 + fr, fq * 8);
#define PG8_SA(b, h) (((b) * 2 + (h)) * HTB)
#define PG8_SB(b, h) ((4 + (b) * 2 + (h)) * HTB)
#define PG8_STAGE(bufoff, gbase, voff) do { _Pragma("unroll") for (int _i = 0; _i < 2; ++_i) \
        __builtin_amdgcn_global_load_lds((const unsigned*)((const char*)(gbase) + (voff)[_i]), (PG8_LAS unsigned*)(lds + (bufoff) + ldsw + _i * 8192), 16, 0, 0); } while (0)
#define PG8_LDA(dst, b, h) do { _Pragma("unroll") for (int m = 0; m < 4; ++m) _Pragma("unroll") for (int k = 0; k < 2; ++k) dst[m][k] = *(const PG8_LAS bf16x8*)(lds + PG8_SA(b, h) + aoff + m * 2048 + k * 1024); } while (0)
#define PG8_LDB(dst, b, h) do { _Pragma("unroll") for (int n = 0; n < 2; ++n) _Pragma("unroll") for (int k = 0; k < 2; ++k) dst[n][k] = *(const PG8_LAS bf16x8*)(lds + PG8_SB(b, h) + boff + n * 2048 + k * 1024); } while (0)
#define PG8_MMA(ai, bj, At, Bt) do { __builtin_amdgcn_s_setprio(1); _Pragma("unroll") for (int m = 0; m < 4; ++m) _Pragma("unroll") for (int n = 0; n < 2; ++n) _Pragma("unroll") for (int k = 0; k < 2; ++k) \
        acc[ai][bj][m][n] = __builtin_amdgcn_mfma_f32_16x16x32_bf16(Bt[n][k], At[m][k], acc[ai][bj][m][n], 0, 0, 0); __builtin_amdgcn_s_setprio(0); } while (0)
#define PG8_WAIT_V(n) asm volatile("s_waitcnt vmcnt(" #n ")" ::: "memory")
#define PG8_WAIT_L(n) asm volatile("s_waitcnt lgkmcnt(" #n ")" ::: "memory")
#define PG8_BAR __builtin_amdgcn_s_barrier()
#define PG8_SCHED __builtin_amdgcn_sched_barrier(0)
    Unit cur, nxt; int ui = 0;
    if (!S.next(0, cur)) return;
    f32x4 acc[2][2][4][2];
#pragma unroll
    for (int a = 0; a < 2; ++a)
#pragma unroll
        for (int b = 0; b < 2; ++b)
#pragma unroll
            for (int m = 0; m < 4; ++m)
#pragma unroll
                for (int n = 0; n < 2; ++n) acc[a][b][m][n] = (f32x4){0.f, 0.f, 0.f, 0.f};
    bf16x8 At[4][2], B0[2][2], B1[2][2];
    const char* cA = (const char*)g.A + (size_t)cur.pm * tstep; const char* cB = (const char*)g.Bt + (size_t)cur.pn * tstep;
    S.a_ready(cur);
    if constexpr (SP2) {
        PG8_STAGE(PG8_SB(0, 0), cB, voffB); PG8_STAGE(PG8_SB(0, 1), cB + hstep, voffB); PG8_STAGE(PG8_SA(0, 0), cA, voffA); PG8_STAGE(PG8_SA(0, 1), cA + hstep, voffA);
        if (wr == 1) PG8_BAR;
        PG8_WAIT_V(2); PG8_BAR;
        PG8_STAGE(PG8_SB(1, 0), cB + kstep, voffB); PG8_STAGE(PG8_SA(1, 0), cA + kstep, voffA); PG8_STAGE(PG8_SB(1, 1), cB + hstep + kstep, voffB);
        PG8_WAIT_V(6); PG8_BAR;
    } else {
        PG8_STAGE(PG8_SB(0, 0), cB, voffB); PG8_STAGE(PG8_SA(0, 0), cA, voffA); PG8_STAGE(PG8_SB(0, 1), cB + hstep, voffB); PG8_STAGE(PG8_SA(0, 1), cA + hstep, voffA);
        if (wr == 1) PG8_BAR;
        PG8_WAIT_V(4); PG8_BAR;
        PG8_STAGE(PG8_SB(1, 0), cB + kstep, voffB); PG8_STAGE(PG8_SA(1, 0), cA + kstep, voffA); PG8_STAGE(PG8_SB(1, 1), cB + hstep + kstep, voffB);
        PG8_WAIT_V(6); PG8_BAR;
    }
    for (;;) {
        const bool has_next = S.next(ui + 1, nxt);
        const char* nA = has_next ? (const char*)g.A + (size_t)nxt.pm * tstep : cA; const char* nB = has_next ? (const char*)g.Bt + (size_t)nxt.pn * tstep : cB;
        for (int t = 0; t < nt; t += 2) {
            const bool last = (t == nt - 2);
            const char* a1 = cA + (size_t)(t + 1) * kstep;
            const char* a2 = last ? nA : cA + (size_t)(t + 2) * kstep; const char* b2 = last ? nB : cB + (size_t)(t + 2) * kstep;
            const char* a3 = a2 + kstep; const char* b3 = b2 + kstep;
            if (last && has_next) S.a_ready(nxt);
            if constexpr (SP2) {
            PG8_LDB(B0, 0, 0); PG8_LDB(B1, 0, 1); PG8_SCHED; PG8_LDA(At, 0, 0); PG8_STAGE(PG8_SA(1, 1), a1 + hstep, voffA);
            PG8_WAIT_V(8); PG8_WAIT_L(0); PG8_BAR; PG8_MMA(0, 0, At, B0); PG8_MMA(0, 1, At, B1); PG8_BAR; PG8_SCHED;
            PG8_LDA(At, 0, 1); PG8_STAGE(PG8_SB(0, 0), b2, voffB); PG8_STAGE(PG8_SB(0, 1), b2 + hstep, voffB); PG8_STAGE(PG8_SA(0, 0), a2, voffA);
            PG8_WAIT_V(8); PG8_WAIT_L(0); PG8_BAR; PG8_MMA(1, 0, At, B0); PG8_MMA(1, 1, At, B1); PG8_BAR; PG8_SCHED;
            PG8_LDB(B0, 1, 0); PG8_LDB(B1, 1, 1); PG8_SCHED; PG8_LDA(At, 1, 0); PG8_STAGE(PG8_SA(0, 1), a2 + hstep, voffA);
            PG8_WAIT_V(8); PG8_WAIT_L(0); PG8_BAR; PG8_MMA(0, 0, At, B0); PG8_MMA(0, 1, At, B1); PG8_BAR; PG8_SCHED;
            PG8_LDA(At, 1, 1); PG8_STAGE(PG8_SB(1, 0), b3, voffB); PG8_STAGE(PG8_SB(1, 1), b3 + hstep, voffB); PG8_STAGE(PG8_SA(1, 0), a3, voffA);
            PG8_WAIT_V(8); PG8_WAIT_L(0); PG8_BAR; PG8_MMA(1, 0, At, B0); PG8_MMA(1, 1, At, B1); PG8_BAR; PG8_SCHED;
            } else {
            PG8_LDB(B0, 0, 0); PG8_SCHED; PG8_LDA(At, 0, 0); PG8_STAGE(PG8_SA(1, 1), a1 + hstep, voffA);
            PG8_WAIT_L(8); PG8_BAR; PG8_WAIT_L(0); PG8_MMA(0, 0, At, B0); PG8_BAR; PG8_SCHED;
            PG8_LDB(B1, 0, 1); PG8_STAGE(PG8_SB(0, 0), b2, voffB);
            PG8_BAR; PG8_WAIT_L(0); PG8_MMA(0, 1, At, B1); PG8_BAR;
            PG8_LDA(At, 0, 1); PG8_STAGE(PG8_SA(0, 0), a2, voffA);
            PG8_BAR; PG8_WAIT_L(0); PG8_MMA(1, 0, At, B0); PG8_BAR; PG8_SCHED;
            PG8_STAGE(PG8_SB(0, 1), b2 + hstep, voffB);
            PG8_WAIT_V(6); PG8_BAR; PG8_MMA(1, 1, At, B1); PG8_BAR;
            PG8_LDB(B0, 1, 0); PG8_SCHED; PG8_LDA(At, 1, 0); PG8_STAGE(PG8_SA(0, 1), a2 + hstep, voffA);
            PG8_WAIT_L(8); PG8_BAR; PG8_WAIT_L(0); PG8_MMA(0, 0, At, B0); PG8_BAR; PG8_SCHED;
            PG8_LDB(B1, 1, 1); PG8_STAGE(PG8_SB(1, 0), b3, voffB);
            PG8_BAR; PG8_WAIT_L(0); PG8_MMA(0, 1, At, B1); PG8_BAR;
            PG8_LDA(At, 1, 1); PG8_STAGE(PG8_SA(1, 0), a3, voffA);
            PG8_BAR; PG8_WAIT_L(0); PG8_MMA(1, 0, At, B0); PG8_BAR; PG8_SCHED;
            PG8_STAGE(PG8_SB(1, 1), b3 + hstep, voffB);
            PG8_WAIT_V(6); PG8_BAR; PG8_MMA(1, 1, At, B1); PG8_BAR;
            }
        }
        if constexpr (ALIGN_EPI) { if (wr == 0) PG8_BAR; }
        if constexpr (!Epi::AFTER_DRAIN) { E(acc, cur, wr, wc, fr, fq); S.done(cur); }
        if (!has_next) break;
#pragma unroll
        for (int a = 0; a < 2; ++a)
#pragma unroll
            for (int b = 0; b < 2; ++b)
#pragma unroll
                for (int m = 0; m < 4; ++m)
#pragma unroll
                    for (int n = 0; n < 2; ++n) acc[a][b][m][n] = (f32x4){0.f, 0.f, 0.f, 0.f};
        cur = nxt; cA = nA; cB = nB; ++ui;
        if constexpr (ALIGN_EPI) { if (wr == 1) PG8_BAR; }
    }
    PG8_WAIT_V(0);
    if constexpr (!ALIGN_EPI) { if (wr == 0) PG8_BAR; }
    PG8_BAR;
    if constexpr (Epi::AFTER_DRAIN) { E.fused(acc, cur, wr, wc, fr, fq, lds, wid, lane); S.done(cur); }
#undef PG8_SA
#undef PG8_SB
#undef PG8_STAGE
#undef PG8_LDA
#undef PG8_LDB
#undef PG8_MMA
#undef PG8_WAIT_V
#undef PG8_WAIT_L
#undef PG8_BAR
#undef PG8_SCHED
}
}

#ifndef PG8_SP2
#define PG8_SP2 true
#endif
#ifndef PG8_ALIGN
#define PG8_ALIGN true
#endif

constexpr int NWAVES = 8;
constexpr int DM = 4096, NBATCH = 4, SEQ = 2048, MROWS = NBATCH * SEQ, DEPTH = 4;
constexpr int MEMT = 256, XH = 4, XW = 1024, XHD = 256, MIXW = 3072, DFF = 6144;
constexpr int GH = 24, GHD = 128;
constexpr int SC_IN = 3 * MIXW + XW;
constexpr int GDN_SRC = 4 * MIXW + 2 * GH + XW;
constexpr int GDN_LD = 4 * MIXW + XW;
constexpr int GDN_N = GDN_LD + 256;
constexpr float EPS = 1e-6f;

constexpr size_t MiB = 1u << 20;
constexpr size_t WS_CTL = 0, CTL_ZERO_BYTES = 1 * MiB;
constexpr size_t WS_H = 1 * MiB;
constexpr size_t WS_A = WS_H + 128 * MiB;
constexpr size_t WS_OUT = WS_A + 64 * MiB;
constexpr size_t WS_CAT = WS_OUT + 64 * MiB;
constexpr size_t WS_ACT = WS_CAT + 64 * MiB;
constexpr size_t WS_PROJ = WS_ACT + 96 * MiB;
constexpr size_t WS_AUX = WS_PROJ + 208 * MiB;
constexpr size_t WS_AB = WS_AUX + 2 * MiB;
constexpr size_t WS_QKV = WS_AB + 2 * MiB;
constexpr size_t WS_O = WS_QKV + 144 * MiB;
constexpr size_t WS_KVOPS = WS_O + 96 * MiB;
constexpr size_t WS_KB = WS_KVOPS + 96 * MiB;
constexpr size_t WS_VTB = WS_KB + 8 * MiB;
constexpr size_t WS_WGU = WS_VTB + 8 * MiB;
constexpr size_t WS_WDN = WS_WGU + 768 * MiB;
constexpr size_t WS_WOUT = WS_WDN + 384 * MiB;
constexpr size_t WS_WSC = WS_WOUT + 128 * MiB;
constexpr size_t WS_WGDN = WS_WSC + 160 * MiB;
constexpr size_t WS_CHB = WS_WGDN + 212 * MiB;
constexpr size_t WS_UT = WS_CHB + 168 * MiB;
constexpr size_t WS_CD = WS_UT + 96 * MiB;
constexpr size_t WS_END = WS_CD + 1 * MiB;
constexpr int CW_BAR = 4096;

constexpr int RING_OFF = 0, RING_BYTES = 131072;
constexpr int XP_SCR = 64 * 65 * 4;
constexpr int LDSCTL_OFF = 139264, MISC_OFF = LDSCTL_OFF + 320;
static_assert(LDSCTL_OFF >= 8 * XP_SCR, "LDS map");
static_assert(LDSCTL_OFF >= RING_BYTES, "LDS map");
constexpr int LDS_BYTES = 147456;

#define GAS __attribute__((address_space(1)))
#define LAS __attribute__((address_space(3)))
typedef unsigned short bf16;
typedef unsigned v4u __attribute__((ext_vector_type(4)));
typedef unsigned v2u __attribute__((ext_vector_type(2)));
typedef float f32x4 __attribute__((ext_vector_type(4)));
typedef float f32x2 __attribute__((ext_vector_type(2)));
typedef short bf16x8 __attribute__((ext_vector_type(8)));
#define LDS_WAIT() asm volatile("s_waitcnt lgkmcnt(0)" ::: "memory")
#define VM_WAIT() asm volatile("s_waitcnt vmcnt(0)" ::: "memory")
__device__ __forceinline__ unsigned pk2(float lo, float hi) { return pg8::cvt_pk_bf16(lo, hi); }
__device__ __forceinline__ float bflo(unsigned u) { return __uint_as_float(u << 16); }
__device__ __forceinline__ float bfhi(unsigned u) { return __uint_as_float(u & 0xffff0000u); }
__device__ __forceinline__ float silu_f(float x) { return x * __builtin_amdgcn_rcpf(1.0f + __builtin_amdgcn_exp2f(x * -1.44269504089f)); }
__device__ __forceinline__ int opq_v(int x) { asm volatile("" : "+v"(x)); return x; }
__device__ __forceinline__ int opq_s(int x) { asm volatile("" : "+s"(x)); return x; }

#define XB_TMO      128
#define XB_XCNT(j)  (256  + 64 * (j))
#define XB_XSUB(j)  (1280 + 64 * (j))
#define XB_XGEN(j)  (2304 + 64 * (j))
#define XB_TOP      3328
#define XB_TOPGEN   3392
#define XCD_BAR_WORDS 3456
#define XB_SPIN_CAP (1u << 18)

__device__ __forceinline__ unsigned xb_ld(unsigned* p)              { return __hip_atomic_load(p, __ATOMIC_RELAXED, __HIP_MEMORY_SCOPE_AGENT); }
__device__ __forceinline__ unsigned xb_add(unsigned* p, unsigned v) { return __hip_atomic_fetch_add(p, v, __ATOMIC_RELAXED, __HIP_MEMORY_SCOPE_AGENT); }
__device__ __forceinline__ unsigned xb_xcc_id() { return (unsigned)__builtin_amdgcn_s_getreg((3 << 11) | 20) & 0xFu; }
#define XB_SPIN(cond, bar) do { unsigned _sp = 0; while (cond) { __builtin_amdgcn_s_sleep(1); \
    if ((++_sp & 255u) == 0u) { if (xb_ld(&(bar)[XB_TMO])) break; if (_sp > XB_SPIN_CAP) { atomicAdd(&(bar)[XB_TMO], 1u); break; } } } } while (0)

struct XcdBarrier {
    unsigned* bar; unsigned x;
    volatile LAS unsigned* st;
};
__device__ __forceinline__ XcdBarrier xcd_barrier_post(unsigned* bar, volatile LAS unsigned* st) {
    XcdBarrier b; b.bar = bar; b.x = xb_xcc_id(); b.st = st;
    if (threadIdx.x == 0) (void)xb_add(&bar[XB_XCNT(b.x)], 1u);
    return b;
}
__device__ __forceinline__ void xcd_barrier_complete(unsigned* bar, unsigned x, unsigned& nloc, unsigned& nx) {
    const unsigned G = gridDim.x * gridDim.y * gridDim.z;
    unsigned sum, cnt, mine, sp = 0u;
    for (;;) {
        sum = 0u; cnt = 0u; mine = 0u;
#pragma unroll
        for (unsigned j = 0; j < 16; ++j) { const unsigned c = xb_ld(&bar[XB_XCNT(j)]); sum += c; cnt += (c > 0u) ? 1u : 0u; mine = (j == x) ? c : mine; }
        if (sum == G) break;
        __builtin_amdgcn_s_sleep(1);
        if ((++sp & 255u) == 0u) { if (xb_ld(&bar[XB_TMO])) break; if (sp > XB_SPIN_CAP) { atomicAdd(&bar[XB_TMO], 1u); break; } }
    }
    nloc = mine > 0u ? mine : 1u; nx = cnt > 0u ? cnt : 1u;
}
__device__ __forceinline__ void xcd_barrier(const XcdBarrier& b) {
    asm volatile("s_waitcnt vmcnt(0)" ::: "memory");
    __syncthreads();
    if (threadIdx.x == 0) {
        unsigned* bar = b.bar;
        __builtin_amdgcn_s_waitcnt(0);
        unsigned nloc = b.st[0], nx = b.st[1];
        if (nloc == 0u) { xcd_barrier_complete(bar, b.x, nloc, nx); b.st[0] = nloc; b.st[1] = nx; }
        const unsigned old = xb_add(&bar[XB_XSUB(b.x)], 1u);
        const unsigned gen = old / nloc;
        if (old + 1u == (gen + 1u) * nloc) {
            __builtin_amdgcn_fence(__ATOMIC_RELEASE, "agent");
            asm volatile("s_waitcnt vmcnt(0)" ::: "memory");
            const unsigned og = xb_add(&bar[XB_TOP], 1u);
            const unsigned tg = og / nx;
            if (og + 1u == (tg + 1u) * nx) xb_add(&bar[XB_TOPGEN], 1u);
            else XB_SPIN(xb_ld(&bar[XB_TOPGEN]) == tg, bar);
            __builtin_amdgcn_fence(__ATOMIC_ACQUIRE, "agent");
            xb_add(&bar[XB_XGEN(b.x)], 1u);
            asm volatile("s_waitcnt vmcnt(0)" ::: "memory");
        } else {
            XB_SPIN(xb_ld(&bar[XB_XGEN(b.x)]) == gen, bar);
            __builtin_amdgcn_fence(__ATOMIC_ACQUIRE, "agent");
            asm volatile("s_waitcnt vmcnt(0)" ::: "memory");
        }
    }
    __syncthreads();
}

__device__ __forceinline__ float wave_sum(float v) {
#pragma unroll
    for (int o = 1; o < 64; o <<= 1) v += __shfl_xor(v, o);
    return v;
}
__device__ __forceinline__ float grp16_sum(float v) {
#pragma unroll
    for (int o = 1; o < 16; o <<= 1) v += __shfl_xor(v, o);
    return v;
}
template <int CTRL> __device__ __forceinline__ float dpp_mov(float v) {
    return __builtin_bit_cast(float, __builtin_amdgcn_update_dpp(0, __builtin_bit_cast(int, v), CTRL, 0xF, 0xF, true));
}
__device__ __forceinline__ float grp8_sum(float v) {
    v += dpp_mov<0xB1>(v); v += dpp_mov<0x4E>(v); v += dpp_mov<0x141>(v); return v;
}

__device__ __forceinline__ void xpose_load(f32x4 (&v)[16], float (&gv)[16], const float* W, int N, int col0, int nvalid, int k0, int n0, int lane, const float* gk) {
    const int nn = n0 + 4 * (lane & 15); const bool ok = nn < nvalid;
    const float* p = W + (size_t)(k0 + (lane >> 4)) * N + col0 + nn;
#pragma unroll
    for (int i = 0; i < 16; ++i) v[i] = ok ? __builtin_nontemporal_load((const GAS f32x4*)(p + (size_t)(4 * i) * N)) : (f32x4){0.f, 0.f, 0.f, 0.f};
#pragma unroll
    for (int i = 0; i < 16; ++i) gv[i] = gk ? gk[k0 + (lane >> 4) + 4 * i] : 1.0f;
}
__device__ __forceinline__ void xpose_store(const f32x4 (&v)[16], const float (&gv)[16], bf16* WT, int Kd, int drow0, LAS float* scr, int k0, int lane) {
    LAS float* w = scr + (lane >> 4) * 65 + 4 * (lane & 15);
#pragma unroll
    for (int i = 0; i < 16; ++i) { w[(4 * i) * 65 + 0] = v[i][0] * gv[i]; w[(4 * i) * 65 + 1] = v[i][1] * gv[i]; w[(4 * i) * 65 + 2] = v[i][2] * gv[i]; w[(4 * i) * 65 + 3] = v[i][3] * gv[i]; }
    LDS_WAIT(); asm volatile("" ::: "memory");
    const int c = lane & 7;
#pragma unroll
    for (int j = 0; j < 8; ++j) { const int n = (lane >> 3) + 8 * j; const LAS float* s = scr + (8 * c) * 65 + n;
        v4u o; o.x = pk2(s[0 * 65], s[1 * 65]); o.y = pk2(s[2 * 65], s[3 * 65]); o.z = pk2(s[4 * 65], s[5 * 65]); o.w = pk2(s[6 * 65], s[7 * 65]);
        __builtin_nontemporal_store(o, (GAS v4u*)(WT + (size_t)(drow0 + n) * Kd + k0 + 8 * c)); }
    LDS_WAIT(); asm volatile("" ::: "memory");
}

struct Args { const float* in[19]; float* out; unsigned char* ws; };
enum { I_X = 0, I_MEM, I_FPRE, I_FPOST, I_MPRE, I_MPOST, I_MEMG, I_WG, I_WU, I_WD, I_WKV, I_WOUT, I_SCIN, I_SCCONV, I_GDNIN, I_GDNCONV, I_ALOG, I_DTB, I_NORMG };

__device__ __forceinline__ void norm_load(v4u (&hq)[16], v4u (&ov)[8], const void* hsrc, bool h16, const bf16* outb, int row, int lane) {
    if (h16) { const bf16* hr = (const bf16*)hsrc + (size_t)row * DM;
#pragma unroll
        for (int j = 0; j < 8; ++j) hq[j] = __builtin_nontemporal_load((const GAS v4u*)(hr + (j * 64 + lane) * 8)); }
    else { const float* hr = (const float*)hsrc + (size_t)row * DM;
#pragma unroll
        for (int j = 0; j < 8; ++j) { const int e = (j * 64 + lane) * 8; hq[2 * j] = __builtin_nontemporal_load((const GAS v4u*)(hr + e)); hq[2 * j + 1] = __builtin_nontemporal_load((const GAS v4u*)(hr + e + 4)); } }
    if (outb) {
#pragma unroll
        for (int j = 0; j < 8; ++j) ov[j] = __builtin_nontemporal_load((const GAS v4u*)(outb + (size_t)row * DM + (j * 64 + lane) * 8)); }
}
__device__ __forceinline__ void norm_row(const v4u (&hq)[16], bool h16, const v4u (&ov)[8], int row, int lane, bool has_out, float w, const f32x4 (&gp)[16], void* hdst, bool d16, float* rs2) {
    float sc = 0.f;
    if (has_out) {
        float ss = 0.f;
#pragma unroll
        for (int j = 0; j < 8; ++j)
#pragma unroll
            for (int q = 0; q < 4; ++q) { const float a = bflo(ov[j][q]), b = bfhi(ov[j][q]); ss += a * a + b * b; }
        ss = wave_sum(ss);
        sc = w / sqrtf(ss * (1.0f / DM) + EPS);
    }
    float ss2 = 0.f;
#pragma unroll
    for (int j = 0; j < 8; ++j) { const int e = (j * 64 + lane) * 8;
        f32x4 h0, h1;
        if (h16) { const v4u x = hq[j]; h0 = (f32x4){bflo(x.x), bfhi(x.x), bflo(x.y), bfhi(x.y)}; h1 = (f32x4){bflo(x.z), bfhi(x.z), bflo(x.w), bfhi(x.w)}; }
        else { h0 = __builtin_bit_cast(f32x4, hq[2 * j]); h1 = __builtin_bit_cast(f32x4, hq[2 * j + 1]); }
        if (has_out) { const f32x4 g0 = gp[2 * j], g1 = gp[2 * j + 1];
            const f32x4 o0 = {bflo(ov[j][0]), bfhi(ov[j][0]), bflo(ov[j][1]), bfhi(ov[j][1])}, o1 = {bflo(ov[j][2]), bfhi(ov[j][2]), bflo(ov[j][3]), bfhi(ov[j][3])};
            h0 += o0 * g0 * sc; h1 += o1 * g1 * sc; }
        ss2 += (h0[0] * h0[0] + h0[1] * h0[1]) + (h0[2] * h0[2] + h0[3] * h0[3]) + (h1[0] * h1[0] + h1[1] * h1[1]) + (h1[2] * h1[2] + h1[3] * h1[3]);
        if (d16) { v4u o; o.x = pk2(h0[0], h0[1]); o.y = pk2(h0[2], h0[3]); o.z = pk2(h1[0], h1[1]); o.w = pk2(h1[2], h1[3]);
            __builtin_nontemporal_store(o, (GAS v4u*)((bf16*)hdst + (size_t)row * DM + e)); }
        else { __builtin_nontemporal_store(h0, (GAS f32x4*)((float*)hdst + (size_t)row * DM + e)); __builtin_nontemporal_store(h1, (GAS f32x4*)((float*)hdst + (size_t)row * DM + e + 4)); }
    }
    if (rs2) { ss2 = wave_sum(ss2); if (lane == 0) rs2[row] = 1.0f / sqrtf(ss2 * (1.0f / DM) + EPS); }
}
__device__ __forceinline__ void norm_phase(int gw, int NGW, int lane, const bf16* outb, float w, const float* g_post, const void* hsrc, bool h16, void* hdst, bool d16, float* rs2) {
    f32x4 gp[16];
#pragma unroll
    for (int j = 0; j < 8; ++j) { const int e = (j * 64 + lane) * 8; gp[2 * j] = outb ? *(const GAS f32x4*)(g_post + e) : (f32x4){0.f, 0.f, 0.f, 0.f}; gp[2 * j + 1] = outb ? *(const GAS f32x4*)(g_post + e + 4) : (f32x4){0.f, 0.f, 0.f, 0.f}; }
    for (int row = gw; row < MROWS; row += 2 * NGW) {
        const int row2 = row + NGW; const bool two = h16 && row2 < MROWS;
        v4u qa[16], qb[16], oa[8], ob[8];
#pragma unroll
        for (int j = 0; j < 8; ++j) { oa[j] = (v4u){0u, 0u, 0u, 0u}; ob[j] = (v4u){0u, 0u, 0u, 0u}; }
        norm_load(qa, oa, hsrc, h16, outb, row, lane);
        if (two) norm_load(qb, ob, hsrc, h16, nullptr, row2, lane);
        norm_row(qa, h16, oa, row, lane, outb != nullptr, w, gp, hdst, d16, rs2);
        if (two) { if (outb) {
#pragma unroll
                for (int j = 0; j < 8; ++j) ob[j] = __builtin_nontemporal_load((const GAS v4u*)(outb + (size_t)row2 * DM + (j * 64 + lane) * 8)); }
            norm_row(qb, h16, ob, row2, lane, outb != nullptr, w, gp, hdst, d16, rs2); }
        else if (row2 < MROWS) { norm_load(qa, oa, hsrc, h16, outb, row2, lane); norm_row(qa, h16, oa, row2, lane, outb != nullptr, w, gp, hdst, d16, rs2); }
    }
}

constexpr int XA_PITCH = 544;
__device__ __forceinline__ void xa_stage(LAS unsigned char* ldsb, const bf16* src, int tid) {
#pragma unroll
    for (int hf = 0; hf < 2; ++hf) { v4u t[8];
#pragma unroll
        for (int e = 0; e < 8; ++e) { const int p = tid + 512 * (8 * hf + e); t[e] = *(const GAS v4u*)(src + (size_t)(p >> 5) * 1024 + (p & 31) * 8); }
#pragma unroll
        for (int e = 0; e < 8; ++e) { const int p = tid + 512 * (8 * hf + e); *(LAS v4u*)(ldsb + (p >> 5) * XA_PITCH + (p & 31) * 16) = t[e]; } }
}
__device__ __forceinline__ void xattn_unit(int unit, LAS unsigned char* ldsb, const bf16* proj, int ldp, int xq_col0, const bf16* Kb, const bf16* VTb, bf16* cat, int tid, int wave, int lane) {
    const int rb = unit & 15, h = (unit >> 4) & 3, b = unit >> 6;
    const int r0 = b * SEQ + rb * 128 + wave * 16, c15 = lane & 15, q4 = lane >> 4;
    xa_stage(ldsb, Kb + (size_t)(b * MEMT) * 1024 + h * XHD, tid);
    bf16x8 qf[8];
    const bf16* qp = proj + (size_t)(r0 + c15) * ldp + xq_col0 + h * XHD + 8 * q4;
#pragma unroll
    for (int s = 0; s < 8; ++s) qf[s] = *(const GAS bf16x8*)(qp + 32 * s);
    __syncthreads();
    f32x4 st[16];
    const LAS unsigned char* fp = ldsb + c15 * XA_PITCH + 16 * q4;
#pragma unroll
    for (int kb = 0; kb < 16; ++kb) { f32x4 acc = {0.f, 0.f, 0.f, 0.f};
#pragma unroll
        for (int s = 0; s < 8; ++s) acc = __builtin_amdgcn_mfma_f32_16x16x32_bf16(*(const LAS bf16x8*)(fp + (16 * kb) * XA_PITCH + 64 * s), qf[s], acc, 0, 0, 0);
        st[kb] = acc; }
    __syncthreads();
    xa_stage(ldsb, VTb + (size_t)(h * XHD) * 1024 + b * MEMT, tid);
    float mx = -3.0e38f;
#pragma unroll
    for (int kb = 0; kb < 16; ++kb)
#pragma unroll
        for (int j = 0; j < 4; ++j) mx = fmaxf(mx, st[kb][j]);
    mx = fmaxf(mx, __shfl_xor(mx, 16)); mx = fmaxf(mx, __shfl_xor(mx, 32));
    const float sc = 0.0625f * 1.44269504089f; float sum = 0.f;
#pragma unroll
    for (int kb = 0; kb < 16; ++kb)
#pragma unroll
        for (int j = 0; j < 4; ++j) { const float p = __builtin_amdgcn_exp2f((st[kb][j] - mx) * sc); st[kb][j] = p; sum += p; }
    sum += __shfl_xor(sum, 16); sum += __shfl_xor(sum, 32);
    const float inv = 1.0f / sum;
    bf16x8 pf[8];
#pragma unroll
    for (int s = 0; s < 8; ++s) { v4u w; w.x = pk2(st[2 * s][0], st[2 * s][1]); w.y = pk2(st[2 * s][2], st[2 * s][3]); w.z = pk2(st[2 * s + 1][0], st[2 * s + 1][1]); w.w = pk2(st[2 * s + 1][2], st[2 * s + 1][3]);
        pf[s] = __builtin_bit_cast(bf16x8, w); }
    __syncthreads();
    bf16* op = cat + (size_t)(r0 + c15) * DM + MIXW + h * XHD + 4 * q4;
#pragma unroll 4
    for (int db = 0; db < 16; ++db) { f32x4 acc = {0.f, 0.f, 0.f, 0.f};
#pragma unroll
        for (int s = 0; s < 8; ++s) acc = __builtin_amdgcn_mfma_f32_16x16x32_bf16(*(const LAS bf16x8*)(fp + (16 * db) * XA_PITCH + 64 * s), pf[s], acc, 0, 0, 0);
        v2u o; o.x = pk2(acc[0] * inv, acc[1] * inv); o.y = pk2(acc[2] * inv, acc[3] * inv);
        *(GAS v2u*)(op + 16 * db) = o; }
    __syncthreads();
}

__device__ __forceinline__ void sc_gate_phase(int gw, int NGW, int lane, const bf16* proj, const float* convw, bf16* cat) {
    for (int task = gw; task < (MROWS / 16) * 6; task += NGW) {
        const int row0 = (task / 6) * 16, c = (task % 6) * 512 + lane * 8;
        float cw[3][8];
#pragma unroll
        for (int j = 0; j < 3; ++j) { const f32x4 a = *(const GAS f32x4*)(convw + j * MIXW + c), b = *(const GAS f32x4*)(convw + j * MIXW + c + 4);
            cw[j][0] = a[0]; cw[j][1] = a[1]; cw[j][2] = a[2]; cw[j][3] = a[3]; cw[j][4] = b[0]; cw[j][5] = b[1]; cw[j][6] = b[2]; cw[j][7] = b[3]; }
        float u2[8], u1[8];
#pragma unroll
        for (int e = 0; e < 8; ++e) { u2[e] = 0.f; u1[e] = 0.f; }
        if ((row0 % SEQ) != 0) {
#pragma unroll
            for (int hrow = 0; hrow < 2; ++hrow) { const bf16* pr = proj + (size_t)(row0 - 2 + hrow) * SC_IN + c;
                const v4u cv = __builtin_nontemporal_load((const GAS v4u*)(pr + MIXW)), hv = __builtin_nontemporal_load((const GAS v4u*)(pr + 2 * MIXW));
#pragma unroll
                for (int q = 0; q < 4; ++q) { const float a = bflo(cv[q]) * bflo(hv[q]), b = bfhi(cv[q]) * bfhi(hv[q]);
                    if (hrow == 0) { u2[2 * q] = a; u2[2 * q + 1] = b; } else { u1[2 * q] = a; u1[2 * q + 1] = b; } } }
        }
#pragma unroll 4
        for (int r = 0; r < 16; ++r) { const bf16* pr = proj + (size_t)(row0 + r) * SC_IN + c;
            const v4u bv = __builtin_nontemporal_load((const GAS v4u*)(pr)), cv = __builtin_nontemporal_load((const GAS v4u*)(pr + MIXW)), hv = __builtin_nontemporal_load((const GAS v4u*)(pr + 2 * MIXW));
            float u0[8], y[8];
#pragma unroll
            for (int q = 0; q < 4; ++q) { u0[2 * q] = bflo(cv[q]) * bflo(hv[q]); u0[2 * q + 1] = bfhi(cv[q]) * bfhi(hv[q]); }
#pragma unroll
            for (int q = 0; q < 4; ++q) {
                y[2 * q] = bflo(bv[q]) * (cw[0][2 * q] * u2[2 * q] + cw[1][2 * q] * u1[2 * q] + cw[2][2 * q] * u0[2 * q]);
                y[2 * q + 1] = bfhi(bv[q]) * (cw[0][2 * q + 1] * u2[2 * q + 1] + cw[1][2 * q + 1] * u1[2 * q + 1] + cw[2][2 * q + 1] * u0[2 * q + 1]); }
            v4u o; o.x = pk2(y[0], y[1]); o.y = pk2(y[2], y[3]); o.z = pk2(y[4], y[5]); o.w = pk2(y[6], y[7]);
            *(GAS v4u*)(cat + (size_t)(row0 + r) * DM + c) = o;
#pragma unroll
            for (int e = 0; e < 8; ++e) { u2[e] = u1[e]; u1[e] = u0[e]; } }
    }
}

constexpr int NCHUNK = SEQ / 64;
constexpr int CHB_WC = 0, CHB_QD = 16384, CHB_IN = 32768, CHB_KT = 40960, CHB_BYTES = 57344;
constexpr int P2_PITCH = 272;
constexpr int P2_GC = 0, P2_BETA = 256, P2_EG = 512, P2_Q = 768, P2_K = P2_Q + 64 * P2_PITCH, P2_V = P2_K + 64 * P2_PITCH, P2_A = P2_V + 64 * P2_PITCH, P2_HALF = P2_A + 16384;
__device__ __forceinline__ int kperm_pos(int col) { const int o = col & 31; return (col & ~31) + 8 * ((o & 15) >> 2) + (o & 3) + ((o >> 4) << 2); }
__device__ __forceinline__ unsigned short bf1(float x) { return (unsigned short)(pk2(x, 0.f) & 0xffffu); }
__device__ __forceinline__ float ldbf(const LAS unsigned char* p) { return __uint_as_float((unsigned)(*(const LAS unsigned short*)p) << 16); }

__device__ __forceinline__ void gdn_chunk_phase(int c, int G, int tid, LAS unsigned char* ldsb, const bf16* proj, const float* convw, const float* aux, const float* alog, const float* dtb, unsigned char* chb, float* utb, float* cdb) {
    const int half = __builtin_amdgcn_readfirstlane(tid >> 8), w4 = __builtin_amdgcn_readfirstlane((tid >> 6) & 3);
    const int role = half ? (w4 - 2) : w4;
    const int ew = half ? w4 : (w4 - 2);
    const bool isE = (ew == 0 || ew == 1);
    const int npair = (NBATCH * GH * NCHUNK) / 2;
#define P2_FRESH() unsigned lbv = (unsigned)(size_t)(ldsb + half * P2_HALF), afv = lbv + P2_A; asm volatile("" : "+v"(lbv)); asm volatile("" : "+v"(afv)); \
        LAS unsigned char* lb = (LAS unsigned char*)(size_t)lbv; LAS float* Af = (LAS float*)(size_t)afv; LAS float* gcs = (LAS float*)(lb + P2_GC); LAS float* bts = (LAS float*)(lb + P2_BETA); LAS float* egs = (LAS float*)(lb + P2_EG); \
        const int t = opq_v(tid) & 255, lane = t & 63; (void)Af; (void)gcs; (void)bts; (void)egs; (void)lane; (void)t
    v4u tr[3][8]; float gq = 0.f, bq = 0.f;
#define P2_BUILD(ci_) do { const int n_ = (ci_) % NCHUNK, bh_ = (ci_) / NCHUNK, h_ = bh_ % GH, b_ = bh_ / GH; const size_t row0_ = (size_t)b_ * SEQ + (size_t)n_ * 64; \
        const int ln_ = opq_v(tid) & 63, tt_ = ew * 64 + ln_, cg_ = tt_ & 15, rg_ = tt_ >> 4; \
        if (ew == 0) { const float bi = aux[(row0_ + ln_) * 64 + h_], ai = aux[(row0_ + ln_) * 64 + GH + h_] + dtb[h_]; \
            const float e_ = __expf(ai);   \
            const float sp = ai > 20.f ? ai : (e_ < 0.01f ? e_ * (1.0f - e_ * (0.5f - e_ * 0.33333334f)) : __logf(1.0f + e_)); gq = -__expf(alog[h_]) * sp; bq = 1.0f / (1.0f + __expf(-bi)); } \
        asm volatile("" : "+v"(gq), "+v"(bq)); \
        _Pragma("unroll") for (int ty = 0; ty < 3; ++ty) { const int ch = ty * MIXW + h_ * GHD + cg_ * 8; \
            float cw[4][8]; \
            _Pragma("unroll") for (int j = 0; j < 4; ++j) { const f32x4 a = *(const GAS f32x4*)(convw + j * (3 * MIXW) + ch), b4 = *(const GAS f32x4*)(convw + j * (3 * MIXW) + ch + 4); \
                cw[j][0] = a[0]; cw[j][1] = a[1]; cw[j][2] = a[2]; cw[j][3] = a[3]; cw[j][4] = b4[0]; cw[j][5] = b4[1]; cw[j][6] = b4[2]; cw[j][7] = b4[3]; } \
            v4u xr[11]; \
            _Pragma("unroll") for (int rr = 0; rr < 11; ++rr) { const int lr = 8 * rg_ - 3 + rr; \
                xr[rr] = (lr < 0 && n_ == 0) ? (v4u){0u, 0u, 0u, 0u} : *(const GAS v4u*)(proj + (size_t)((long)row0_ + lr) * GDN_LD + ch); } \
            const float post = (ty == 0) ? 0.08838834764831845f : 1.0f; \
            _Pragma("unroll") for (int r = 0; r < 8; ++r) { float y[8]; float ss = 0.f; \
                _Pragma("unroll") for (int q = 0; q < 4; ++q) { \
                    const float v0 = cw[0][2 * q] * bflo(xr[r][q]) + cw[1][2 * q] * bflo(xr[r + 1][q]) + cw[2][2 * q] * bflo(xr[r + 2][q]) + cw[3][2 * q] * bflo(xr[r + 3][q]); \
                    const float v1 = cw[0][2 * q + 1] * bfhi(xr[r][q]) + cw[1][2 * q + 1] * bfhi(xr[r + 1][q]) + cw[2][2 * q + 1] * bfhi(xr[r + 2][q]) + cw[3][2 * q + 1] * bfhi(xr[r + 3][q]); \
                    y[2 * q] = silu_f(v0); y[2 * q + 1] = silu_f(v1); ss += y[2 * q] * y[2 * q] + y[2 * q + 1] * y[2 * q + 1]; } \
                if (ty < 2) { ss = grp16_sum(ss); const float sc = post / sqrtf(ss + EPS); \
                    _Pragma("unroll") for (int e = 0; e < 8; ++e) y[e] *= sc; } \
                tr[ty][r].x = pk2(y[0], y[1]); tr[ty][r].y = pk2(y[2], y[3]); tr[ty][r].z = pk2(y[4], y[5]); tr[ty][r].w = pk2(y[6], y[7]); } } \
    } while (0)
    if (isE) {
        if (c < npair) P2_BUILD(c * 2 + half);
        for (int pr = c; pr < npair; pr += G) {
            const int ci = pr * 2 + half;
            unsigned char* blob = chb + (size_t)ci * CHB_BYTES;
        { P2_FRESH();
            const int tt = ew * 64 + lane, cg = tt & 15, rg = tt >> 4;
#pragma unroll
            for (int ty = 0; ty < 3; ++ty)
#pragma unroll
                for (int r = 0; r < 8; ++r) *(LAS v4u*)(lb + P2_Q + ty * (64 * P2_PITCH) + (8 * rg + r) * P2_PITCH + cg * 16) = tr[ty][r];
            if (ew == 0) { float g = gq;
#pragma unroll
                for (int o = 1; o < 64; o <<= 1) { const float y = __shfl_up(g, o); if (lane >= o) g += y; }
                gcs[lane] = g; bts[lane] = bq; egs[lane] = __expf(g); }
        }
        __syncthreads();
        { P2_FRESH();
            const int i15 = lane & 15, q4 = lane >> 4;
            bf16x8 kA[4], qA[4];
#pragma unroll
            for (int s = 0; s < 4; ++s) { kA[s] = *(const LAS bf16x8*)(lb + P2_K + (16 * w4 + i15) * P2_PITCH + (32 * s + 8 * q4) * 2);
                                          qA[s] = *(const LAS bf16x8*)(lb + P2_Q + (16 * w4 + i15) * P2_PITCH + (32 * s + 8 * q4) * 2); }
            bf16* In = (bf16*)(blob + CHB_IN);
#pragma unroll
            for (int nb = 0; nb < 4; ++nb) {
                const int jg = 16 * nb + i15;
                if (nb <= w4) {
                    f32x4 akk = {0.f, 0.f, 0.f, 0.f}, aqk = {0.f, 0.f, 0.f, 0.f};
#pragma unroll
                    for (int s = 0; s < 4; ++s) { const bf16x8 kB = *(const LAS bf16x8*)(lb + P2_K + (16 * nb + i15) * P2_PITCH + (32 * s + 8 * q4) * 2);
                        akk = __builtin_amdgcn_mfma_f32_16x16x32_bf16(kA[s], kB, akk, 0, 0, 0); aqk = __builtin_amdgcn_mfma_f32_16x16x32_bf16(qA[s], kB, aqk, 0, 0, 0); }
                    const float gj = gcs[jg];
#pragma unroll
                    for (int r = 0; r < 4; ++r) { const int ig = 16 * w4 + 4 * q4 + r;
                        const float dec = (ig >= jg) ? __expf(gcs[ig] - gj) : 0.f;
                        Af[ig * 64 + jg] = (ig > jg) ? bts[ig] * akk[r] * dec : 0.f;
                        *(GAS unsigned short*)(In + ig * 64 + kperm_pos(jg)) = bf1(aqk[r] * dec); }
                } else {
#pragma unroll
                    for (int r = 0; r < 4; ++r) { const int ig = 16 * w4 + 4 * q4 + r; *(GAS unsigned short*)(In + ig * 64 + kperm_pos(jg)) = 0; }
                }
            }
        }
        __syncthreads();
        { P2_FRESH();
            const int t2 = ew * 64 + lane;
#pragma unroll
            for (int ps = 0; ps < 2; ++ps) { const int tt = t2 + 128 * ps; const int i = tt >> 2, cseg = (tt & 3) * 32; const float e = egs[i];
                v4u sv[4];
#pragma unroll
                for (int q = 0; q < 4; ++q) { const v4u xv = *(const LAS v4u*)(lb + P2_Q + i * P2_PITCH + (cseg + 8 * q) * 2);
                    sv[q].x = pk2(bflo(xv.x) * e, bfhi(xv.x) * e); sv[q].y = pk2(bflo(xv.y) * e, bfhi(xv.y) * e); sv[q].z = pk2(bflo(xv.z) * e, bfhi(xv.z) * e); sv[q].w = pk2(bflo(xv.w) * e, bfhi(xv.w) * e); }
#pragma unroll
                for (int q = 0; q < 4; ++q) { const v4u lo = sv[q >> 1], hi = sv[2 + (q >> 1)];
                    v4u o; o.x = (q & 1) ? lo.z : lo.x; o.y = (q & 1) ? lo.w : lo.y; o.z = (q & 1) ? hi.z : hi.x; o.w = (q & 1) ? hi.w : hi.y;
                    *(GAS v4u*)(blob + CHB_QD + (i * 128 + cseg + 8 * q) * 2) = o; } }
            const float gl = gcs[63];
#pragma unroll
            for (int ps = 0; ps < 2; ++ps) { const int d = t2, hh = ps; float y[32];
#pragma unroll
                for (int jj = 0; jj < 32; ++jj) { const int i = 32 * hh + jj; y[jj] = ldbf(lb + P2_K + i * P2_PITCH + d * 2) * __expf(gl - gcs[i]); }
#pragma unroll
                for (int q = 0; q < 4; ++q) { v4u o; o.x = pk2(y[4 * q], y[4 * q + 1]); o.y = pk2(y[4 * q + 2], y[4 * q + 3]); o.z = pk2(y[16 + 4 * q], y[16 + 4 * q + 1]); o.w = pk2(y[16 + 4 * q + 2], y[16 + 4 * q + 3]);
                    *(GAS v4u*)(blob + CHB_KT + (d * 64 + 32 * hh + 8 * q) * 2) = o; } }
            if (t2 == 0) cdb[ci] = __expf(gl);
            if (pr + G < npair) P2_BUILD((pr + G) * 2 + half);
        }
        __syncthreads();
        }
    } else {
        for (int pr = c; pr < npair; pr += G) {
            const int ci = pr * 2 + half;
            unsigned char* blob = chb + (size_t)ci * CHB_BYTES;
        __syncthreads();
        { P2_FRESH();
            const int i15 = lane & 15, q4 = lane >> 4;
            bf16x8 kA[4], qA[4];
#pragma unroll
            for (int s = 0; s < 4; ++s) { kA[s] = *(const LAS bf16x8*)(lb + P2_K + (16 * w4 + i15) * P2_PITCH + (32 * s + 8 * q4) * 2);
                                          qA[s] = *(const LAS bf16x8*)(lb + P2_Q + (16 * w4 + i15) * P2_PITCH + (32 * s + 8 * q4) * 2); }
            bf16* In = (bf16*)(blob + CHB_IN);
#pragma unroll
            for (int nb = 0; nb < 4; ++nb) {
                const int jg = 16 * nb + i15;
                if (nb <= w4) {
                    f32x4 akk = {0.f, 0.f, 0.f, 0.f}, aqk = {0.f, 0.f, 0.f, 0.f};
#pragma unroll
                    for (int s = 0; s < 4; ++s) { const bf16x8 kB = *(const LAS bf16x8*)(lb + P2_K + (16 * nb + i15) * P2_PITCH + (32 * s + 8 * q4) * 2);
                        akk = __builtin_amdgcn_mfma_f32_16x16x32_bf16(kA[s], kB, akk, 0, 0, 0); aqk = __builtin_amdgcn_mfma_f32_16x16x32_bf16(qA[s], kB, aqk, 0, 0, 0); }
                    const float gj = gcs[jg];
#pragma unroll
                    for (int r = 0; r < 4; ++r) { const int ig = 16 * w4 + 4 * q4 + r;
                        const float dec = (ig >= jg) ? __expf(gcs[ig] - gj) : 0.f;
                        Af[ig * 64 + jg] = (ig > jg) ? bts[ig] * akk[r] * dec : 0.f;
                        *(GAS unsigned short*)(In + ig * 64 + kperm_pos(jg)) = bf1(aqk[r] * dec); }
                } else {
#pragma unroll
                    for (int r = 0; r < 4; ++r) { const int ig = 16 * w4 + 4 * q4 + r; *(GAS unsigned short*)(In + ig * 64 + kperm_pos(jg)) = 0; }
                }
            }
        }
        __syncthreads();
        { P2_FRESH();
            f32x2 x[64];
            const LAS unsigned char* tp = lb + (role ? P2_K : P2_V) + lane * 2;
#pragma unroll
            for (int g8 = 0; g8 < 8; ++g8) {
#pragma unroll
                for (int ii = 0; ii < 8; ++ii) { const int i = 8 * g8 + ii; const float e = egs[i], sc = bts[i] * (role ? e : 1.0f);
                    x[i] = (f32x2){ldbf(tp + i * P2_PITCH) * sc, ldbf(tp + i * P2_PITCH + 128) * sc}; asm volatile("" : "+v"(x[i])); }
                __builtin_amdgcn_sched_barrier(0);
            }
            f32x4 cur[4], nxt[4];
            cur[0] = *(const LAS f32x4*)(Af + 64);
#define P2_ROWS(NSEG, ILO, IHI) \
            _Pragma("unroll") for (int i = (ILO); i <= (IHI); ++i) { \
                f32x2 a0 = x[i], a1 = {0.f, 0.f}; \
                _Pragma("unroll") for (int sg = 0; sg < (NSEG); ++sg) { \
                    const bool more = (sg + 1 < (NSEG)); const int ni = more ? i : i + 1, nsg = more ? sg + 1 : 0; \
                    if (ni < 64) { _Pragma("unroll") for (int q = 0; q < 4; ++q) if (16 * nsg + 4 * q < ni) nxt[q] = *(const LAS f32x4*)(Af + ni * 64 + 16 * nsg + 4 * q); } \
                    __builtin_amdgcn_sched_barrier(0); \
                    _Pragma("unroll") for (int jj = 0; jj < (more ? 16 : i - 16 * sg); ++jj) { const int j = 16 * sg + jj; const float aij = cur[jj >> 2][jj & 3]; if (j & 1) a1 -= x[j] * aij; else a0 -= x[j] * aij; } \
                    __builtin_amdgcn_sched_barrier(0); \
                    _Pragma("unroll") for (int q = 0; q < 4; ++q) cur[q] = nxt[q]; \
                } \
                x[i] = a0 + a1; \
            }
            P2_ROWS(1, 1, 16)
            P2_ROWS(2, 17, 32)
            P2_ROWS(3, 33, 48)
            P2_ROWS(4, 49, 63)
#undef P2_ROWS
            if (role == 0) { float* up = utb + (size_t)ci * 8192 + lane * 64;
#pragma unroll
                for (int i = 0; i < 16; ++i) { *(GAS f32x4*)(up + 4 * i) = (f32x4){x[4 * i][0], x[4 * i + 1][0], x[4 * i + 2][0], x[4 * i + 3][0]};
                                               *(GAS f32x4*)(up + 4096 + 4 * i) = (f32x4){x[4 * i][1], x[4 * i + 1][1], x[4 * i + 2][1], x[4 * i + 3][1]}; } }
            else { bf16* wp = (bf16*)(blob + CHB_WC) + kperm_pos(lane);
#pragma unroll
                for (int i = 0; i < 64; ++i) { *(GAS unsigned short*)(wp + i * 128) = bf1(x[i][0]); *(GAS unsigned short*)(wp + i * 128 + 64) = bf1(x[i][1]); } }
        }
        __syncthreads();
        }
    }
#undef P2_BUILD
#undef P2_FRESH
}

constexpr int S2_WC = 0, S2_QD = 18432, S2_IN = 36864, S2_KT = 47104, S2_BUF = 67584;
__device__ __forceinline__ bf16x8 s2_frag(const LAS unsigned char* p) { return *(const LAS bf16x8*)p; }
__device__ __forceinline__ bf16x8 s2_pack(const f32x4& a, const f32x4& b) { v4u w; w.x = pk2(a[0], a[1]); w.y = pk2(a[2], a[3]); w.z = pk2(b[0], b[1]); w.w = pk2(b[2], b[3]); return __builtin_bit_cast(bf16x8, w); }
__device__ __forceinline__ void gdn_scan2_unit(int bh, LAS unsigned char* ldsb, const unsigned char* chb, const float* utb, const float* cdb, bf16* O, int tid, int wave, int lane) {
    const int b = bh / GH, h = bh % GH, i15 = lane & 15, q4 = lane >> 4, n0 = wave * 16;
    const size_t ci0 = (size_t)bh * NCHUNK;
    f32x4 S[8];
#pragma unroll
    for (int kb = 0; kb < 8; ++kb) S[kb] = (f32x4){0.f, 0.f, 0.f, 0.f};
    v4u r[7]; f32x4 utn[4], ocp[4];
#define S2_STORE_O(cc_) do { bf16* op_ = O + ((size_t)b * SEQ + (size_t)(cc_) * 64 + 4 * q4) * MIXW + h * GHD + n0 + i15; \
        _Pragma("unroll") for (int mb = 0; mb < 4; ++mb) _Pragma("unroll") for (int j = 0; j < 4; ++j) *(GAS unsigned short*)(op_ + (size_t)(16 * mb + j) * MIXW) = bf1(ocp[mb][j]); } while (0)
#define S2_ISSUE(cc_) do { const unsigned char* bp_ = chb + (ci0 + (cc_)) * CHB_BYTES + tid * 16; \
        _Pragma("unroll") for (int e = 0; e < 7; ++e) r[e] = __builtin_nontemporal_load((const GAS v4u*)(bp_ + e * 8192)); \
        const float* up_ = utb + (ci0 + (cc_)) * 8192 + (n0 + i15) * 64 + 4 * q4; \
        _Pragma("unroll") for (int mb = 0; mb < 4; ++mb) utn[mb] = __builtin_nontemporal_load((const GAS f32x4*)(up_ + 16 * mb)); } while (0)
    S2_ISSUE(0);
#if defined(TPROBE) && TPROBE >= 11 && TPROBE <= 13
    volatile LAS unsigned* MISCp = (volatile LAS unsigned*)(ldsb - RING_OFF + MISC_OFF); const bool prb = (bh == 0 && tid == 0);
#define S2_T0() unsigned long long pt0_ = prb ? __builtin_amdgcn_s_memrealtime() : 0ull
#define S2_T1(k) do { if ((k) == TPROBE && prb) { const unsigned long long d_ = __builtin_amdgcn_s_memrealtime() - pt0_; const unsigned long long a_ = ((((unsigned long long)MISCp[19] << 32) | MISCp[18])) + d_; MISCp[18] = (unsigned)a_; MISCp[19] = (unsigned)(a_ >> 32); } } while (0)
#else
#define S2_T0() do {} while (0)
#define S2_T1(k) do {} while (0)
#endif
    for (int cc = 0; cc < NCHUNK; ++cc) {
        LAS unsigned char* buf = ldsb + (cc & 1) * S2_BUF;
        { S2_T0(); asm volatile("s_waitcnt vmcnt(0)" ::: "memory"); S2_T1(11); }
        *(LAS v4u*)(buf + S2_WC + (tid >> 4) * 288 + (tid & 15) * 16) = r[0];
        *(LAS v4u*)(buf + S2_WC + ((tid + 512) >> 4) * 288 + (tid & 15) * 16) = r[1];
        *(LAS v4u*)(buf + S2_QD + (tid >> 4) * 288 + (tid & 15) * 16) = r[2];
        *(LAS v4u*)(buf + S2_QD + ((tid + 512) >> 4) * 288 + (tid & 15) * 16) = r[3];
        *(LAS v4u*)(buf + S2_IN + (tid >> 3) * 160 + (tid & 7) * 16) = r[4];
        *(LAS v4u*)(buf + S2_KT + (tid >> 3) * 160 + (tid & 7) * 16) = r[5];
        *(LAS v4u*)(buf + S2_KT + ((tid + 512) >> 3) * 160 + (tid & 7) * 16) = r[6];
        f32x4 ut[4];
#pragma unroll
        for (int mb = 0; mb < 4; ++mb) ut[mb] = utn[mb];
        const float cd = cdb[ci0 + cc];
        { S2_T0(); __syncthreads(); S2_T1(12); }
        S2_T0();
        if (cc > 0) S2_STORE_O(cc - 1);
        if (cc + 1 < NCHUNK) S2_ISSUE(cc + 1);
        bf16x8 sb[4];
#pragma unroll
        for (int s = 0; s < 4; ++s) sb[s] = s2_pack(S[2 * s], S[2 * s + 1]);
#define S2_LD4x2(dst, base, pitch, s0) do { _Pragma("unroll") for (int e_ = 0; e_ < 8; ++e_) dst[e_] = s2_frag(buf + (base) + (16 * (e_ & 3) + i15) * (pitch) + (32 * ((s0) + (e_ >> 2)) + 8 * q4) * 2); } while (0)
#define S2_LD8x1(dst, base, pitch, s0) do { _Pragma("unroll") for (int e_ = 0; e_ < 8; ++e_) dst[e_] = s2_frag(buf + (base) + (16 * e_ + i15) * (pitch) + (32 * (s0) + 8 * q4) * 2); } while (0)
#define S2_SB() __builtin_amdgcn_sched_barrier(0)
        bf16x8 fa[8], fb[8];
        f32x4 vn[4], oc[4];
#pragma unroll
        for (int mb = 0; mb < 4; ++mb) { vn[mb] = (f32x4){0.f, 0.f, 0.f, 0.f}; oc[mb] = (f32x4){0.f, 0.f, 0.f, 0.f}; }
        S2_LD4x2(fa, S2_WC, 288, 0); S2_LD4x2(fb, S2_WC, 288, 2); S2_SB();
#pragma unroll
        for (int e = 0; e < 8; ++e) vn[e & 3] = __builtin_amdgcn_mfma_f32_16x16x32_bf16(fa[e], sb[e >> 2], vn[e & 3], 0, 0, 0);
        S2_SB(); S2_LD4x2(fa, S2_QD, 288, 0); S2_SB();
#pragma unroll
        for (int e = 0; e < 8; ++e) vn[e & 3] = __builtin_amdgcn_mfma_f32_16x16x32_bf16(fb[e], sb[2 + (e >> 2)], vn[e & 3], 0, 0, 0);
        S2_SB(); S2_LD4x2(fb, S2_QD, 288, 2); S2_SB();
#pragma unroll
        for (int e = 0; e < 8; ++e) oc[e & 3] = __builtin_amdgcn_mfma_f32_16x16x32_bf16(fa[e], sb[e >> 2], oc[e & 3], 0, 0, 0);
        S2_SB(); S2_LD4x2(fa, S2_IN, 160, 0); S2_SB();
#pragma unroll
        for (int mb = 0; mb < 4; ++mb) vn[mb] = ut[mb] - vn[mb];
        bf16x8 vb[2];
        vb[0] = s2_pack(vn[0], vn[1]); vb[1] = s2_pack(vn[2], vn[3]);
#pragma unroll
        for (int e = 0; e < 8; ++e) oc[e & 3] = __builtin_amdgcn_mfma_f32_16x16x32_bf16(fb[e], sb[2 + (e >> 2)], oc[e & 3], 0, 0, 0);
        S2_SB(); S2_LD8x1(fb, S2_KT, 160, 0); S2_SB();
#pragma unroll
        for (int e = 0; e < 8; ++e) oc[e & 3] = __builtin_amdgcn_mfma_f32_16x16x32_bf16(fa[e], vb[e >> 2], oc[e & 3], 0, 0, 0);
        S2_SB(); S2_LD8x1(fa, S2_KT, 160, 1); S2_SB();
#pragma unroll
        for (int kb = 0; kb < 8; ++kb) S[kb] = __builtin_amdgcn_mfma_f32_16x16x32_bf16(fb[kb], vb[0], S[kb] * cd, 0, 0, 0);
        S2_SB();
#pragma unroll
        for (int mb = 0; mb < 4; ++mb) ocp[mb] = oc[mb];
        asm volatile("" :: "v"(S[0]), "v"(S[7]), "v"(ocp[3])); S2_T1(13);
#pragma unroll
        for (int kb = 0; kb < 8; ++kb) S[kb] = __builtin_amdgcn_mfma_f32_16x16x32_bf16(fa[kb], vb[1], S[kb], 0, 0, 0);
#undef S2_LD4x2
#undef S2_LD8x1
#undef S2_SB
    }
    S2_STORE_O(NCHUNK - 1);
    __syncthreads();
#undef S2_STORE_O
#undef S2_ISSUE
}

__device__ __forceinline__ void gdn_out_phase(int gw, int NGW, int lane, const bf16* O, const bf16* proj, const float* normg, bf16* cat) {
    const int dl = (lane & 15) * 8;
    const f32x4 g0 = *(const GAS f32x4*)(normg + dl), g1 = *(const GAS f32x4*)(normg + dl + 4);
    for (int row = gw; row < MROWS; row += NGW) {
#pragma unroll 2
        for (int it = 0; it < 6; ++it) { const int ch = (it * 4 + (lane >> 4)) * GHD + dl;
            const v4u ov = __builtin_nontemporal_load((const GAS v4u*)(O + (size_t)row * MIXW + ch)); const f32x4 o0 = {bflo(ov.x), bfhi(ov.x), bflo(ov.y), bfhi(ov.y)}, o1 = {bflo(ov.z), bfhi(ov.z), bflo(ov.w), bfhi(ov.w)};
            const v4u zv = __builtin_nontemporal_load((const GAS v4u*)(proj + (size_t)row * GDN_LD + 3 * MIXW + ch));
            float ss = (o0[0] * o0[0] + o0[1] * o0[1]) + (o0[2] * o0[2] + o0[3] * o0[3]) + (o1[0] * o1[0] + o1[1] * o1[1]) + (o1[2] * o1[2] + o1[3] * o1[3]);
            ss = grp16_sum(ss);
            const float r = 1.0f / sqrtf(ss * (1.0f / GHD) + EPS);
            float y[8];
            y[0] = o0[0] * r * g0[0] * silu_f(bflo(zv[0])); y[1] = o0[1] * r * g0[1] * silu_f(bfhi(zv[0])); y[2] = o0[2] * r * g0[2] * silu_f(bflo(zv[1])); y[3] = o0[3] * r * g0[3] * silu_f(bfhi(zv[1]));
            y[4] = o1[0] * r * g1[0] * silu_f(bflo(zv[2])); y[5] = o1[1] * r * g1[1] * silu_f(bfhi(zv[2])); y[6] = o1[2] * r * g1[2] * silu_f(bflo(zv[3])); y[7] = o1[3] * r * g1[3] * silu_f(bfhi(zv[3]));
            v4u w; w.x = pk2(y[0], y[1]); w.y = pk2(y[2], y[3]); w.z = pk2(y[4], y[5]); w.w = pk2(y[6], y[7]);
            *(GAS v4u*)(cat + (size_t)row * DM + ch) = w; }
    }
}

typedef unsigned char* const __attribute__((address_space(4)))* karg_tab_t;
__device__ __forceinline__ unsigned char* karg_ptr(int i) { asm volatile("" : "+s"(i)); return ((karg_tab_t)__builtin_amdgcn_kernarg_segment_ptr())[i]; }
#define INP(i) ((const float*)karg_ptr(i))
#define WSP(off) (karg_ptr(20) + (off))

__global__ void __launch_bounds__(NWAVES * 64, 2) fwd_kernel(Args args) {
    extern __shared__ __attribute__((aligned(16))) unsigned char lds[];
    LAS unsigned char* L = (LAS unsigned char*)lds;
    volatile LAS unsigned* MISC = (volatile LAS unsigned*)(L + MISC_OFF);
    const int tid0 = threadIdx.x;
    const int G = gridDim.x, c = blockIdx.x;
#define tid (opq_v(tid0))
#define lane (opq_v(tid0) & 63)
#define wave (__builtin_amdgcn_readfirstlane(opq_v(tid0) >> 6))
#define gw (opq_s(c) * NWAVES + __builtin_amdgcn_readfirstlane(opq_v(tid0) >> 6))
#define NGW (opq_s(G) * NWAVES)
    for (int u = tid0; u < (LDS_BYTES - LDSCTL_OFF) / 4; u += NWAVES * 64) ((LAS unsigned*)(L + LDSCTL_OFF))[u] = 0u;
    __syncthreads();
    (void)xcd_barrier_post((unsigned*)(WSP(WS_CTL)) + CW_BAR, MISC + 8);
#define GRID_BAR() do { XcdBarrier bar_; bar_.bar = (unsigned*)(WSP(WS_CTL)) + CW_BAR; bar_.x = xb_xcc_id(); bar_.st = MISC + 8; xcd_barrier(bar_); } while (0)
#if defined(TPROBE) && TPROBE == 8
#define TP_BEGIN(k) do { if ((k) == 3 && c == 0 && tid0 == 0) { const unsigned long long t_ = __builtin_amdgcn_s_memrealtime(), y_ = __builtin_amdgcn_s_memtime(); MISC[16] = (unsigned)t_; MISC[17] = (unsigned)(t_ >> 32); MISC[20] = (unsigned)y_; MISC[21] = (unsigned)(y_ >> 32); } } while (0)
#define TP_END(k) do { if ((k) == 3 && c == 0 && tid0 == 0) { const unsigned long long t_ = __builtin_amdgcn_s_memrealtime() - (((unsigned long long)MISC[17] << 32) | MISC[16]), y_ = __builtin_amdgcn_s_memtime() - (((unsigned long long)MISC[21] << 32) | MISC[20]); \
        const unsigned long long a_ = ((((unsigned long long)MISC[19] << 32) | MISC[18])) + t_, b_ = ((((unsigned long long)MISC[23] << 32) | MISC[22])) + y_; MISC[18] = (unsigned)a_; MISC[19] = (unsigned)(a_ >> 32); MISC[22] = (unsigned)b_; MISC[23] = (unsigned)(b_ >> 32); } } while (0)
#elif defined(TPROBE)
#define TP_BEGIN(k) do { if ((k) == TPROBE && c == 0 && tid0 == 0) { const unsigned long long t_ = __builtin_amdgcn_s_memrealtime(); MISC[16] = (unsigned)t_; MISC[17] = (unsigned)(t_ >> 32); } } while (0)
#define TP_END(k) do { if ((k) == TPROBE && c == 0 && tid0 == 0) { const unsigned long long t_ = __builtin_amdgcn_s_memrealtime() - (((unsigned long long)MISC[17] << 32) | MISC[16]); \
        const unsigned long long a_ = ((((unsigned long long)MISC[19] << 32) | MISC[18])) + t_; MISC[18] = (unsigned)a_; MISC[19] = (unsigned)(a_ >> 32); } } while (0)
#else
#define TP_BEGIN(k) do {} while (0)
#define TP_END(k) do {} while (0)
#endif
#ifdef NO_P0
#define PH_P0(x)
#else
#define PH_P0(x) x
#endif
#ifdef NO_KV
#define PH_KV(x)
#else
#define PH_KV(x) x
#endif
#ifdef NO_GU
#define PH_GU(x)
#else
#define PH_GU(x) x
#endif
#ifdef NO_DN
#define PH_DN(x)
#else
#define PH_DN(x) x
#endif
#ifdef NO_NORM
#define PH_NORM(x)
#else
#define PH_NORM(x) x
#endif
#ifdef NO_SCIN
#define PH_SCIN(x)
#else
#define PH_SCIN(x) x
#endif
#ifdef NO_SCG
#define PH_SCG(x)
#else
#define PH_SCG(x) x
#endif
#ifdef NO_XA
#define PH_XA(x)
#else
#define PH_XA(x) x
#endif
#ifdef NO_GDNIN
#define PH_GDNIN(x)
#else
#define PH_GDNIN(x) x
#endif
#ifdef NO_PREP
#define PH_PREP(x)
#else
#define PH_PREP(x) x
#endif
#ifdef NO_GOUT
#define PH_GOUT(x)
#else
#define PH_GOUT(x) x
#endif
#ifdef NO_WOUT
#define PH_WOUT(x)
#else
#define PH_WOUT(x) x
#endif
#ifdef NO_SCAN
#define DO_SCAN(x)
#else
#define DO_SCAN(x) x
#endif

#define Hbuf ((bf16*)WSP(WS_H))
#define RS2 ((float*)WSP(WS_A))
#define OUTb ((bf16*)WSP(WS_OUT))
#define CAT ((bf16*)WSP(WS_CAT))
#define ACT ((bf16*)WSP(WS_ACT))
#define PROJ ((bf16*)WSP(WS_PROJ))
#define AUX ((float*)WSP(WS_AUX))
#define AB ((float*)WSP(WS_AB))
#define QKVN ((bf16*)WSP(WS_QKV))
#define OBUF ((bf16*)WSP(WS_O))
#define KVOPS ((bf16*)WSP(WS_KVOPS))
#define KB ((bf16*)WSP(WS_KB))
#define VTB ((bf16*)WSP(WS_VTB))
#define WGU ((bf16*)WSP(WS_WGU))
#define WDN ((bf16*)WSP(WS_WDN))
#define WOUT ((bf16*)WSP(WS_WOUT))
#define WSC ((bf16*)WSP(WS_WSC))
#define WGDN ((bf16*)WSP(WS_WGDN))
#define CHB ((unsigned char*)WSP(WS_CHB))
#define UTB ((float*)WSP(WS_UT))
#define CDB ((float*)WSP(WS_CD))

    TP_BEGIN(1);
#ifndef NO_P0
    {
        LAS float* scr = (LAS float*)(L + RING_OFF + wave * XP_SCR);
        long base = 0;
        for (int job = 0; job < 40; ++job) {
            const float* W; bf16* WT; int K, N, col0 = 0, ncols, nvalid, mode = 0, roff = 0;
            const float* gk = nullptr;
            if (job < 8)       { W = INP(I_WG) + (size_t)job * DM * DFF; K = DM; N = DFF; ncols = DFF; WT = WGU + (size_t)job * 2 * DFF * DM; mode = 1; roff = 0; gk = INP(I_FPRE) + (size_t)job * DM; }
            else if (job < 16) { W = INP(I_WU) + (size_t)(job - 8) * DM * DFF; K = DM; N = DFF; ncols = DFF; WT = WGU + (size_t)(job - 8) * 2 * DFF * DM; mode = 1; roff = 128; gk = INP(I_FPRE) + (size_t)(job - 8) * DM; }
            else if (job < 24) { W = INP(I_WD) + (size_t)(job - 16) * DFF * DM; K = DFF; N = DM; ncols = DM; WT = WDN + (size_t)(job - 16) * DM * DFF; }
            else if (job < 28) { W = INP(I_WOUT) + (size_t)(job - 24) * DM * DM; K = DM; N = DM; ncols = DM; WT = WOUT + (size_t)(job - 24) * DM * DM; }
            else if (job < 32) { W = INP(I_WKV) + (size_t)(job - 28) * DM * 2 * XW; K = DM; N = 2 * XW; ncols = 2 * XW; WT = KVOPS + ((size_t)(job - 28) * 3072 + 1024) * DM; }
            else if (job < 34) { W = INP(I_SCIN) + (size_t)(job - 32) * DM * SC_IN; K = DM; N = SC_IN; ncols = SC_IN; WT = WSC + (size_t)(job - 32) * SC_IN * DM; gk = INP(I_MPRE) + (size_t)(2 * (job - 32)) * DM; }
            else if (job < 36) { W = INP(I_GDNIN) + (size_t)(job - 34) * DM * GDN_SRC; K = DM; N = GDN_SRC; ncols = 4 * MIXW; WT = WGDN + (size_t)(job - 34) * GDN_N * DM; gk = INP(I_MPRE) + (size_t)(2 * (job - 34) + 1) * DM; }
            else if (job < 38) { W = INP(I_GDNIN) + (size_t)(job - 36) * DM * GDN_SRC; K = DM; N = GDN_SRC; col0 = 4 * MIXW + 2 * GH; ncols = XW; WT = WGDN + (size_t)(job - 36) * GDN_N * DM; roff = 4 * MIXW; gk = INP(I_MPRE) + (size_t)(2 * (job - 36) + 1) * DM; }
            else               { W = INP(I_GDNIN) + (size_t)(job - 38) * DM * GDN_SRC; K = DM; N = GDN_SRC; col0 = 4 * MIXW; ncols = 64; WT = WGDN + (size_t)(job - 38) * GDN_N * DM; roff = GDN_LD; gk = INP(I_MPRE) + (size_t)(2 * (job - 38) + 1) * DM; }
            nvalid = (job >= 38) ? 2 * GH : ncols;
            const int nblk = ncols / 64, items = (K / 64) * nblk;
            int first = (int)(((long)gw - base) % NGW); if (first < 0) first += NGW;
            const int step = NGW;
#define XP_DROW(nb_) (mode ? (256 * ((nb_) >> 1) + 64 * ((nb_) & 1) + roff) : (64 * (nb_) + roff))
            if (first < items) {
                f32x4 va[16], vb[16]; float ga[16], gb[16];
                int it = first;
                xpose_load(va, ga, W, N, col0, nvalid, 64 * (it / nblk), 64 * (it % nblk), lane, gk);
                for (;;) {
                    const int it1 = it + step;
                    if (it1 < items) xpose_load(vb, gb, W, N, col0, nvalid, 64 * (it1 / nblk), 64 * (it1 % nblk), lane, gk);
                    xpose_store(va, ga, WT, K, XP_DROW(it % nblk), scr, 64 * (it / nblk), lane);
                    if (it1 >= items) break;
                    const int it2 = it1 + step;
                    if (it2 < items) xpose_load(va, ga, W, N, col0, nvalid, 64 * (it2 / nblk), 64 * (it2 % nblk), lane, gk);
                    xpose_store(vb, gb, WT, K, XP_DROW(it1 % nblk), scr, 64 * (it1 / nblk), lane);
                    if (it2 >= items) break;
                    it = it2;
                }
            }
#undef XP_DROW
            base += items;
        }
        for (int r = gw; r < 2 * 192; r += NGW) { bf16* p = WGDN + ((size_t)(r / 192) * GDN_N + GDN_LD + 64 + (r % 192)) * DM;
#pragma unroll
            for (int j = 0; j < 8; ++j) *(GAS v4u*)(p + (j * 64 + lane) * 8) = (v4u){0u, 0u, 0u, 0u}; }
        for (int r = gw; r < NBATCH * MEMT; r += NGW) { const float* mr = INP(I_MEM) + (size_t)r * DM;
            f32x4 v[16]; float ss = 0.f;
#pragma unroll
            for (int j = 0; j < 16; ++j) { v[j] = *(const GAS f32x4*)(mr + (j * 64 + lane) * 4); ss += (v[j][0] * v[j][0] + v[j][1] * v[j][1]) + (v[j][2] * v[j][2] + v[j][3] * v[j][3]); }
            ss = wave_sum(ss); const float sc = 1.0f / sqrtf(ss * (1.0f / DM) + EPS);
            for (int l = 0; l < DEPTH; ++l) { const float* g = INP(I_MEMG) + (size_t)l * DM; bf16* dst = KVOPS + ((size_t)l * 3072 + r) * DM;
#pragma unroll
                for (int j = 0; j < 16; ++j) { const f32x4 gg = *(const GAS f32x4*)(g + (j * 64 + lane) * 4); const f32x4 a = v[j] * gg * sc;
                    v2u o; o.x = pk2(a[0], a[1]); o.y = pk2(a[2], a[3]); *(GAS v2u*)(dst + (j * 64 + lane) * 4) = o; } } }
        norm_phase(gw, NGW, lane, nullptr, 0.f, nullptr, INP(I_X), false, Hbuf, true, RS2);
    }
#endif
    GRID_BAR();
    TP_END(1);

#define FFN_GEMMS(f_) do { \
        TP_BEGIN(3); \
        { pg8::Gemm g{Hbuf, WGU + (size_t)(l * 2 + (f_)) * 2 * DFF * DM, MROWS, 2 * DFF, DM}; pg8::StaticOrder S; S.init(MROWS, 2 * DFF, opq_s(G), opq_s(c)); pg8::EpiSwiGLU E{ACT, DFF, RS2}; \
          PH_GU((pg8::gemm_phase<pg8::EpiSwiGLU, pg8::StaticOrder, PG8_ALIGN, PG8_SP2>(L + RING_OFF, g, S, E))); } \
        GRID_BAR(); \
        { pg8::Gemm g{ACT, WDN + (size_t)(l * 2 + (f_)) * DM * DFF, MROWS, DM, DFF}; pg8::StaticOrder S; S.init(MROWS, DM, opq_s(G), opq_s(c)); pg8::EpiProj E{OUTb, DM, nullptr, -1, nullptr}; \
          PH_DN((pg8::gemm_phase<pg8::EpiProj, pg8::StaticOrder, PG8_ALIGN, PG8_SP2>(L + RING_OFF, g, S, E))); } \
        GRID_BAR(); \
        TP_END(3); \
    } while (0)

    for (int l = 0; l < DEPTH; ++l) {
        const int j2 = l >> 1; const bool gdn = (l & 1) != 0;
        FFN_GEMMS(0);
        TP_BEGIN(6);
        { const int Gq = opq_s(G), cq = opq_s(c); const int nkv = (l == 0 && Gq > 64) ? 32 : 0;
          if (cq < nkv) { pg8::Gemm g{KVOPS, KVOPS, 4 * 3072, 4 * 3072, DM}; pg8::KvOrder S{nkv, cq, 0, 32}; pg8::EpiKV E{KB, VTB};
              PH_KV((pg8::gemm_phase<pg8::EpiKV, pg8::KvOrder, PG8_ALIGN, PG8_SP2>(L + RING_OFF, g, S, E))); }
          else { PH_NORM(norm_phase((cq - nkv) * NWAVES + wave, (Gq - nkv) * NWAVES, lane, OUTb, 0.5f, INP(I_FPOST) + (size_t)(l * 2) * DM, Hbuf, true, Hbuf, true, RS2);) }
          if (l == 0 && nkv == 0) { pg8::Gemm g{KVOPS, KVOPS, 4 * 3072, 4 * 3072, DM}; pg8::KvOrder S{Gq, cq, 0, 32}; pg8::EpiKV E{KB, VTB};
              PH_KV((pg8::gemm_phase<pg8::EpiKV, pg8::KvOrder, PG8_ALIGN, PG8_SP2>(L + RING_OFF, g, S, E))); } }
        GRID_BAR();
        TP_END(6);
        if (!gdn) {
            TP_BEGIN(3);
            { pg8::Gemm g{Hbuf, WSC + (size_t)j2 * SC_IN * DM, MROWS, SC_IN, DM}; pg8::StaticOrder S; S.init(MROWS, SC_IN, opq_s(G), opq_s(c)); pg8::EpiProj E{PROJ, SC_IN, nullptr, -1, RS2};
              PH_SCIN((pg8::gemm_phase<pg8::EpiProj, pg8::StaticOrder, PG8_ALIGN, PG8_SP2>(L + RING_OFF, g, S, E))); }
            GRID_BAR();
            TP_END(3);
            TP_BEGIN(4);
            PH_SCG(sc_gate_phase(gw, NGW, lane, PROJ, INP(I_SCCONV) + (size_t)j2 * 3 * MIXW, CAT);)
            for (int u = opq_s(c); u < 256; u += opq_s(G)) { PH_XA(xattn_unit(u, L + RING_OFF, PROJ, SC_IN, 3 * MIXW, KB + (size_t)l * 1048576, VTB + (size_t)l * 1048576, CAT, tid, wave, lane);) }
            GRID_BAR();
            TP_END(4);
        } else {
            TP_BEGIN(3);
            { pg8::Gemm g{Hbuf, WGDN + (size_t)j2 * GDN_N * DM, MROWS, GDN_N, DM}; pg8::StaticOrder S; S.init(MROWS, GDN_N, opq_s(G), opq_s(c)); pg8::EpiProj E{PROJ, GDN_LD, AUX, GDN_LD / 256, RS2};
              PH_GDNIN((pg8::gemm_phase<pg8::EpiProj, pg8::StaticOrder, PG8_ALIGN, PG8_SP2>(L + RING_OFF, g, S, E))); }
            if (l == 1) { const int Gq = opq_s(G), cq = opq_s(c); const int first = (Gq == 256) ? 160 : 0;
              pg8::Gemm g{KVOPS, KVOPS, 4 * 3072, 4 * 3072, DM}; pg8::KvOrder S{Gq - first, cq - first, 1, 96}; pg8::EpiKV E{KB, VTB};
              PH_KV((pg8::gemm_phase<pg8::EpiKV, pg8::KvOrder, PG8_ALIGN, PG8_SP2>(L + RING_OFF, g, S, E))); }
            GRID_BAR();
            TP_END(3);
            TP_BEGIN(2);
            DO_SCAN(gdn_chunk_phase(opq_s(c), opq_s(G), tid, L + RING_OFF, PROJ, INP(I_GDNCONV) + (size_t)j2 * 4 * 3 * MIXW, AUX, INP(I_ALOG) + j2 * GH, INP(I_DTB) + j2 * GH, CHB, UTB, CDB));
            GRID_BAR();
            TP_END(2);
            TP_BEGIN(7);
            {
                const int nscan = NBATCH * GH;
                const int cq = opq_s(c);
                if (opq_s(G) == 256) {
                    if (cq < nscan) { TP_BEGIN(9); DO_SCAN(gdn_scan2_unit(cq, L + RING_OFF, CHB, UTB, CDB, OBUF, tid, wave, lane)); TP_END(9); }
                    else for (int u = cq - nscan; u < 256; u += 256 - nscan) { PH_XA(xattn_unit(u, L + RING_OFF, PROJ, GDN_LD, 4 * MIXW, KB + (size_t)l * 1048576, VTB + (size_t)l * 1048576, CAT, tid, wave, lane);) }
                } else {
                    for (int u = opq_s(c); u < nscan; u += opq_s(G)) { DO_SCAN(gdn_scan2_unit(u, L + RING_OFF, CHB, UTB, CDB, OBUF, tid, wave, lane)); }
                    for (int u = opq_s(c); u < 256; u += opq_s(G)) { PH_XA(xattn_unit(u, L + RING_OFF, PROJ, GDN_LD, 4 * MIXW, KB + (size_t)l * 1048576, VTB + (size_t)l * 1048576, CAT, tid, wave, lane);) }
                }
            }
            GRID_BAR();
            TP_END(7);
            TP_BEGIN(5);
            PH_GOUT(gdn_out_phase(gw, NGW, lane, OBUF, PROJ, INP(I_NORMG) + j2 * GHD, CAT);)
            GRID_BAR();
            TP_END(5);
        }
        TP_BEGIN(3);
        { pg8::Gemm g{CAT, WOUT + (size_t)l * DM * DM, MROWS, DM, DM}; pg8::StaticOrder S; S.init(MROWS, DM, opq_s(G), opq_s(c)); pg8::EpiProj E{OUTb, DM, nullptr, -1, nullptr};
          PH_WOUT((pg8::gemm_phase<pg8::EpiProj, pg8::StaticOrder, PG8_ALIGN, PG8_SP2>(L + RING_OFF, g, S, E))); }
        GRID_BAR();
        TP_END(3);
        TP_BEGIN(6);
        PH_NORM(norm_phase(gw, NGW, lane, OUTb, 1.0f, INP(I_MPOST) + (size_t)l * DM, Hbuf, true, Hbuf, true, RS2);)
        GRID_BAR();
        TP_END(6);
        FFN_GEMMS(1);
        TP_BEGIN(6);
        if (l < DEPTH - 1) {
            PH_NORM(norm_phase(gw, NGW, lane, OUTb, 0.5f, INP(I_FPOST) + (size_t)(l * 2 + 1) * DM, Hbuf, true, Hbuf, true, RS2);)
            GRID_BAR();
        } else {
            PH_NORM(norm_phase(gw, NGW, lane, OUTb, 0.5f, INP(I_FPOST) + (size_t)(l * 2 + 1) * DM, Hbuf, true, ((float*)karg_ptr(19)), false, nullptr);)
        }
        TP_END(6);
    }
#ifdef TPROBE
    if (c == 0 && tid0 == 0) { unsigned long long a_ = (((unsigned long long)MISC[19] << 32) | MISC[18]); const unsigned long long t0_ = __builtin_amdgcn_s_memrealtime();
#if TPROBE == 8
        { const unsigned long long b_ = (((unsigned long long)MISC[23] << 32) | MISC[22]); a_ = b_ * 10000ull / (a_ ? a_ : 1ull); }
#endif
        while (__builtin_amdgcn_s_memrealtime() - t0_ < a_) __builtin_amdgcn_s_sleep(8); }
#endif
#undef FFN_GEMMS
#undef GRID_BAR
#undef tid
#undef lane
#undef wave
#undef gw
#undef NGW
}

extern "C" void kernel_launch(void* const* d_in, const int* in_sizes, int n_in, void* d_out, int out_size, void* d_ws, size_t ws_size, hipStream_t stream) {
    static int grid = 0;
    if (grid == 0) {
        if (n_in != 19 || in_sizes[0] != MROWS * DM || out_size != MROWS * DM || ws_size < WS_END) {
            fprintf(stderr, "kernel_launch: unexpected problem (n_in %d, in0 %d, out %d, ws %zu, need %zu); nothing launched\n", n_in, n_in > 0 ? in_sizes[0] : -1, out_size, ws_size, (size_t)WS_END); grid = -1; return; }
        int dev = 0, cus = 0, per_cu = 0;
        if (hipGetDevice(&dev) != hipSuccess || hipDeviceGetAttribute(&cus, hipDeviceAttributeMultiprocessorCount, dev) != hipSuccess) { fprintf(stderr, "kernel_launch: device query failed\n"); grid = -1; return; }
        if (hipFuncSetAttribute((const void*)fwd_kernel, hipFuncAttributeMaxDynamicSharedMemorySize, LDS_BYTES) != hipSuccess) { fprintf(stderr, "kernel_launch: hipFuncSetAttribute failed\n"); grid = -1; return; }
        if (hipOccupancyMaxActiveBlocksPerMultiprocessor(&per_cu, (const void*)fwd_kernel, NWAVES * 64, LDS_BYTES) != hipSuccess || per_cu < 1)
            fprintf(stderr, "kernel_launch: note: occupancy query reports %d workgroups per CU\n", per_cu);
        (void)hipGetLastError();
        grid = cus;
    }
    if (grid < 0) return;
    if (hipMemsetAsync((char*)d_ws + WS_CTL, 0, CTL_ZERO_BYTES, stream) != hipSuccess) { fprintf(stderr, "kernel_launch: memset failed\n"); return; }
    Args a{};
    for (int i = 0; i < 19; ++i) a.in[i] = (const float*)d_in[i];
    a.out = (float*)d_out; a.ws = (unsigned char*)d_ws;
    hipLaunchKernelGGL(fwd_kernel, dim3(grid), dim3(NWAVES * 64), LDS_BYTES, stream, a);
    const hipError_t le = hipPeekAtLastError();
    if (le != hipSuccess) fprintf(stderr, "kernel_launch: launch failed: %s\n", hipGetErrorName(le));
}
```
